# Optimizing an MI355X kernel written in HIP

```python
import math
import jax
import jax.numpy as jnp
from jax import lax
import numpy as np

D_MODEL = 1024
BATCH = 4
SEQ = 8192
DEPTH = 4

N_EVEN = (DEPTH + 1) // 2
N_ODD = DEPTH // 2

DIFF_HEADS = 4
DIFF_QK_DIM = 64
DIFF_V_DIM = 2 * DIFF_QK_DIM
ATTN_Q_BLOCK = 128
MOBA_HEADS = 4
MOBA_HEAD_DIM = 128
MOBA_BLOCK = 256
MOBA_TOPK = 3
MOBA_Q_CHUNK = 64
DIFF_QK_W = DIFF_HEADS * 2 * DIFF_QK_DIM
DIFF_V_W = DIFF_HEADS * DIFF_V_DIM
MOBA_W = MOBA_HEADS * MOBA_HEAD_DIM
HY_IN_W = 2 * DIFF_QK_W + DIFF_V_W + 3 * MOBA_W
HY_MIX_W = DIFF_V_W + MOBA_W
GLA_HEADS = 4
GLA_K_W = D_MODEL // 2
GLA_V_W = D_MODEL
GLA_DK = GLA_K_W // GLA_HEADS
GLA_DV = GLA_V_W // GLA_HEADS
GLA_GATE_RANK = 16
GLA_GATE_NORM = 16.0
GLA_CHUNK = 64
GLA_IN_W = 2 * GLA_K_W + 2 * GLA_V_W + GLA_GATE_RANK
D_FF = 4 * D_MODEL
ROPE_THETA = 10000.0
LN_EPS = 1e-5
RMS_EPS = 1e-5
DEEPNORM_ALPHA = (2 * DEPTH) ** 0.25
DEEPNORM_BETA = (8 * DEPTH) ** -0.25

kernel_name = "hybrid_diff_moba_gla_deepnorm"


def layer_norm(x, g, b):
    xf = x.astype(jnp.float32)
    mu = jnp.mean(xf, axis=-1, keepdims=True)
    var = jnp.mean(jnp.square(xf - mu), axis=-1, keepdims=True)
    return (((xf - mu) * lax.rsqrt(var + LN_EPS)) * g + b).astype(x.dtype)


def rms_norm(x, g):
    xf = x.astype(jnp.float32)
    y = xf * lax.rsqrt(jnp.mean(jnp.square(xf), axis=-1, keepdims=True) + RMS_EPS)
    return (y * g).astype(x.dtype)


def rope_tables(seq, dim):
    inv = 1.0 / (ROPE_THETA ** (jnp.arange(0, dim, 2, dtype=jnp.float32) / dim))
    ang = jnp.arange(seq, dtype=jnp.float32)[:, None] * inv[None, :]
    return jnp.cos(ang), jnp.sin(ang)


def apply_rope(x, cos, sin):
    x1, x2 = jnp.split(x, 2, axis=-1)
    c = cos.astype(x.dtype)
    s = sin.astype(x.dtype)
    return jnp.concatenate([x1 * c - x2 * s, x2 * c + x1 * s], axis=-1)


def diff_attention(q, k, v, lam, subln, lambda_init):
    Bn, H, _, S, dq = q.shape
    scale = dq ** -0.5
    lf = lam.astype(jnp.float32)
    lam_full = jnp.exp(jnp.sum(lf[0] * lf[1])) - jnp.exp(jnp.sum(lf[2] * lf[3])) + lambda_init
    nq = S // ATTN_Q_BLOCK
    qb = q.reshape(Bn, H, 2, nq, ATTN_Q_BLOCK, dq).transpose(3, 0, 1, 2, 4, 5)
    kpos = jnp.arange(S)

    def block(args):
        qi, i = args
        s = jnp.einsum('bhmqd,bhmkd->bhmqk', qi, k).astype(jnp.float32) * scale
        qpos = i * ATTN_Q_BLOCK + jnp.arange(ATTN_Q_BLOCK)
        s = jnp.where(kpos[None, :] <= qpos[:, None], s, -jnp.inf)
        p = jax.nn.softmax(s, axis=-1)
        w = p[:, :, 0] - lam_full * p[:, :, 1]
        return jnp.einsum('bhqk,bhkd->bhqd', w.astype(v.dtype), v)

    o = lax.map(block, (qb, jnp.arange(nq)))
    o = o.transpose(1, 2, 0, 3, 4).reshape(Bn, H, S, v.shape[-1])
    return rms_norm(o, subln) * (1.0 - lambda_init)


def moba_attention(q, k, v):
    Bn, H, S, d = q.shape
    scale = d ** -0.5
    s_pad = -(-S // MOBA_BLOCK) * MOBA_BLOCK
    pad = ((0, 0), (0, 0), (0, s_pad - S), (0, 0))
    q, k, v = jnp.pad(q, pad), jnp.pad(k, pad), jnp.pad(v, pad)
    nb = s_pad // MOBA_BLOCK
    topk = min(MOBA_TOPK, nb)
    kb = k.reshape(Bn, H, nb, MOBA_BLOCK, d)
    vb = v.reshape(Bn, H, nb, MOBA_BLOCK, d)
    kmean = jnp.mean(kb, axis=3)
    nc = s_pad // MOBA_Q_CHUNK
    qc = q.reshape(Bn, H, nc, MOBA_Q_CHUNK, d).transpose(2, 0, 1, 3, 4)
    gather = jax.vmap(jax.vmap(lambda blocks, idx: blocks[idx]))
    blk_ids = jnp.arange(nb)

    def chunk(args):
        qi, c = args
        start = c * MOBA_Q_CHUNK
        own = start // MOBA_BLOCK
        qpos = start + jnp.arange(MOBA_Q_CHUNK)
        gate = jnp.einsum('bhqd,bhnd->bhqn', qi, kmean).astype(jnp.float32)
        gate = jnp.where(blk_ids < own, gate, -jnp.inf)
        _, sel = lax.top_k(gate, topk)
        sel_valid = sel < own
        ks = gather(kb, sel)
        vs = gather(vb, sel)
        s_sel = jnp.einsum('bhqd,bhqnld->bhqnl', qi, ks).astype(jnp.float32) * scale
        s_sel = jnp.where(sel_valid[..., None], s_sel, -jnp.inf).reshape(Bn, H, MOBA_Q_CHUNK, topk * MOBA_BLOCK)
        k_own = lax.dynamic_index_in_dim(kb, own, axis=2, keepdims=False)
        v_own = lax.dynamic_index_in_dim(vb, own, axis=2, keepdims=False)
        s_own = jnp.einsum('bhqd,bhld->bhql', qi, k_own).astype(jnp.float32) * scale
        kpos = own * MOBA_BLOCK + jnp.arange(MOBA_BLOCK)
        s_own = jnp.where(kpos[None, :] <= qpos[:, None], s_own, -jnp.inf)
        p = jax.nn.softmax(jnp.concatenate([s_sel, s_own], axis=-1), axis=-1).astype(v.dtype)
        p_sel = p[..., :topk * MOBA_BLOCK].reshape(Bn, H, MOBA_Q_CHUNK, topk, MOBA_BLOCK)
        p_own = p[..., topk * MOBA_BLOCK:]
        return (jnp.einsum('bhqnl,bhqnld->bhqd', p_sel, vs)
                + jnp.einsum('bhql,bhld->bhqd', p_own, v_own))

    o = lax.map(chunk, (qc, jnp.arange(nc)))
    o = o.transpose(1, 2, 0, 3, 4).reshape(Bn, H, s_pad, d)
    return o[:, :, :S]


def gla_chunked(q, k, v, g):
    dtype = v.dtype
    Bn, H, S, dk = q.shape
    dv = v.shape[-1]
    L = GLA_CHUNK
    nc = S // L
    f32 = jnp.float32

    def to_chunks(t):
        return t.astype(f32).reshape(Bn, H, nc, L, t.shape[-1]).transpose(2, 0, 1, 3, 4)

    qc, kc, vc, gc = to_chunks(q * dk ** -0.5), to_chunks(k), to_chunks(v), to_chunks(g)
    causal = jnp.tril(jnp.ones((L, L), dtype=bool))[None, None, :, :, None]

    def step(state, inp):
        qi, ki, vi, gi = inp
        b = jnp.cumsum(gi, axis=2)
        o_inter = jnp.einsum('bhlk,bhkv->bhlv', qi * jnp.exp(b), state)
        rel = jnp.where(causal, b[:, :, :, None, :] - b[:, :, None, :, :], -jnp.inf)
        att = jnp.einsum('bhik,bhijk,bhjk->bhij', qi, jnp.exp(rel), ki)
        o_intra = jnp.einsum('bhij,bhjv->bhiv', att, vi)
        b_last = b[:, :, -1:, :]
        state = (jnp.exp(b_last[:, :, 0, :, None]) * state
                 + jnp.einsum('bhjk,bhjv->bhkv', ki * jnp.exp(b_last - b), vi))
        return state, o_inter + o_intra

    state0 = jnp.zeros((Bn, H, dk, dv), f32)
    _, o = lax.scan(step, state0, (qc, kc, vc, gc))
    return o.transpose(1, 2, 0, 3, 4).reshape(Bn, H, S, dv).astype(dtype)


def split_heads(t, n, d):
    Bn, S, _ = t.shape
    return t.reshape(Bn, S, n, d).transpose(0, 2, 1, 3)


def merge_heads(t):
    Bn, H, S, d = t.shape
    return t.transpose(0, 2, 1, 3).reshape(Bn, S, H * d)


def diff_moba_mixer(x, w_in, lam, subln, w_out, lambda_init, rope_d, rope_m):
    Bn, S, _ = x.shape
    h = x @ w_in
    o1 = DIFF_QK_W
    o2 = o1 + DIFF_QK_W
    o3 = o2 + DIFF_V_W
    o4 = o3 + MOBA_W
    o5 = o4 + MOBA_W

    def two_maps(t):
        return t.reshape(Bn, S, DIFF_HEADS, 2, DIFF_QK_DIM).transpose(0, 2, 3, 1, 4)

    dq = apply_rope(two_maps(h[..., :o1]), *rope_d)
    dk = apply_rope(two_maps(h[..., o1:o2]), *rope_d)
    dv = split_heads(h[..., o2:o3], DIFF_HEADS, DIFF_V_DIM)
    mq = apply_rope(split_heads(h[..., o3:o4], MOBA_HEADS, MOBA_HEAD_DIM), *rope_m)
    mk = apply_rope(split_heads(h[..., o4:o5], MOBA_HEADS, MOBA_HEAD_DIM), *rope_m)
    mv = split_heads(h[..., o5:], MOBA_HEADS, MOBA_HEAD_DIM)
    a = diff_attention(dq, dk, dv, lam, subln, lambda_init)
    b = moba_attention(mq, mk, mv)
    return jnp.concatenate([merge_heads(a), merge_heads(b)], axis=-1) @ w_out


def gla_mixer(x, w_in, w_gate_up, b_gate, norm_g, w_out):
    h = x @ w_in
    o1 = GLA_K_W
    o2 = o1 + GLA_K_W
    o3 = o2 + GLA_V_W
    o4 = o3 + GLA_V_W
    q = split_heads(h[..., :o1], GLA_HEADS, GLA_DK)
    k = split_heads(h[..., o1:o2], GLA_HEADS, GLA_DK)
    v = split_heads(h[..., o2:o3], GLA_HEADS, GLA_DV)
    r = h[..., o3:o4]
    g = jax.nn.log_sigmoid((h[..., o4:] @ w_gate_up + b_gate).astype(jnp.float32)) / GLA_GATE_NORM
    g = split_heads(g, GLA_HEADS, GLA_DK)
    o = rms_norm(gla_chunked(q, k, v, g), norm_g)
    return (merge_heads(o) * jax.nn.silu(r)) @ w_out


def sqrelu_mlp(x, w1, w2):
    return jnp.square(jax.nn.relu(x @ w1)) @ w2


def setup_inputs(seed: int = 0) -> dict:
    key = jax.random.key(seed)
    ks = jax.random.split(key, 17)

    def normal(k, shape, scale):
        return jax.random.normal(k, shape, jnp.float32) * scale

    return {
        'x': normal(ks[0], (BATCH, SEQ, D_MODEL), 1.0),
        'hy_w_in': normal(ks[1], (N_EVEN, D_MODEL, HY_IN_W), D_MODEL ** -0.5),
        'diff_lambda': normal(ks[2], (N_EVEN, 4, DIFF_QK_DIM), 0.1),
        'diff_subln': 1.0 + normal(ks[3], (N_EVEN, DIFF_V_DIM), 0.02),
        'hy_w_out': normal(ks[4], (N_EVEN, HY_MIX_W, D_MODEL), HY_MIX_W ** -0.5 * DEEPNORM_BETA),
        'gla_w_in': normal(ks[5], (N_ODD, D_MODEL, GLA_IN_W), D_MODEL ** -0.5),
        'gla_w_gate_up': normal(ks[6], (N_ODD, GLA_GATE_RANK, GLA_K_W), GLA_GATE_RANK ** -0.5),
        'gla_b_gate': normal(ks[7], (N_ODD, GLA_K_W), 0.02),
        'gla_norm': 1.0 + normal(ks[8], (N_ODD, GLA_DV), 0.02),
        'gla_w_out': normal(ks[9], (N_ODD, GLA_V_W, D_MODEL), GLA_V_W ** -0.5 * DEEPNORM_BETA),
        'ln_mix_g': 1.0 + normal(ks[10], (DEPTH, D_MODEL), 0.02),
        'ln_mix_b': normal(ks[11], (DEPTH, D_MODEL), 0.02),
        'ffn_w1': normal(ks[12], (DEPTH, D_MODEL, D_FF), D_MODEL ** -0.5),
        'ffn_w2': normal(ks[13], (DEPTH, D_FF, D_MODEL), D_FF ** -0.5 * DEEPNORM_BETA),
        'ln_ffn_g': 1.0 + normal(ks[14], (DEPTH, D_MODEL), 0.02),
        'ln_ffn_b': normal(ks[15], (DEPTH, D_MODEL), 0.02),
    }


def reference(x, hy_w_in, diff_lambda, diff_subln, hy_w_out, gla_w_in, gla_w_gate_up,
              gla_b_gate, gla_norm, gla_w_out, ln_mix_g, ln_mix_b, ffn_w1, ffn_w2,
              ln_ffn_g, ln_ffn_b):
    S = x.shape[1]
    rope_d = rope_tables(S, DIFF_QK_DIM)
    rope_m = rope_tables(S, MOBA_HEAD_DIM)
    for l in range(DEPTH):
        if l % 2 == 0:
            e = l // 2
            lambda_init = 0.8 - 0.6 * math.exp(-0.3 * l)
            mix = diff_moba_mixer(x, hy_w_in[e], diff_lambda[e], diff_subln[e], hy_w_out[e],
                                  lambda_init, rope_d, rope_m)
        else:
            o = l // 2
            mix = gla_mixer(x, gla_w_in[o], gla_w_gate_up[o], gla_b_gate[o], gla_norm[o], gla_w_out[o])
        x = layer_norm(DEEPNORM_ALPHA * x + mix, ln_mix_g[l], ln_mix_b[l])
        x = layer_norm(DEEPNORM_ALPHA * x + sqrelu_mlp(x, ffn_w1[l], ffn_w2[l]), ln_ffn_g[l], ln_ffn_b[l])
    return x
```

```cpp
#include <hip/hip_runtime.h>
#include <hip/hip_cooperative_groups.h>
#include <cstdio>
#include <cstdint>
namespace cg = cooperative_groups;

typedef unsigned short bf16_t;
typedef short bf16x8 __attribute__((ext_vector_type(8)));
typedef float f32x4 __attribute__((ext_vector_type(4)));
typedef float f32x16 __attribute__((ext_vector_type(16)));
typedef unsigned u32x2 __attribute__((ext_vector_type(2)));
typedef unsigned u32x4 __attribute__((ext_vector_type(4)));

#define DEVI __device__ __forceinline__
#define NEG_INF (-__builtin_inff())

constexpr int SEQ = 8192, NTOK = 32768, DM = 1024;
constexpr float DN_ALPHA = 1.681792830507429f;

constexpr size_t MiB = 1024ull * 1024ull;
constexpr size_t WS_WT    = 4096;
constexpr size_t WT_LAYER = 24 * MiB;
constexpr size_t WS_WGD   = WS_WT + 4 * WT_LAYER;
constexpr size_t WS_XB    = WS_WGD + 65536;
constexpr size_t WS_AO    = WS_XB + 64 * MiB;
constexpr size_t WS_OV    = WS_AO + 64 * MiB;
constexpr size_t WS_KM    = WS_OV + 256 * MiB;
constexpr size_t WS_DEC   = WS_KM + 524288;
constexpr size_t WS_DSEG  = WS_DEC + 1 * MiB;
constexpr size_t WS_BAR   = WS_DSEG + 131072;
constexpr size_t WS_STATS = WS_BAR + 16384;
constexpr size_t WS_MR    = WS_STATS + 8 * MiB;
constexpr size_t WS_UV    = WS_MR + 524288;
constexpr size_t WS_UVP   = WS_UV + 262144;
constexpr size_t WS_END   = WS_UVP + 4 * MiB;
constexpr int UV_U_IN = 0, UV_V_IN = 3072, UV_U_F1 = 6144, UV_V_F1 = 10240, UV_U_GD = 14336, UV_V_GD = 14352;
constexpr size_t OV_H   = 0;
constexpr size_t OV_DVT = 192 * MiB;
constexpr size_t OV_MVT = 224 * MiB;
constexpr size_t OV_HG  = 0;
constexpr size_t OV_VT  = 128 * MiB;
constexpr size_t OV_KT  = 192 * MiB;
constexpr size_t OV_U   = 224 * MiB;

struct Params {
  const float* in[16];
  float* X;
  unsigned char* ws;
};

typedef __bf16 bf16x2_t __attribute__((ext_vector_type(2)));
DEVI unsigned pk_bf16(float lo, float hi) { bf16x2_t v = {(__bf16)lo, (__bf16)hi}; return __builtin_bit_cast(unsigned, v); }
DEVI bf16_t f2bf(float f) { return (bf16_t)(pk_bf16(f, 0.f) & 0xffffu); }
DEVI float bf2f(bf16_t v) { return __uint_as_float(((unsigned)v) << 16); }
DEVI float bflo(unsigned u) { return __uint_as_float(u << 16); }
DEVI float bfhi(unsigned u) { return __uint_as_float(u & 0xffff0000u); }
DEVI bf16x8 mk8(unsigned a, unsigned b, unsigned c, unsigned d) { u32x4 v = {a, b, c, d}; return __builtin_bit_cast(bf16x8, v); }
DEVI bf16x8 pack8(const f32x16& x, int s) {
  return s == 0 ? mk8(pk_bf16(x[0], x[1]), pk_bf16(x[2], x[3]), pk_bf16(x[4], x[5]), pk_bf16(x[6], x[7]))
                : mk8(pk_bf16(x[8], x[9]), pk_bf16(x[10], x[11]), pk_bf16(x[12], x[13]), pk_bf16(x[14], x[15]));
}
DEVI f32x16 mfma32(bf16x8 a, bf16x8 b, f32x16 c) { return __builtin_amdgcn_mfma_f32_32x32x16_bf16(a, b, c, 0, 0, 0); }
DEVI f32x4 mfma16(bf16x8 a, bf16x8 b, f32x4 c) { return __builtin_amdgcn_mfma_f32_16x16x32_bf16(a, b, c, 0, 0, 0); }
DEVI float ex2(float x) { return __builtin_amdgcn_exp2f(x); }

template <int X> DEVI float swz_xor(float v) { return __int_as_float(__builtin_amdgcn_ds_swizzle(__float_as_int(v), (X << 10) | 0x1f)); }
DEVI void halves(float v, float& lo, float& hi) {
  auto r = __builtin_amdgcn_permlane32_swap(__float_as_uint(v), __float_as_uint(v), false, false);
  lo = __uint_as_float(r[0]); hi = __uint_as_float(r[1]);
}
DEVI void halves_i(int v, int& lo, int& hi) {
  auto r = __builtin_amdgcn_permlane32_swap((unsigned)v, (unsigned)v, false, false);
  lo = (int)r[0]; hi = (int)r[1];
}
DEVI float hsum(float v) { float a, b; halves(v, a, b); return a + b; }
DEVI float hmax(float v) { float a, b; halves(v, a, b); return fmaxf(a, b); }
DEVI float sum16(float v) { v += swz_xor<1>(v); v += swz_xor<2>(v); v += swz_xor<4>(v); v += swz_xor<8>(v); return v; }
DEVI float sum64(float v) { v = sum16(v); v += swz_xor<16>(v); return hsum(v); }
DEVI int otid(int wv) { int t = wv * 64 + (int)__builtin_amdgcn_mbcnt_hi(~0u, __builtin_amdgcn_mbcnt_lo(~0u, 0u)); asm volatile("" : "+v"(t)); return t; }

constexpr double cexp_pos(double x) { double s = 1.0, t = 1.0; for (int i = 1; i < 100; ++i) { t *= x / i; s += t; } return s; }
constexpr float rope_inv(int p, int dim) { return (float)(1.0 / cexp_pos((2.0 * p / dim) * 9.210340371976184)); }
struct RopeTab { float d[32]; float m[64]; };
constexpr RopeTab make_rope_tab() { RopeTab t{}; for (int p = 0; p < 32; ++p) t.d[p] = rope_inv(p, 64); for (int p = 0; p < 64; ++p) t.m[p] = rope_inv(p, 128); return t; }
__device__ const RopeTab g_rope = make_rope_tab();

DEVI void sincos_f(float a, float& s, float& c) {
  float n = rintf(a * 0.636619772367581343f);
  float r = fmaf(-n, 1.5703125f, a);
  r = fmaf(-n, 4.837512969970703125e-4f, r);
  r = fmaf(-n, 7.54978995489188216e-8f, r);
  float r2 = r * r;
  float sp = r + r * r2 * (-1.66666667e-1f + r2 * (8.33333333e-3f + r2 * (-1.98412698e-4f + r2 * 2.75573192e-6f)));
  float cp = 1.f + r2 * (-0.5f + r2 * (4.16666667e-2f + r2 * (-1.38888889e-3f + r2 * (2.48015873e-5f + r2 * (-2.75573192e-7f)))));
  int q = ((int)n) & 3;
  float ss = (q & 1) ? cp : sp, cc = (q & 1) ? sp : cp;
  s = (q & 2) ? -ss : ss;
  c = ((q + 1) & 2) ? -cc : cc;
}

DEVI int perm_even(int c) {
  const int sec = c >> 9, cl = c & 511;
  if (sec == 0 || sec == 1) { const int mm = cl >> 6, j = cl & 63, second = j >> 5, p = j & 31; return sec * 512 + mm * 64 + (p >> 4) * 32 + second * 16 + (p & 15); }
  if (sec == 3 || sec == 4) { const int hh = cl >> 7, j = cl & 127, second = j >> 6, p = j & 63; return sec * 512 + hh * 128 + (p >> 4) * 32 + second * 16 + (p & 15); }
  return c;
}

DEVI int perm32_row(int c) {
  const int x = c & 31; return (c & ~31) + ((x >> 2) & 1) * 16 + (x >> 3) * 4 + (x & 3);
}
struct WJob { const float* W; int ldw; bf16_t* Wt; int K, k0, c0, perm; const float* gvec; const float* bvec; float* uvec; float* vvec; };
DEVI void wjob_load(const WJob& j, int t, f32x4& a, f32x4& b) {
  const float* src = j.W + (size_t)(j.k0 + (t >> 3)) * j.ldw + j.c0 + (t & 7) * 8;
  a = *(const f32x4*)src; b = *(const f32x4*)(src + 4);
}
DEVI void wtrans_tile(const WJob& jw, f32x4 a, f32x4 b, char* lds, int t) {
  bf16_t* Wt = jw.Wt; const int K = jw.K, k0 = jw.k0, c0 = jw.c0, perm = jw.perm;
  const float* gvec = jw.gvec; const float* bvec = jw.bvec; float* uvec = jw.uvec; float* vvec = jw.vvec;
  bf16_t* tl = (bf16_t*)lds;
  float* suw = (float*)(lds + 9216);
  const bool fold = gvec != nullptr;
  { const int kr = t >> 3, cc = (t & 7) * 8;
    if (fold) {
      const float gk = gvec[k0 + kr], bk = bvec[k0 + kr];
      float ua[8], va[8];
#pragma unroll
      for (int i = 0; i < 4; ++i) {
        const bf16_t ra = f2bf(a[i] * gk), rb = f2bf(b[i] * gk);
        tl[(cc + i) * 66 + kr] = ra; tl[(cc + 4 + i) * 66 + kr] = rb;
        ua[i] = bf2f(ra); ua[4 + i] = bf2f(rb); va[i] = a[i] * bk; va[4 + i] = b[i] * bk;
      }
#pragma unroll
      for (int i = 0; i < 8; ++i) {
        float x = ua[i], y = va[i];
        x += swz_xor<8>(x); y += swz_xor<8>(y);
        x += swz_xor<16>(x); y += swz_xor<16>(y);
        x = hsum(x); y = hsum(y);
        if ((t & 63) < 8) { suw[(t >> 6) * 128 + cc + i] = x; suw[(t >> 6) * 128 + 64 + cc + i] = y; }
      }
    } else {
#pragma unroll
      for (int i = 0; i < 4; ++i) { tl[(cc + i) * 66 + kr] = f2bf(a[i]); tl[(cc + 4 + i) * 66 + kr] = f2bf(b[i]); }
    } }
  __syncthreads();
  { const int c = t >> 3, kc = (t & 7) * 8;
    const unsigned* rp = (const unsigned*)(tl + c * 66 + kc);
    const u32x4 v = {rp[0], rp[1], rp[2], rp[3]};
    const int g = perm == 1 ? perm_even(c0 + c) : (perm == 2 || (perm == 3 && ((c0 + c) < 1024 || (c0 + c) >= 2048)) ? perm32_row(c0 + c) : (c0 + c));
    *(u32x4*)(Wt + (size_t)g * K + k0 + kc) = v; }
  if (fold && t < 128) {
    float acc = 0.f;
#pragma unroll
    for (int w8 = 0; w8 < 8; ++w8) acc += suw[w8 * 128 + t];
    const int c = t & 63;
    const int g = perm == 1 ? perm_even(c0 + c) : (perm == 2 || (perm == 3 && ((c0 + c) < 1024 || (c0 + c) >= 2048)) ? perm32_row(c0 + c) : (c0 + c));
    ((t < 64 ? uvec : vvec) + (size_t)(k0 >> 6) * 16384)[g] = acc;
  }
  __syncthreads();
}

DEVI void prologue(const Params& p, char* lds, int wv) {
  const int G = gridDim.x;
  unsigned char* ws = p.ws;
  auto decode = [&](int jb, WJob& j) {
    const int l = jb / 3072; int rem = jb % 3072;
    bf16_t* wl = (bf16_t*)(ws + WS_WT + (size_t)l * WT_LAYER);
    float* uv = (float*)(ws + WS_UVP) + (size_t)l * 16 * 16384;
    j.gvec = nullptr; j.bvec = nullptr; j.uvec = nullptr; j.vvec = nullptr;
    if (rem < 768) {
      const int kt = rem / 48, ct = rem % 48;
      j.K = 1024; j.k0 = kt * 64; j.c0 = ct * 64; j.Wt = wl;
      if (l & 1) { j.W = p.in[5] + (size_t)(l >> 1) * 1024 * 3088; j.ldw = 3088; j.perm = 3; j.gvec = p.in[14] + (l - 1) * 1024; j.bvec = p.in[15] + (l - 1) * 1024; j.uvec = uv + UV_U_IN; j.vvec = uv + UV_V_IN; }
      else       { j.W = p.in[1] + (size_t)(l >> 1) * 1024 * 3072; j.ldw = 3072; j.perm = 1; }
    } else if (rem < 1024) {
      rem -= 768; const int kt = rem / 16, ct = rem % 16;
      j.W = (l & 1) ? p.in[9] + (size_t)(l >> 1) * 1024 * 1024 : p.in[4] + (size_t)(l >> 1) * 1024 * 1024;
      j.ldw = 1024; j.Wt = wl + 3 * 1024 * 1024; j.K = 1024; j.k0 = kt * 64; j.c0 = ct * 64; j.perm = 2;
    } else if (rem < 2048) {
      rem -= 1024; const int kt = rem / 64, ct = rem % 64;
      j.W = p.in[12] + (size_t)l * 1024 * 4096; j.ldw = 4096; j.Wt = wl + 4 * 1024 * 1024; j.K = 1024; j.k0 = kt * 64; j.c0 = ct * 64; j.perm = 2;
      j.gvec = p.in[10] + l * 1024; j.bvec = p.in[11] + l * 1024; j.uvec = uv + UV_U_F1; j.vvec = uv + UV_V_F1;
    } else {
      rem -= 2048; const int kt = rem / 16, ct = rem % 16;
      j.W = p.in[13] + (size_t)l * 4096 * 1024; j.ldw = 1024; j.Wt = wl + 8 * 1024 * 1024; j.K = 4096; j.k0 = kt * 64; j.c0 = ct * 64; j.perm = 2;
    }
  };
  { const int tw = otid(wv);
    int jb = blockIdx.x;
    WJob cur{}, nxt{}; f32x4 ca = {}, cbv = {}, na = {}, nb = {};
    if (jb < 4 * 3072) { decode(jb, cur); wjob_load(cur, tw, ca, cbv); }
#pragma unroll 1
    while (jb < 4 * 3072) {
      const int jn = jb + G;
      if (jn < 4 * 3072) { decode(jn, nxt); wjob_load(nxt, tw, na, nb); }
      wtrans_tile(cur, ca, cbv, lds, tw);
      cur = nxt; ca = na; cbv = nb; jb = jn;
    } }
  const int gt = blockIdx.x * 512 + otid(wv), GT = G * 512;
  { const int t = otid(wv); const int gw = blockIdx.x * 8 + (t >> 6), lane = t & 63;
    if (gw < 32) {
      const int o = gw >> 4, rr = gw & 15, lsrc = 2 * o;
      const float* gv = p.in[14] + lsrc * 1024; const float* bv = p.in[15] + lsrc * 1024;
      float us = 0.f, vs = 0.f;
      for (int k = lane; k < 1024; k += 64) {
        const float wgt = p.in[5][(size_t)o * 1024 * 3088 + (size_t)k * 3088 + 3072 + rr];
        const bf16_t rb = f2bf(wgt * gv[k]);
        ((bf16_t*)(ws + WS_WGD))[(o * 16 + rr) * 1024 + k] = rb;
        us += bf2f(rb); vs += wgt * bv[k];
      }
      us = sum64(us); vs = sum64(vs);
      if (lane == 0) { float* uv = (float*)(ws + WS_UV) + (size_t)(2 * o + 1) * 16384; uv[UV_U_GD + rr] = us; uv[UV_V_GD + rr] = vs; }
    } }
  for (int i = gt; i < 131072; i += GT) ((float*)(ws + WS_KM))[i] = 0.f;
  for (int i = gt; i < NTOK * DM / 8; i += 4 * GT) {
    f32x4 a[4], b[4];
#pragma unroll
    for (int k = 0; k < 4; ++k) { if (i + k * GT < NTOK * DM / 8) { const size_t e8 = (size_t)(i + k * GT) * 8; a[k] = *(const f32x4*)(p.in[0] + e8); b[k] = *(const f32x4*)(p.in[0] + e8 + 4); } }
#pragma unroll
    for (int k = 0; k < 4; ++k) {
      if (i + k * GT < NTOK * DM / 8) {
        u32x4 v = {pk_bf16(a[k][0], a[k][1]), pk_bf16(a[k][2], a[k][3]), pk_bf16(b[k][0], b[k][1]), pk_bf16(b[k][2], b[k][3])};
        *(u32x4*)((bf16_t*)(ws + WS_XB) + (size_t)(i + k * GT) * 8) = v;
      }
    }
  }
}

#define LAS __attribute__((address_space(3)))
constexpr int BM = 256, BK = 64, HALF = 128, HTB = HALF * BK * 2, NXCD = 8, WGM = 4;
DEVI int lds_byte(int r, int c) { const int st = (r >> 4) * 2 + (c >> 5), rr = r & 15, cc = c & 31, ob = rr * 64 + cc * 2; return st * 1024 + (ob ^ (((ob >> 9) & 1) << 5)); }
DEVI void stage_rc(int b, int& R, int& C) { const int st = b / 1024, sb = b % 1024, swz = sb ^ (((sb >> 9) & 1) << 5); R = (st >> 1) * 16 + swz / 64; C = (st & 1) * 32 + (swz % 64) / 2; }

enum { EPI_EVEN = 0, EPI_GLA = 1, EPI_RES = 2, EPI_FFN1 = 3 };
struct EpiArgs {
  int kind;
  bf16_t* H; bf16_t* vt0; bf16_t* vt1; float* kmsum;
  bf16_t* Hff;
  const float* stat_in; const float* u; const float* v;
  bf16_t* Y; float* X;
  const float* stat_prev; const float* gprev; const float* bprev;
  float* stat_new; int final_out;
};
DEVI void row_sums(const float* raw, int row, float& s1, float& s2) {
  typedef float f32x2 __attribute__((ext_vector_type(2)));
  float a1 = 0.f, a2 = 0.f;
#pragma unroll
  for (int k = 0; k < 16; ++k) { const f32x2 p = *(const f32x2*)(raw + (size_t)k * 65536 + 2 * row); a1 += p[0]; a2 += p[1]; }
  s1 = a1; s2 = a2;
}
DEVI void stat_finalize(const float* raw, float* mr, int wv) {
  for (int row = blockIdx.x * 512 + otid(wv); row < NTOK; row += gridDim.x * 512) {
    float s1, s2; row_sums(raw, row, s1, s2);
    const float mu = s1 * (1.f / 1024.f);
    const float var = fmaxf(s2 * (1.f / 1024.f) - mu * mu, 0.f);
    mr[2 * row] = mu; mr[2 * row + 1] = rsqrtf(var + 1e-5f);
  }
}
DEVI void row_mu_rstd(const float* mr, int row, float& mu, float& rstd) { mu = mr[2 * row]; rstd = mr[2 * row + 1]; }
struct Unit { int brow, bcol, swap; };

DEVI bool unit_next(int i, int nN, int kind, Unit& u) {
  const int nM = NTOK / BM, nwg = nM * nN;
  const long L = (long)i * gridDim.x + blockIdx.x;
  if (L >= nwg) return false;
  int wgid = (int)L;
  { const int q = nwg / NXCD, r = nwg % NXCD, xcd = wgid % NXCD, off = wgid / NXCD; wgid = (xcd < r ? xcd * (q + 1) : r * (q + 1) + (xcd - r) * q) + off; }
  const int nig = WGM * nN, gid = wgid / nig, fm = gid * WGM, gsz = (nM - fm) < WGM ? (nM - fm) : WGM;
  const int pm = fm + ((wgid % nig) % gsz), pn = (wgid % nig) / gsz;
  u.brow = pm * BM; u.bcol = pn * BM;
  const int sec = u.bcol >> 9;
  u.swap = (kind == EPI_EVEN && (sec == 2 || sec == 5)) || (kind == EPI_GLA && (sec == 2 || sec == 3));
  return true;
}

DEVI void acc_init(f32x4 (&acc)[2][2][4][2], const Unit& un, int wr, int wc, int fr, int fq, const EpiArgs& e) {
  if (!e.stat_in) {
#pragma unroll
    for (int a = 0; a < 2; ++a)
#pragma unroll
      for (int b = 0; b < 2; ++b)
#pragma unroll
        for (int m = 0; m < 4; ++m)
#pragma unroll
          for (int n = 0; n < 2; ++n) acc[a][b][m][n] = (f32x4){0.f, 0.f, 0.f, 0.f};
  } else if (!un.swap) {
    float nmu[8];
#pragma unroll
    for (int q = 0; q < 8; ++q) nmu[q] = -e.stat_in[2 * (un.brow + (q >> 2) * 128 + wr * 64 + (q & 3) * 16 + fr)];
#pragma unroll
    for (int bj = 0; bj < 2; ++bj)
#pragma unroll
      for (int n = 0; n < 2; ++n) {
        const f32x4 u4 = *(const f32x4*)(e.u + un.bcol + bj * 128 + wc * 32 + n * 16 + 4 * fq);
#pragma unroll
        for (int q = 0; q < 8; ++q) acc[q >> 2][bj][q & 3][n] = u4 * nmu[q];
      }
  } else {
    float uc[8];
#pragma unroll
    for (int q = 0; q < 8; ++q) uc[q] = e.u[un.bcol + (q >> 2) * 128 + wr * 64 + (q & 3) * 16 + fr];
#pragma unroll
    for (int bj = 0; bj < 2; ++bj)
#pragma unroll
      for (int n = 0; n < 2; ++n) {
        const int tok = un.brow + bj * 128 + wc * 32 + n * 16 + 4 * fq;
        const f32x4 sa = *(const f32x4*)(e.stat_in + 2 * tok), sb = *(const f32x4*)(e.stat_in + 2 * tok + 4);
        const f32x4 nmu = {-sa[0], -sa[2], -sb[0], -sb[2]};
#pragma unroll
        for (int q = 0; q < 8; ++q) acc[q >> 2][bj][q & 3][n] = nmu * uc[q];
      }
  }
}
DEVI float row_rstd(const float* mr, int row) { return mr[2 * row + 1]; }
DEVI f32x4 rstd4(const float* mr, int tok) {
  const f32x4 sa = *(const f32x4*)(mr + 2 * tok), sb = *(const f32x4*)(mr + 2 * tok + 4);
  return (f32x4){sa[1], sa[3], sb[1], sb[3]};
}

template <bool FOLD>
DEVI void epi_vt(const f32x4 (&acc)[2][2][4][2], bf16_t* vt, int chan0, int tok0, int nchan, int wr, int wc, int fr, int fq, const EpiArgs& e, int gcol0) {
  const int b = tok0 >> 13, s0 = tok0 & 8191;
  f32x4 rs[2][2];
#pragma unroll
  for (int bj = 0; bj < 2; ++bj)
#pragma unroll
    for (int n = 0; n < 2; ++n) { if (FOLD) rs[bj][n] = rstd4(e.stat_in, tok0 + bj * 128 + wc * 32 + n * 16 + 4 * fq); else rs[bj][n] = (f32x4){1.f, 1.f, 1.f, 1.f}; }
  float vcs[8];
#pragma unroll
  for (int q = 0; q < 8; ++q) { if (FOLD) vcs[q] = e.v[gcol0 + (q >> 2) * 128 + wr * 64 + (q & 3) * 16 + fr]; else vcs[q] = 0.f; }
#pragma unroll
  for (int ai = 0; ai < 2; ++ai)
#pragma unroll
    for (int m = 0; m < 4; ++m) {
      bf16_t* rowp = (bf16_t*)((char*)vt + ((unsigned)(b * nchan + chan0 + ai * 128 + wr * 64 + m * 16 + fr) * 8192u + (unsigned)(s0 + wc * 32 + 4 * fq)) * 2u);
      const float vc = vcs[ai * 4 + m];
#pragma unroll
      for (int bj = 0; bj < 2; ++bj)
#pragma unroll
        for (int n = 0; n < 2; ++n) {
          const f32x4 v = acc[ai][bj][m][n] * rs[bj][n] + vc;
          u32x2 w2 = {pk_bf16(v[0], v[1]), pk_bf16(v[2], v[3])};
          *(u32x2*)(rowp + bj * 128 + n * 16) = w2;
        }
    }
}

DEVI void epi_even(const f32x4 (&acc)[2][2][4][2], const Unit& u, int wr, int wc, int fr, int fq, const EpiArgs& e) {
  const int sec = u.bcol >> 9;
  if (u.swap) { epi_vt<false>(acc, sec == 2 ? e.vt0 : e.vt1, u.bcol & 511, u.brow, 512, wr, wc, fr, fq, e, u.bcol); return; }
  const bool moba = sec >= 3;
  const int b = u.brow >> 13, sb = u.brow & 8191;
#pragma unroll
  for (int bj = 0; bj < 2; ++bj) {
    const int gl = (u.bcol & 511) + bj * 128 + wc * 32;
    int p0, c1, half;
    if (!moba) { const int mm = gl >> 6, grp = (gl >> 5) & 1; p0 = grp * 16 + 4 * fq; c1 = sec * 512 + mm * 64 + p0; half = 32; }
    else       { const int hh = gl >> 7, grp = (gl >> 5) & 3; p0 = grp * 16 + 4 * fq; c1 = sec * 512 + hh * 128 + p0; half = 64; }
    const f32x4 inv = moba ? *(const f32x4*)(g_rope.m + p0) : *(const f32x4*)(g_rope.d + p0);
    f32x4 ks1 = {0.f, 0.f, 0.f, 0.f}, ks2 = {0.f, 0.f, 0.f, 0.f};
#pragma unroll
    for (int ai = 0; ai < 2; ++ai)
#pragma unroll
      for (int m = 0; m < 4; ++m) {
        const int row = u.brow + ai * 128 + wr * 64 + m * 16 + fr;
        const float pos = (float)(row & 8191);
        const f32x4 x1 = acc[ai][bj][m][0], x2 = acc[ai][bj][m][1];
        f32x4 y1, y2;
#pragma unroll
        for (int j = 0; j < 4; ++j) {
          float sn, cs; sincos_f(pos * inv[j], sn, cs);
          y1[j] = x1[j] * cs - x2[j] * sn; y2[j] = x2[j] * cs + x1[j] * sn;
        }
        u32x2 w1 = {pk_bf16(y1[0], y1[1]), pk_bf16(y1[2], y1[3])}, w2 = {pk_bf16(y2[0], y2[1]), pk_bf16(y2[2], y2[3])};
        const unsigned hoff = (unsigned)row * 6144u + (unsigned)c1 * 2u;
        *(u32x2*)((char*)e.H + hoff) = w1;
        *(u32x2*)((char*)e.H + hoff + (unsigned)half * 2u) = w2;
        ks1 += y1; ks2 += y2;
        __builtin_amdgcn_sched_barrier(0);
      }
    if (sec == 4) {
#pragma unroll
      for (int j = 0; j < 4; ++j) {
        float a = ks1[j], c = ks2[j];
        a = sum16(a); c = sum16(c);
        if (fr == 0) {
          float* kp = e.kmsum + (size_t)(b * 32 + (sb >> 8)) * 512 + (c1 - 2048) + j;
          atomicAdd(kp, a); atomicAdd(kp + 64, c);
        }
      }
    }
  }
}

DEVI void epi_gla(const f32x4 (&acc)[2][2][4][2], const Unit& u, int wr, int wc, int fr, int fq, const EpiArgs& e) {
  if (u.swap) { epi_vt<true>(acc, e.vt0, u.bcol - 1024, u.brow, 1024, wr, wc, fr, fq, e, u.bcol); return; }
  const int cb = (u.bcol < 1024) ? u.bcol : u.bcol - 1024;
  f32x4 v4[2][2];
#pragma unroll
  for (int bj = 0; bj < 2; ++bj)
#pragma unroll
    for (int n = 0; n < 2; ++n) v4[bj][n] = *(const f32x4*)(e.v + u.bcol + bj * 128 + wc * 32 + n * 16 + 4 * fq);
  float rsq[8];
#pragma unroll
  for (int q = 0; q < 8; ++q) rsq[q] = row_rstd(e.stat_in, u.brow + (q >> 2) * 128 + wr * 64 + (q & 3) * 16 + fr);
#pragma unroll
  for (int ai = 0; ai < 2; ++ai)
#pragma unroll
    for (int m = 0; m < 4; ++m) {
      bf16_t* rowp = (bf16_t*)((char*)e.H + ((unsigned)(u.brow + ai * 128 + wr * 64 + m * 16 + fr) * 2048u + (unsigned)(cb + wc * 32 + 8 * fq)) * 2u);
      const float rsr = rsq[ai * 4 + m];
#pragma unroll
      for (int bj = 0; bj < 2; ++bj) {
        const f32x4 v0 = acc[ai][bj][m][0] * rsr + v4[bj][0], v1 = acc[ai][bj][m][1] * rsr + v4[bj][1];
        u32x4 w4 = {pk_bf16(v0[0], v0[1]), pk_bf16(v0[2], v0[3]), pk_bf16(v1[0], v1[1]), pk_bf16(v1[2], v1[3])};
        *(u32x4*)(rowp + bj * 128) = w4;
      }
    }
}

DEVI void epi_res(const f32x4 (&acc)[2][2][4][2], const Unit& u, int wr, int wc, int fr, int fq, const EpiArgs& e) {
  float mus[8], rsd[8]; f32x4 g4[2][2], b4[2][2];
  const bool ln = e.stat_prev != nullptr;
  if (ln) {
#pragma unroll
    for (int q = 0; q < 8; ++q) row_mu_rstd(e.stat_prev, u.brow + (q >> 2) * 128 + wr * 64 + (q & 3) * 16 + fr, mus[q], rsd[q]);
#pragma unroll
    for (int bj = 0; bj < 2; ++bj)
#pragma unroll
      for (int n = 0; n < 2; ++n) {
        const int c = u.bcol + bj * 128 + wc * 32 + 8 * fq + 4 * n;
        g4[bj][n] = *(const f32x4*)(e.gprev + c); b4[bj][n] = *(const f32x4*)(e.bprev + c);
      }
  } else {
#pragma unroll
    for (int q = 0; q < 8; ++q) { mus[q] = 0.f; rsd[q] = 1.f; }
#pragma unroll
    for (int bj = 0; bj < 2; ++bj)
#pragma unroll
      for (int n = 0; n < 2; ++n) { g4[bj][n] = (f32x4){1.f, 1.f, 1.f, 1.f}; b4[bj][n] = (f32x4){0.f, 0.f, 0.f, 0.f}; }
  }
#pragma unroll
  for (int ai = 0; ai < 2; ++ai)
#pragma unroll
    for (int m = 0; m < 4; ++m) {
      const int row = u.brow + ai * 128 + wr * 64 + m * 16 + fr;
      const unsigned o0 = (unsigned)row * 1024u + (unsigned)(u.bcol + wc * 32 + 8 * fq);
      const float mu = mus[ai * 4 + m], rstd = rsd[ai * 4 + m];
      u32x4 rb[2];
#pragma unroll
      for (int bj = 0; bj < 2; ++bj) rb[bj] = *(const u32x4*)((const char*)e.Y + (o0 + bj * 128) * 2u);
      float s1 = 0.f, s2 = 0.f;
#pragma unroll
      for (int bj = 0; bj < 2; ++bj) {
        const unsigned o = o0 + bj * 128;
        f32x4 r0 = {bflo(rb[bj][0]), bfhi(rb[bj][0]), bflo(rb[bj][1]), bfhi(rb[bj][1])};
        f32x4 r1 = {bflo(rb[bj][2]), bfhi(rb[bj][2]), bflo(rb[bj][3]), bfhi(rb[bj][3])};
        r0 = (r0 - mu) * rstd * g4[bj][0] + b4[bj][0];
        r1 = (r1 - mu) * rstd * g4[bj][1] + b4[bj][1];
        const f32x4 y0 = r0 * DN_ALPHA + acc[ai][bj][m][0], y1 = r1 * DN_ALPHA + acc[ai][bj][m][1];
        u32x4 w4 = {pk_bf16(y0[0], y0[1]), pk_bf16(y0[2], y0[3]), pk_bf16(y1[0], y1[1]), pk_bf16(y1[2], y1[3])};
        *(u32x4*)((char*)e.Y + o * 2u) = w4;
        if (e.final_out) { *(f32x4*)((char*)e.X + o * 4u) = y0; *(f32x4*)((char*)e.X + o * 4u + 16) = y1; }
        s1 += ((y0[0] + y0[1]) + (y0[2] + y0[3])) + ((y1[0] + y1[1]) + (y1[2] + y1[3]));
        s2 += ((y0[0] * y0[0] + y0[1] * y0[1]) + (y0[2] * y0[2] + y0[3] * y0[3])) + ((y1[0] * y1[0] + y1[1] * y1[1]) + (y1[2] * y1[2] + y1[3] * y1[3]));
      }
      s1 += swz_xor<16>(s1); s2 += swz_xor<16>(s2);
      s1 = hsum(s1); s2 = hsum(s2);
      if (fq == 0) { float* sp = e.stat_new + (size_t)((u.bcol >> 8) * 4 + wc) * 65536 + 2 * row; sp[0] = s1; sp[1] = s2; }
    }
}

DEVI void epi_ffn1(const f32x4 (&acc)[2][2][4][2], const Unit& u, int wr, int wc, int fr, int fq, const EpiArgs& e) {
  float rs[8]; f32x4 v4[2][2];
#pragma unroll
  for (int q = 0; q < 8; ++q) rs[q] = row_rstd(e.stat_in, u.brow + (q >> 2) * 128 + wr * 64 + (q & 3) * 16 + fr);
#pragma unroll
  for (int bj = 0; bj < 2; ++bj)
#pragma unroll
    for (int n = 0; n < 2; ++n) v4[bj][n] = *(const f32x4*)(e.v + u.bcol + bj * 128 + wc * 32 + n * 16 + 4 * fq);
#pragma unroll
  for (int ai = 0; ai < 2; ++ai)
#pragma unroll
    for (int m = 0; m < 4; ++m) {
      bf16_t* rowp = (bf16_t*)((char*)e.Hff + ((unsigned)(u.brow + ai * 128 + wr * 64 + m * 16 + fr) * 4096u + (unsigned)(u.bcol + wc * 32 + 8 * fq)) * 2u);
      const float rsr = rs[ai * 4 + m];
#pragma unroll
      for (int bj = 0; bj < 2; ++bj) {
        f32x4 v0 = acc[ai][bj][m][0] * rsr + v4[bj][0], v1 = acc[ai][bj][m][1] * rsr + v4[bj][1];
#pragma unroll
        for (int j = 0; j < 4; ++j) { const float t0 = fmaxf(v0[j], 0.f), t1 = fmaxf(v1[j], 0.f); v0[j] = t0 * t0; v1[j] = t1 * t1; }
        u32x4 w4 = {pk_bf16(v0[0], v0[1]), pk_bf16(v0[2], v0[3]), pk_bf16(v1[0], v1[1]), pk_bf16(v1[2], v1[3])};
        *(u32x4*)(rowp + bj * 128) = w4;
      }
    }
}

extern __shared__ __attribute__((aligned(16))) unsigned char g_lds[];

DEVI void gemm_phase(const bf16_t* A, const bf16_t* Bt, int N, int K, const EpiArgs& e, int wv) {
  LAS unsigned char* lds = (LAS unsigned char*)g_lds;
  const int tid = otid(wv), wid = __builtin_amdgcn_readfirstlane(tid >> 6), lane = tid & 63, wr = wid >> 2, wc = wid & 3, fr = lane & 15, fq = lane >> 4;
  const int nt = K / BK, nN = N / BM;
  unsigned voff[2];
#pragma unroll
  for (int i = 0; i < 2; ++i) { int R, C; stage_rc(tid * 16 + i * 8192, R, C); voff[i] = (unsigned)(R * K + C) * 2u; }
  const size_t kstep = (size_t)(BK * 2);
  const size_t hstep = (size_t)HALF * K * 2;
  const size_t tstep = 2 * hstep;
  const unsigned ldsw = (unsigned)wid * 1024u;
  const int aoff = lds_byte(wr * 64 + fr, fq * 8), boff = lds_byte(wc * 32 + fr, fq * 8);
#define PG8_SA(b, h) (((b) * 2 + (h)) * HTB)
#define PG8_SB(b, h) ((4 + (b) * 2 + (h)) * HTB)
#define PG8_STAGE(bufoff, gbase) do { _Pragma("unroll") for (int _i = 0; _i < 2; ++_i) \
    __builtin_amdgcn_global_load_lds((const unsigned*)((const char*)(gbase) + voff[_i]), (LAS unsigned*)(lds + (bufoff) + ldsw + _i * 8192), 16, 0, 0); } while (0)
#define PG8_LDA(dst, b, h) do { _Pragma("unroll") for (int m = 0; m < 4; ++m) _Pragma("unroll") for (int k = 0; k < 2; ++k) dst[m][k] = *(const LAS bf16x8*)(lds + PG8_SA(b, h) + aoff + m * 2048 + k * 1024); } while (0)
#define PG8_LDB(dst, b, h) do { _Pragma("unroll") for (int n = 0; n < 2; ++n) _Pragma("unroll") for (int k = 0; k < 2; ++k) dst[n][k] = *(const LAS bf16x8*)(lds + PG8_SB(b, h) + boff + n * 2048 + k * 1024); } while (0)
#define PG8_MMA(ai, bj, At, Bt_) do { __builtin_amdgcn_s_setprio(1); _Pragma("unroll") for (int m = 0; m < 4; ++m) _Pragma("unroll") for (int n = 0; n < 2; ++n) _Pragma("unroll") for (int k = 0; k < 2; ++k) \
    acc[ai][bj][m][n] = __builtin_amdgcn_mfma_f32_16x16x32_bf16(Bt_[n][k], At[m][k], acc[ai][bj][m][n], 0, 0, 0); __builtin_amdgcn_s_setprio(0); } while (0)
#define PG8_WAIT_V(n) asm volatile("s_waitcnt vmcnt(" #n ")" ::: "memory")
#define PG8_WAIT_L(n) asm volatile("s_waitcnt lgkmcnt(" #n ")" ::: "memory")
#define PG8_BAR __builtin_amdgcn_s_barrier()
#define PG8_SCHED __builtin_amdgcn_sched_barrier(0)
#define UNIT_P(u) ((const char*)((u).swap ? Bt : A) + (size_t)(((u).swap ? (u).bcol : (u).brow) >> 8) * tstep)
#define UNIT_Q(u) ((const char*)((u).swap ? A : Bt) + (size_t)(((u).swap ? (u).brow : (u).bcol) >> 8) * tstep)
  Unit cur, nxt; int ui = 0;
  if (!unit_next(0, nN, e.kind, cur)) return;
  f32x4 acc[2][2][4][2];
  acc_init(acc, cur, wr, wc, fr, fq, e);
  bf16x8 At[4][2], B0[2][2], B1[2][2];
  const char* cA = UNIT_P(cur); const char* cB = UNIT_Q(cur);
  PG8_STAGE(PG8_SB(0, 0), cB); PG8_STAGE(PG8_SB(0, 1), cB + hstep); PG8_STAGE(PG8_SA(0, 0), cA); PG8_STAGE(PG8_SA(0, 1), cA + hstep);
  if (wr == 1) PG8_BAR;
  PG8_WAIT_V(2); PG8_BAR;
  PG8_STAGE(PG8_SB(1, 0), cB + kstep); PG8_STAGE(PG8_SA(1, 0), cA + kstep); PG8_STAGE(PG8_SB(1, 1), cB + hstep + kstep);
  PG8_WAIT_V(6); PG8_BAR;
  for (;;) {
    const bool has_next = unit_next(ui + 1, nN, e.kind, nxt);
    const char* nA = has_next ? UNIT_P(nxt) : cA; const char* nB = has_next ? UNIT_Q(nxt) : cB;
#pragma unroll 1
    for (int t = 0; t < nt; t += 2) {
      const bool last = (t == nt - 2);
      const char* a1 = cA + (size_t)(t + 1) * kstep;
      const char* a2 = last ? nA : cA + (size_t)(t + 2) * kstep; const char* b2 = last ? nB : cB + (size_t)(t + 2) * kstep;
      const char* a3 = a2 + kstep; const char* b3 = b2 + kstep;
      PG8_LDB(B0, 0, 0); PG8_LDB(B1, 0, 1); PG8_SCHED; PG8_LDA(At, 0, 0); PG8_STAGE(PG8_SA(1, 1), a1 + hstep);
      PG8_WAIT_V(8); PG8_WAIT_L(0); PG8_BAR; PG8_MMA(0, 0, At, B0); PG8_MMA(0, 1, At, B1); PG8_BAR; PG8_SCHED;
      PG8_LDA(At, 0, 1); PG8_STAGE(PG8_SB(0, 0), b2); PG8_STAGE(PG8_SB(0, 1), b2 + hstep); PG8_STAGE(PG8_SA(0, 0), a2);
      PG8_WAIT_V(8); PG8_WAIT_L(0); PG8_BAR; PG8_MMA(1, 0, At, B0); PG8_MMA(1, 1, At, B1); PG8_BAR; PG8_SCHED;
      PG8_LDB(B0, 1, 0); PG8_LDB(B1, 1, 1); PG8_SCHED; PG8_LDA(At, 1, 0); PG8_STAGE(PG8_SA(0, 1), a2 + hstep);
      PG8_WAIT_V(8); PG8_WAIT_L(0); PG8_BAR; PG8_MMA(0, 0, At, B0); PG8_MMA(0, 1, At, B1); PG8_BAR; PG8_SCHED;
      PG8_LDA(At, 1, 1); PG8_STAGE(PG8_SB(1, 0), b3); PG8_STAGE(PG8_SB(1, 1), b3 + hstep); PG8_STAGE(PG8_SA(1, 0), a3);
      PG8_WAIT_V(8); PG8_WAIT_L(0); PG8_BAR; PG8_MMA(1, 0, At, B0); PG8_MMA(1, 1, At, B1); PG8_BAR; PG8_SCHED;
    }
    if (wr == 0) PG8_BAR;
    {
      const int tid_e = otid(wv);
      const int wid_e = __builtin_amdgcn_readfirstlane(tid_e >> 6), lane_e = tid_e & 63;
      const int wr_e = wid_e >> 2, wc_e = wid_e & 3, fr_e = lane_e & 15, fq_e = lane_e >> 4;
      if (e.kind == EPI_EVEN) epi_even(acc, cur, wr_e, wc_e, fr_e, fq_e, e);
      else if (e.kind == EPI_GLA) epi_gla(acc, cur, wr_e, wc_e, fr_e, fq_e, e);
      else if (e.kind == EPI_RES) epi_res(acc, cur, wr_e, wc_e, fr_e, fq_e, e);
      else epi_ffn1(acc, cur, wr_e, wc_e, fr_e, fq_e, e);
    }
    if (!has_next) break;
    cur = nxt; cA = nA; cB = nB; ++ui;
    { const int tid_i = otid(wv); const int wid_i = __builtin_amdgcn_readfirstlane(tid_i >> 6), lane_i = tid_i & 63;
      acc_init(acc, cur, wid_i >> 2, wid_i & 3, lane_i & 15, lane_i >> 4, e); }
    if (wr == 1) PG8_BAR;
  }
  PG8_WAIT_V(0);
  PG8_BAR;
#undef PG8_SA
#undef PG8_SB
#undef PG8_STAGE
#undef PG8_LDA
#undef PG8_LDB
#undef PG8_MMA
}

DEVI void ln_phase(float* X, bf16_t* XB, const float* g, const float* bt, bool final_out, int wv) {
  const int tidl = otid(wv); const int w = tidl >> 6, lane = tidl & 63;
  const int stride = gridDim.x * 8;
  int row = blockIdx.x * 8 + w;
  f32x4 v[4], vn[4];
  if (row < NTOK) {
#pragma unroll
    for (int i = 0; i < 4; ++i) v[i] = *(const f32x4*)(X + (size_t)row * 1024 + i * 256 + lane * 4);
  }
  for (; row < NTOK; row += stride) {
    float* xr = X + (size_t)row * 1024;
    if (row + stride < NTOK) {
#pragma unroll
      for (int i = 0; i < 4; ++i) vn[i] = *(const f32x4*)(X + (size_t)(row + stride) * 1024 + i * 256 + lane * 4);
    }
    float s = 0.f;
#pragma unroll
    for (int i = 0; i < 4; ++i) s += (v[i][0] + v[i][1]) + (v[i][2] + v[i][3]);
    s = sum64(s);
    const float mu = s * (1.f / 1024.f);
    float q = 0.f;
#pragma unroll
    for (int i = 0; i < 4; ++i) { const f32x4 d = v[i] - mu; q += (d[0] * d[0] + d[1] * d[1]) + (d[2] * d[2] + d[3] * d[3]); }
    q = sum64(q);
    const float rstd = rsqrtf(q * (1.f / 1024.f) + 1e-5f);
#pragma unroll
    for (int i = 0; i < 4; ++i) {
      const int c = i * 256 + lane * 4;
      const f32x4 gg = *(const f32x4*)(g + c), bb = *(const f32x4*)(bt + c);
      const f32x4 y = (v[i] - mu) * rstd * gg + bb;
      if (final_out) *(f32x4*)(xr + c) = y;
      else { u32x2 pkd = {pk_bf16(y[0], y[1]), pk_bf16(y[2], y[3])}; *(u32x2*)(XB + (size_t)row * 1024 + c) = pkd; }
    }
#pragma unroll
    for (int i = 0; i < 4; ++i) v[i] = vn[i];
  }
}

DEVI void ln_bf16_phase(const bf16_t* Y, bf16_t* XN, const float* g, const float* bt, int wv) {
  const int tidl = otid(wv); const int w = tidl >> 6, lane = tidl & 63;
  const int stride = gridDim.x * 8;
  int row = blockIdx.x * 8 + w;
  u32x4 ra = {}, rb = {}, na = {}, nb = {};
  if (row < NTOK) { ra = *(const u32x4*)(Y + (size_t)row * 1024 + lane * 8); rb = *(const u32x4*)(Y + (size_t)row * 1024 + 512 + lane * 8); }
  for (; row < NTOK; row += stride, ra = na, rb = nb) {
    if (row + stride < NTOK) { na = *(const u32x4*)(Y + (size_t)(row + stride) * 1024 + lane * 8); nb = *(const u32x4*)(Y + (size_t)(row + stride) * 1024 + 512 + lane * 8); }
    float v[16];
#pragma unroll
    for (int i = 0; i < 4; ++i) { v[2 * i] = bflo(ra[i]); v[2 * i + 1] = bfhi(ra[i]); v[8 + 2 * i] = bflo(rb[i]); v[8 + 2 * i + 1] = bfhi(rb[i]); }
    float sacc = 0.f;
#pragma unroll
    for (int i = 0; i < 16; ++i) sacc += v[i];
    sacc = sum64(sacc);
    const float mu = sacc * (1.f / 1024.f);
    float q = 0.f;
#pragma unroll
    for (int i = 0; i < 16; ++i) { const float d = v[i] - mu; q += d * d; }
    q = sum64(q);
    const float rstd = rsqrtf(q * (1.f / 1024.f) + 1e-5f);
#pragma unroll
    for (int hf = 0; hf < 2; ++hf) {
      const int c = hf * 512 + lane * 8;
      const f32x4 g0 = *(const f32x4*)(g + c), g1 = *(const f32x4*)(g + c + 4), b0 = *(const f32x4*)(bt + c), b1 = *(const f32x4*)(bt + c + 4);
      float y[8];
#pragma unroll
      for (int i = 0; i < 4; ++i) { y[i] = (v[hf * 8 + i] - mu) * rstd * g0[i] + b0[i]; y[4 + i] = (v[hf * 8 + 4 + i] - mu) * rstd * g1[i] + b1[i]; }
      u32x4 o = {pk_bf16(y[0], y[1]), pk_bf16(y[2], y[3]), pk_bf16(y[4], y[5]), pk_bf16(y[6], y[7])};
      *(u32x4*)(XN + (size_t)row * 1024 + c) = o;
    }
  }
}

constexpr int AT_BUF = 34816;
struct TileRegs { u32x4 k0, k1, v0, v1; };
DEVI void at_gload(TileRegs& r, const bf16_t* Kbase, const bf16_t* VTbase, int key0, int t) {
  r.k0 = *(const u32x4*)(Kbase + (size_t)(key0 + (t >> 4)) * 3072 + (t & 15) * 8);
  r.k1 = *(const u32x4*)(Kbase + (size_t)(key0 + 32 + (t >> 4)) * 3072 + (t & 15) * 8);
  r.v0 = *(const u32x4*)(VTbase + (size_t)(t >> 3) * 8192 + key0 + (t & 7) * 8);
  r.v1 = *(const u32x4*)(VTbase + (size_t)(64 + (t >> 3)) * 8192 + key0 + (t & 7) * 8);
}
DEVI void at_lstore(const TileRegs& r, unsigned char* buf, int t) {
  *(u32x4*)(buf + (t >> 4) * 272 + (t & 15) * 16) = r.k0;
  *(u32x4*)(buf + (32 + (t >> 4)) * 272 + (t & 15) * 16) = r.k1;
  unsigned char* vb = buf + 17408;
  u32x2* p0 = (u32x2*)(vb + (t >> 3) * 136 + (t & 7) * 16);
  u32x2 a = {r.v0[0], r.v0[1]}, b = {r.v0[2], r.v0[3]}; p0[0] = a; p0[1] = b;
  u32x2* p1 = (u32x2*)(vb + (64 + (t >> 3)) * 136 + (t & 7) * 16);
  u32x2 c = {r.v1[0], r.v1[1]}, d = {r.v1[2], r.v1[3]}; p1[0] = c; p1[1] = d;
}

template <int MODE>
DEVI void attn_item(const bf16_t* H, const bf16_t* vT, const float* kmsum, bf16_t* AO, int b, int hh, int qi,
                    float lam_full, float one_m_linit, const float* subln, int wv) {
  constexpr int NKS = MODE ? 8 : 4;
  unsigned char* lds = g_lds;
  const int tid = otid(wv), w = tid >> 6, lane = tid & 63, r = lane & 31, h = lane >> 5;
  const int map = MODE ? 0 : (w & 1);
  const int q0 = MODE ? qi * 256 + w * 32 : qi * 128 + (w >> 1) * 32;
  const int ntiles = MODE ? 4 * (qi + 1) : 2 * qi + 2;
  const size_t tokbase = (size_t)b * 8192;
#ifdef MOBA_ON_DIFF
  const int qcol = MODE ? hh * 128 : hh * 128 + map * 64;
  const int kcol = 512 + hh * 128;
#else
  const int qcol = MODE ? 1536 + hh * 128 : hh * 128 + map * 64;
  const int kcol = MODE ? 2048 + hh * 128 : 512 + hh * 128;
#endif
  const bf16_t* Kbase = H + tokbase * 3072 + kcol;
  const bf16_t* VTbase = vT + (size_t)(b * 512 + hh * 128) * 8192;
  const float cs = (MODE ? 0.08838834764831845f : 0.125f) * 1.4426950408889634f;
  const int kboff = MODE ? 0 : map * 128;

  bf16x8 qf[NKS];
  { const bf16_t* qp = H + (tokbase + q0 + r) * 3072 + qcol + 8 * h;
#pragma unroll
    for (int ks = 0; ks < NKS; ++ks) qf[ks] = *(const bf16x8*)(qp + 16 * ks); }

  unsigned sel = 0;
  if (MODE) {
    f32x16 gt = {};
    const float* kmp = kmsum + (size_t)(b * 32 + r) * 512 + hh * 128 + 8 * h;
    f32x4 kma[8], kmc[8];
#pragma unroll
    for (int ks = 0; ks < 8; ++ks) { kma[ks] = *(const f32x4*)(kmp + 16 * ks); kmc[ks] = *(const f32x4*)(kmp + 16 * ks + 4); }
#pragma unroll
    for (int ks = 0; ks < 8; ++ks) {
      const f32x4 a = kma[ks] * (1.f / 256.f), c = kmc[ks] * (1.f / 256.f);
      gt = mfma32(mk8(pk_bf16(a[0], a[1]), pk_bf16(a[2], a[3]), pk_bf16(c[0], c[1]), pk_bf16(c[2], c[3])), qf[ks < NKS ? ks : 0], gt);
    }
    float gv[16];
#pragma unroll
    for (int rg = 0; rg < 16; ++rg) { const int blk = (rg & 3) + 8 * (rg >> 2) + 4 * h; gv[rg] = (blk < qi) ? gt[rg] : NEG_INF; }
#pragma unroll
    for (int round = 0; round < 3; ++round) {
      float best = NEG_INF; int bi = 99;
#pragma unroll
      for (int rg = 0; rg < 16; ++rg) { const int blk = (rg & 3) + 8 * (rg >> 2) + 4 * h; if (gv[rg] > best) { best = gv[rg]; bi = blk; } }
      float b_lo, b_hi; int i_lo, i_hi; halves(best, b_lo, b_hi); halves_i(bi, i_lo, i_hi);
      const bool lowin = (b_lo > b_hi) || (b_lo == b_hi && i_lo < i_hi);
      const float wval = lowin ? b_lo : b_hi; const int wi = lowin ? i_lo : i_hi;
      if (wval > NEG_INF) sel |= 1u << wi;
#pragma unroll
      for (int rg = 0; rg < 16; ++rg) { const int blk = (rg & 3) + 8 * (rg >> 2) + 4 * h; if (blk == wi) gv[rg] = NEG_INF; }
    }
  }

#ifdef SELFIX
  if (MODE) sel = (qi >= 3) ? 7u : ((1u << qi) - 1u);
#endif
  f32x16 o[4] = {};
  float m = NEG_INF, l = 0.f;
  TileRegs tr;
  at_gload(tr, Kbase, VTbase, 0, tid); at_lstore(tr, lds, tid); __syncthreads();
#pragma unroll 1
  for (int tt = 0; tt < ntiles; ++tt) {
    const unsigned char* buf = lds + (tt & 1) * AT_BUF;
    const int key0 = tt * 64;
    if (tt + 1 < ntiles) at_gload(tr, Kbase, VTbase, key0 + 64, tid);
    bool active, needmask, lanesel = true;
    if (MODE && (tt >> 2) < qi) { lanesel = (sel >> (tt >> 2)) & 1u; active = __any(lanesel ? 1 : 0) != 0; needmask = false; }
    else { active = key0 <= q0 + 31; needmask = key0 + 63 > q0; }
    if (active) {
      f32x16 st[2];
      {
        bf16x8 kfa[NKS], kfb[NKS];
        const unsigned char* kp0 = buf + r * 272 + kboff + h * 16;
#pragma unroll
        for (int ks = 0; ks < NKS; ++ks) kfa[ks] = *(const bf16x8*)(kp0 + ks * 32);
#pragma unroll
        for (int ks = 0; ks < NKS; ++ks) kfb[ks] = *(const bf16x8*)(kp0 + 32 * 272 + ks * 32);
        __builtin_amdgcn_sched_barrier(0);
        f32x16 a0 = {}, a1 = {};
#pragma unroll
        for (int ks = 0; ks < NKS; ++ks) a0 = mfma32(kfa[ks], qf[ks], a0);
#pragma unroll
        for (int ks = 0; ks < NKS; ++ks) a1 = mfma32(kfb[ks], qf[ks], a1);
        st[0] = a0; st[1] = a1;
      }
      if (needmask) {
#pragma unroll
        for (int T = 0; T < 2; ++T)
#pragma unroll
          for (int rg = 0; rg < 16; ++rg) { const int key = key0 + 32 * T + 8 * (rg >> 2) + 4 * h + (rg & 3); if (key > q0 + r) st[T][rg] = NEG_INF; }
      }
      float mxr = NEG_INF;
#pragma unroll
      for (int T = 0; T < 2; ++T)
#pragma unroll
        for (int rg = 0; rg < 16; ++rg) mxr = fmaxf(mxr, st[T][rg]);
      mxr = hmax(mxr);
      const float mxs = lanesel ? mxr * cs : NEG_INF;
      if (__any((mxs > m + 8.0f) ? 1 : 0)) {
        const float mn = fmaxf(m, mxs);
        const float mu2 = (mn == NEG_INF) ? 0.f : mn;
        const float alpha = ex2(m - mu2);
        m = mn;
        l *= alpha;
#pragma unroll
        for (int dt = 0; dt < 4; ++dt) o[dt] = o[dt] * alpha;
      }
      const float nb = lanesel ? ((m == NEG_INF) ? 0.f : -m) : NEG_INF;
      float ps = 0.f;
#pragma unroll
      for (int T = 0; T < 2; ++T)
#pragma unroll
        for (int rg = 0; rg < 16; ++rg) { const float pv = ex2(fmaf(st[T][rg], cs, nb)); st[T][rg] = pv; ps += pv; }
      l += ps;
      {
        const unsigned char* vb0 = buf + 17408 + r * 136 + 8 * h;
        u32x2 vlo[2][4], vhi[2][4];
#pragma unroll
        for (int dt = 0; dt < 4; ++dt) { const unsigned char* vp = vb0 + dt * 32 * 136; vlo[0][dt] = *(const u32x2*)vp; vhi[0][dt] = *(const u32x2*)(vp + 16); }
#pragma unroll
        for (int step = 0; step < 4; ++step) {
          const int T = step >> 1, sx = step & 1;
          if (step < 3) {
#pragma unroll
            for (int dt = 0; dt < 4; ++dt) { const unsigned char* vp = vb0 + dt * 32 * 136 + (step + 1) * 32; vlo[(step + 1) & 1][dt] = *(const u32x2*)vp; vhi[(step + 1) & 1][dt] = *(const u32x2*)(vp + 16); }
          }
          const bf16x8 pb = pack8(st[T], sx);
#pragma unroll
          for (int dt = 0; dt < 4; ++dt) o[dt] = mfma32(mk8(vlo[step & 1][dt][0], vlo[step & 1][dt][1], vhi[step & 1][dt][0], vhi[step & 1][dt][1]), pb, o[dt]);
          __builtin_amdgcn_sched_barrier(0);
        }
      }
    }
    if (tt + 1 < ntiles) at_lstore(tr, lds + ((tt + 1) & 1) * AT_BUF, tid);
    __syncthreads();
  }
  const float lt = hsum(l);
  const float il = 1.f / lt;
  const size_t token = tokbase + q0 + r;
  if (MODE) {
#pragma unroll
    for (int dt = 0; dt < 4; ++dt)
#pragma unroll
      for (int g = 0; g < 4; ++g) {
        const int dv = 32 * dt + 8 * g + 4 * h;
        u32x2 pkd = {pk_bf16(o[dt][4 * g] * il, o[dt][4 * g + 1] * il), pk_bf16(o[dt][4 * g + 2] * il, o[dt][4 * g + 3] * il)};
        *(u32x2*)(AO + token * 1024 + 512 + hh * 128 + dv) = pkd;
      }
  } else {
    float* ex = (float*)lds;
    const int rgp = w >> 1;
    if (map == 1) {
      const float f = il * lam_full;
#pragma unroll
      for (int dt = 0; dt < 4; ++dt)
#pragma unroll
        for (int rg = 0; rg < 16; ++rg) ex[((rgp * 4 + dt) * 16 + rg) * 64 + lane] = o[dt][rg] * f;
    }
    __syncthreads();
    if (map == 0) {
      float ss = 0.f;
#pragma unroll
      for (int dt = 0; dt < 4; ++dt)
#pragma unroll
        for (int rg = 0; rg < 16; ++rg) { const float d = o[dt][rg] * il - ex[((rgp * 4 + dt) * 16 + rg) * 64 + lane]; o[dt][rg] = d; ss += d * d; }
      ss = hsum(ss);
      const float rinv = rsqrtf(ss * (1.f / 128.f) + 1e-5f) * one_m_linit;
#pragma unroll
      for (int dt = 0; dt < 4; ++dt)
#pragma unroll
        for (int g = 0; g < 4; ++g) {
          const int dv = 32 * dt + 8 * g + 4 * h;
          const f32x4 sl = *(const f32x4*)(lds + 130048 + dv * 4);
          u32x2 pkd = {pk_bf16(o[dt][4 * g] * rinv * sl[0], o[dt][4 * g + 1] * rinv * sl[1]), pk_bf16(o[dt][4 * g + 2] * rinv * sl[2], o[dt][4 * g + 3] * rinv * sl[3])};
          *(u32x2*)(AO + token * 1024 + hh * 128 + dv) = pkd;
        }
    }
    __syncthreads();
  }
}

#ifndef AM
#define AM 3
#endif
DEVI void attn_phase(const Params& p, int e, int wv) {
  asm volatile("" : "+s"(e));
  unsigned char* ws = p.ws;
  const bf16_t* H = (const bf16_t*)(ws + WS_OV + OV_H);
  const bf16_t* dvT = (const bf16_t*)(ws + WS_OV + OV_DVT);
  const bf16_t* mvT = (const bf16_t*)(ws + WS_OV + OV_MVT);
  const float* kmsum = (const float*)(ws + WS_KM) + (size_t)e * 65536;
  bf16_t* AO = (bf16_t*)(ws + WS_AO);
  const float* lam = p.in[2] + e * 256;
  float s1 = 0.f, s2 = 0.f;
  for (int i = 0; i < 64; ++i) { s1 += lam[i] * lam[64 + i]; s2 += lam[128 + i] * lam[192 + i]; }
  const float linit = (e == 0) ? 0.2f : 0.47071301834358413f;
  const float lam_full = __expf(s1) - __expf(s2) + linit;
  const float* subln = p.in[3] + e * 128;
  { const int t0 = otid(wv); if (t0 < 128) ((float*)(g_lds + 130048))[t0] = subln[t0]; __syncthreads(); }
  const int vb = (gridDim.x == 256) ? (int)((blockIdx.x & 7) * 32 + (blockIdx.x >> 3)) : (int)blockIdx.x;
#pragma unroll 1
  for (int u = vb; u < 768; u += gridDim.x) {
    if (u < 512) {
      if (!(AM & 1)) continue;
      const int pidx = (u & 255) * 2 + (u >> 8); const int bh = pidx >> 5, ip = pidx & 31;
      attn_item<0>(H, dvT, kmsum, AO, bh >> 2, bh & 3, 63 - ip, lam_full, 1.f - linit, subln, wv);
      attn_item<0>(H, dvT, kmsum, AO, bh >> 2, bh & 3, ip, lam_full, 1.f - linit, subln, wv);
    } else {
      if (!(AM & 2)) continue;
      const int pp = u - 512, bh = pp >> 4, jp = pp & 15;
#ifdef MOBA_ON_DIFF
#define MVT_SRC dvT
#else
#define MVT_SRC mvT
#endif
      attn_item<1>(H, MVT_SRC, kmsum, AO, bh >> 2, bh & 3, 31 - jp, lam_full, 1.f - linit, subln, wv);
      attn_item<1>(H, MVT_SRC, kmsum, AO, bh >> 2, bh & 3, jp, lam_full, 1.f - linit, subln, wv);
    }
  }
}

DEVI void gla_prep_item(int item, const bf16_t* XB, const bf16_t* WgdT, const float* Wup, const float* bgate,
                        bf16_t* Hg, bf16_t* kT, float* decay, const float* stat_in, const float* ugd, const float* vgd, int wv) {
  const int tid = otid(wv), w = tid >> 6, lane = tid & 63;
  const int b = item >> 7, ch = item & 127;
  const size_t tok0 = (size_t)b * 8192 + ch * 64;
  float* gd = (float*)g_lds;
  if (w < 4) {
    const int fr = lane & 15, fq = lane >> 4;
    f32x4 acc = {};
    const bf16_t* ap = XB + (tok0 + 16 * w + fr) * 1024 + 8 * fq;
    const bf16_t* bp = WgdT + fr * 1024 + 8 * fq;
#pragma unroll 4
    for (int ks = 0; ks < 32; ++ks) acc = mfma16(*(const bf16x8*)(ap + 32 * ks), *(const bf16x8*)(bp + 32 * ks), acc);
    const float ug = ugd[fr], vg = vgd[fr];
#pragma unroll
    for (int j = 0; j < 4; ++j) {
      float mu, rstd; row_mu_rstd(stat_in, (int)tok0 + 16 * w + 4 * fq + j, mu, rstd);
      gd[(16 * w + 4 * fq + j) * 16 + fr] = rstd * (acc[j] - mu * ug) + vg;
    }
  }
  __syncthreads();
  const int c = tid;
  float wup[16];
#pragma unroll
  for (int rr = 0; rr < 16; ++rr) wup[rr] = Wup[rr * 512 + c];
  const float bias = bgate[c];
  float bsum = 0.f;
  bf16_t* qp = Hg + tok0 * 2048 + c;
  bf16_t* kp = qp + 512;
  bf16_t* ktp = kT + (size_t)(b * 512 + c) * 8192 + ch * 64;
  bf16_t qv[8], kv[8], qn[8], kn[8];
#pragma unroll
  for (int tt = 0; tt < 8; ++tt) { qv[tt] = qp[(size_t)tt * 2048]; kv[tt] = kp[(size_t)tt * 2048]; }
#pragma unroll 1
  for (int t8 = 0; t8 < 8; ++t8) {
    if (t8 < 7) {
#pragma unroll
      for (int tt = 0; tt < 8; ++tt) { qn[tt] = qp[(size_t)((t8 + 1) * 8 + tt) * 2048]; kn[tt] = kp[(size_t)((t8 + 1) * 8 + tt) * 2048]; }
    }
    unsigned short kb[8];
#pragma unroll
    for (int tt = 0; tt < 8; ++tt) {
      const int t = t8 * 8 + tt;
      const f32x4* g4 = (const f32x4*)(gd + t * 16);
      float z = bias;
#pragma unroll
      for (int i = 0; i < 4; ++i) { const f32x4 gg = g4[i]; z += gg[0] * wup[4 * i] + gg[1] * wup[4 * i + 1] + gg[2] * wup[4 * i + 2] + gg[3] * wup[4 * i + 3]; }
      const float ls = fminf(z, 0.f) - __logf(1.f + __expf(-fabsf(z)));
      bsum += ls * 0.0625f;
      const float eb = __expf(bsum), en = __expf(-bsum);
      const float q = bf2f(qv[tt]), k = bf2f(kv[tt]);
      qp[(size_t)t * 2048] = f2bf(q * eb * 0.08838834764831845f);
      const bf16_t kk = f2bf(k * en);
      kp[(size_t)t * 2048] = kk;
      kb[tt] = kk;
    }
    u32x4 pk = {(unsigned)kb[0] | ((unsigned)kb[1] << 16), (unsigned)kb[2] | ((unsigned)kb[3] << 16),
                (unsigned)kb[4] | ((unsigned)kb[5] << 16), (unsigned)kb[6] | ((unsigned)kb[7] << 16)};
    *(u32x4*)(ktp + t8 * 8) = pk;
#pragma unroll
    for (int tt = 0; tt < 8; ++tt) { qv[tt] = qn[tt]; kv[tt] = kn[tt]; }
  }
  decay[(size_t)(b * 128 + ch) * 512 + c] = __expf(bsum);
  __syncthreads();
}

constexpr int GL_Q = 0, GL_K = 17408, GL_KT = 34816, GL_BUF = 53248, GL_RED = 2 * GL_BUF;

template <int PASS>
DEVI void gla_scan_item(int item, const bf16_t* Hg, const bf16_t* vT, const bf16_t* kT, const float* decay,
                        float* Ubuf, float* Dseg, bf16_t* AO, const float* normg, int wv) {
  const int tid = otid(wv), w = tid >> 6, lane = tid & 63, r = lane & 31, h = lane >> 5;
  const int bh = item >> 4, seg = item & 15, b = bh >> 2, hd = bh & 3;
  unsigned char* lds = g_lds;
  const bf16_t* hq = Hg + ((size_t)b * 8192 + seg * 512 + (tid >> 4)) * 2048 + hd * 128 + (tid & 15) * 8;
  const bf16_t* kts = kT + (size_t)(b * 512 + hd * 128 + (tid >> 3)) * 8192 + seg * 512 + (tid & 7) * 8;
  u32x4 rq0, rq1, rk0, rk1, rt0, rt1;
#define GL_GLOAD(cc) do { \
    if (PASS == 1) { const bf16_t* _p = hq + (size_t)(cc) * 64 * 2048; rq0 = *(const u32x4*)_p; rq1 = *(const u32x4*)(_p + 32 * 2048); \
                     rk0 = *(const u32x4*)(_p + 512); rk1 = *(const u32x4*)(_p + 32 * 2048 + 512); } \
    rt0 = *(const u32x4*)(kts + (cc) * 64); rt1 = *(const u32x4*)(kts + (size_t)64 * 8192 + (cc) * 64); } while (0)
#define GL_LSTORE(bufp) do { \
    if (PASS == 1) { unsigned char* _q = (bufp) + GL_Q + (tid >> 4) * 272 + (tid & 15) * 16; *(u32x4*)_q = rq0; *(u32x4*)(_q + 32 * 272) = rq1; \
                     *(u32x4*)(_q + GL_K) = rk0; *(u32x4*)(_q + GL_K + 32 * 272) = rk1; } \
    unsigned char* _t = (bufp) + GL_KT + (tid >> 3) * 144 + (tid & 7) * 16; *(u32x4*)_t = rt0; *(u32x4*)(_t + 64 * 144) = rt1; } while (0)
  GL_GLOAD(0);
  f32x16 S[4] = {};
  if (PASS == 1) {
#pragma unroll 1
    for (int js = 0; js < seg; ++js) {
      const int it2 = bh * 16 + js;
      const float* up = Ubuf + ((size_t)(it2 * 8 + w) * 4) * 1024 + lane;
      const float* dp = Dseg + it2 * 128 + 4 * h;
#pragma unroll
      for (int dkt = 0; dkt < 4; ++dkt)
#pragma unroll
        for (int g = 0; g < 4; ++g) {
          const f32x4 d4 = *(const f32x4*)(dp + 32 * dkt + 8 * g);
#pragma unroll
          for (int i = 0; i < 4; ++i) S[dkt][4 * g + i] = S[dkt][4 * g + i] * d4[i] + up[(dkt * 16 + 4 * g + i) * 64];
        }
    }
  }
  GL_LSTORE(lds);
  __syncthreads();
  const bf16_t* vrow = vT + (size_t)(b * 1024 + hd * 256 + 32 * w + r) * 8192;
#pragma unroll 1
  for (int cc = 0; cc < 8; ++cc) {
    const int ch = seg * 8 + cc, tc0 = ch * 64;
    const size_t tokabs0 = (size_t)b * 8192 + tc0;
    const unsigned char* buf = lds + (cc & 1) * GL_BUF;
    if (cc + 1 < 8) GL_GLOAD(cc + 1);
    bf16x8 vnat[4];
#pragma unroll
    for (int ks = 0; ks < 4; ++ks) vnat[ks] = *(const bf16x8*)(vrow + tc0 + 16 * ks + 8 * h);
    f32x16 o0 = {}, o1 = {};
    if (PASS == 1) {
      f32x16 X00 = {}, X01 = {}, X11 = {};
      { const unsigned char* qL = buf + GL_Q + r * 272 + h * 16; const unsigned char* kL = buf + GL_K + r * 272 + h * 16;
#pragma unroll
        for (int ks = 0; ks < 8; ++ks) {
          const bf16x8 k0 = *(const bf16x8*)(kL + ks * 32), k1 = *(const bf16x8*)(kL + 32 * 272 + ks * 32);
          const bf16x8 q0 = *(const bf16x8*)(qL + ks * 32), q1 = *(const bf16x8*)(qL + 32 * 272 + ks * 32);
          X00 = mfma32(k0, q0, X00); X01 = mfma32(k0, q1, X01); X11 = mfma32(k1, q1, X11);
        } }
      u32x2 vpa[4], vpb[4];
      { const bf16_t* vp = vrow + tc0 + 4 * h;
#pragma unroll
        for (int q = 0; q < 4; ++q) { vpa[q] = *(const u32x2*)(vp + 16 * q); vpb[q] = *(const u32x2*)(vp + 16 * q + 8); } }
#pragma unroll
      for (int rg = 0; rg < 16; ++rg) { const int j = (rg & 3) + 8 * (rg >> 2) + 4 * h; if (r < j) { X00[rg] = 0.f; X11[rg] = 0.f; } }
      { const unsigned char* qP = buf + GL_Q + r * 272 + 8 * h;
#pragma unroll
        for (int dkt = 0; dkt < 4; ++dkt)
#pragma unroll
          for (int sx = 0; sx < 2; ++sx) {
            const bf16x8 sa = pack8(S[dkt], sx);
            const unsigned char* qq = qP + (32 * dkt + 16 * sx) * 2;
            const u32x2 a0 = *(const u32x2*)qq, a1 = *(const u32x2*)(qq + 16);
            const u32x2 c0 = *(const u32x2*)(qq + 32 * 272), c1 = *(const u32x2*)(qq + 32 * 272 + 16);
            o0 = mfma32(sa, mk8(a0[0], a0[1], a1[0], a1[1]), o0);
            o1 = mfma32(sa, mk8(c0[0], c0[1], c1[0], c1[1]), o1);
          } }
#pragma unroll
      for (int sx = 0; sx < 2; ++sx) {
        const bf16x8 v0 = mk8(vpa[sx][0], vpa[sx][1], vpb[sx][0], vpb[sx][1]), v1 = mk8(vpa[2 + sx][0], vpa[2 + sx][1], vpb[2 + sx][0], vpb[2 + sx][1]);
        o0 = mfma32(v0, pack8(X00, sx), o0);
        o1 = mfma32(v0, pack8(X01, sx), o1);
        o1 = mfma32(v1, pack8(X11, sx), o1);
      }
      float ss0 = 0.f, ss1 = 0.f;
#pragma unroll
      for (int rg = 0; rg < 16; ++rg) { ss0 += o0[rg] * o0[rg]; ss1 += o1[rg] * o1[rg]; }
      ss0 = hsum(ss0); ss1 = hsum(ss1);
      float* red = (float*)(lds + GL_RED) + (cc & 1) * 512;
      if (h == 0) { red[w * 64 + r] = ss0; red[w * 64 + 32 + r] = ss1; }
    }
    { const unsigned char* ktL = buf + GL_KT + r * 144 + h * 16;
#pragma unroll
      for (int ks = 0; ks < 4; ++ks)
#pragma unroll
        for (int dkt = 0; dkt < 4; ++dkt) S[dkt] = mfma32(*(const bf16x8*)(ktL + dkt * 32 * 144 + ks * 32), vnat[ks], S[dkt]); }
    { const float* dcp = decay + (size_t)(b * 128 + ch) * 512 + hd * 128 + 4 * h;
#pragma unroll
      for (int dkt = 0; dkt < 4; ++dkt)
#pragma unroll
        for (int g = 0; g < 4; ++g) {
          const f32x4 d4 = *(const f32x4*)(dcp + 32 * dkt + 8 * g);
#pragma unroll
          for (int i = 0; i < 4; ++i) S[dkt][4 * g + i] *= d4[i];
        } }
    if (cc + 1 < 8) GL_LSTORE(lds + ((cc + 1) & 1) * GL_BUF);
    __syncthreads();
    if (PASS == 1) {
      const float* red = (const float*)(lds + GL_RED) + (cc & 1) * 512;
      float t0 = 0.f, t1 = 0.f;
#pragma unroll
      for (int ww = 0; ww < 8; ++ww) { t0 += red[ww * 64 + r]; t1 += red[ww * 64 + 32 + r]; }
      const float ri0 = rsqrtf(t0 * (1.f / 256.f) + 1e-5f), ri1 = rsqrtf(t1 * (1.f / 256.f) + 1e-5f);
      u32x2 r4s[2][4]; f32x4 gns[4];
#pragma unroll
      for (int g = 0; g < 4; ++g) {
        gns[g] = *(const f32x4*)(normg + 32 * w + 8 * g + 4 * h);
#pragma unroll
        for (int it = 0; it < 2; ++it) r4s[it][g] = *(const u32x2*)(Hg + (tokabs0 + 32 * it + r) * 2048 + 1024 + hd * 256 + 32 * w + 8 * g + 4 * h);
      }
#pragma unroll
      for (int it = 0; it < 2; ++it)
#pragma unroll
        for (int g = 0; g < 4; ++g) {
          const int dv0 = 32 * w + 8 * g + 4 * h;
          const size_t tok = tokabs0 + 32 * it + r;
          const u32x2 r4 = r4s[it][g];
          const f32x4 gn = gns[g];
          const float rv[4] = {bflo(r4[0]), bfhi(r4[0]), bflo(r4[1]), bfhi(r4[1])};
          float ov[4];
#pragma unroll
          for (int i = 0; i < 4; ++i) {
            const float oo = it ? o1[4 * g + i] : o0[4 * g + i];
            const float sg = rv[i] / (1.f + __expf(-rv[i]));
            ov[i] = oo * (it ? ri1 : ri0) * gn[i] * sg;
          }
          u32x2 pkd = {pk_bf16(ov[0], ov[1]), pk_bf16(ov[2], ov[3])};
          *(u32x2*)(AO + tok * 1024 + hd * 256 + dv0) = pkd;
        }
    }
  }
#undef GL_GLOAD
#undef GL_LSTORE
  if (PASS == 0) {
    float* up = Ubuf + ((size_t)(item * 8 + w) * 4) * 1024 + lane;
#pragma unroll
    for (int dkt = 0; dkt < 4; ++dkt)
#pragma unroll
      for (int rg = 0; rg < 16; ++rg) up[(dkt * 16 + rg) * 64] = S[dkt][rg];
    if (tid < 128) {
      float dv8[8];
#pragma unroll
      for (int cc = 0; cc < 8; ++cc) dv8[cc] = decay[(size_t)(b * 128 + seg * 8 + cc) * 512 + hd * 128 + tid];
      float d = 1.f;
#pragma unroll
      for (int cc = 0; cc < 8; ++cc) d *= dv8[cc];
      Dseg[item * 128 + tid] = d;
    }
  }
  __syncthreads();
}

#define XB_TMO      128
#define XB_XCNT(j)  (256  + 64 * (j))
#define XB_XSUB(j)  (1280 + 64 * (j))
#define XB_XGEN(j)  (2304 + 64 * (j))
#define XB_TOP      3328
#define XB_TOPGEN   3392
#define XCD_BAR_WORDS 3456
#define XB_SPIN_CAP (1u << 20)
DEVI unsigned xb_ld(unsigned* p)              { return __hip_atomic_load(p, __ATOMIC_RELAXED, __HIP_MEMORY_SCOPE_AGENT); }
DEVI unsigned xb_add(unsigned* p, unsigned v) { return __hip_atomic_fetch_add(p, v, __ATOMIC_RELAXED, __HIP_MEMORY_SCOPE_AGENT); }
DEVI unsigned xb_xcc_id() { return (unsigned)__builtin_amdgcn_s_getreg((3 << 11) | 20) & 0xFu; }
#define XB_SPIN(cond, bar) do { unsigned _sp = 0; while (cond) { __builtin_amdgcn_s_sleep(1); \
    if ((++_sp & 255u) == 0u) { if (xb_ld(&(bar)[XB_TMO])) break; if (_sp > XB_SPIN_CAP) { atomicAdd(&(bar)[XB_TMO], 1u); break; } } } } while (0)
struct XcdBarrier { unsigned* bar; unsigned x; volatile LAS unsigned* st; };
DEVI void xcd_barrier_complete(unsigned* bar, unsigned x, unsigned& nloc, unsigned& nx) {
  const unsigned G = gridDim.x * gridDim.y * gridDim.z;
  unsigned sum, cnt, mine, sp = 0u;
  for (;;) {
    sum = 0u; cnt = 0u; mine = 0u;
#pragma unroll
    for (unsigned j = 0; j < 16; ++j) { const unsigned c = xb_ld(&bar[XB_XCNT(j)]); sum += c; cnt += (c > 0u) ? 1u : 0u; mine = (j == x) ? c : mine; }
    if (sum == G) break;
    __builtin_amdgcn_s_sleep(1);
    if ((++sp & 255u) == 0u) { if (xb_ld(&bar[XB_TMO])) break; if (sp > XB_SPIN_CAP) { atomicAdd(&bar[XB_TMO], 1u); break; } }
  }
  nloc = mine > 0u ? mine : 1u; nx = cnt > 0u ? cnt : 1u;
}
DEVI void xcd_barrier(const XcdBarrier& b, bool leader) {
  asm volatile("s_waitcnt vmcnt(0)" ::: "memory");
  __syncthreads();
  if (leader) {
    unsigned* bar = b.bar;
    __builtin_amdgcn_s_waitcnt(0);
    unsigned bx = xb_xcc_id(); asm volatile("" : "+s"(bx));
    unsigned nloc = b.st[0], nx = b.st[1];
    if (nloc == 0u) { xcd_barrier_complete(bar, bx, nloc, nx); b.st[0] = nloc; b.st[1] = nx; }
    const unsigned old = xb_add(&bar[XB_XSUB(bx)], 1u);
    const unsigned gen = old / nloc;
    if (old + 1u == (gen + 1u) * nloc) {
      __builtin_amdgcn_fence(__ATOMIC_RELEASE, "agent");
      asm volatile("s_waitcnt vmcnt(0)" ::: "memory");
      const unsigned og = xb_add(&bar[XB_TOP], 1u);
      const unsigned tg = og / nx;
      if (og + 1u == (tg + 1u) * nx) xb_add(&bar[XB_TOPGEN], 1u);
      else XB_SPIN(xb_ld(&bar[XB_TOPGEN]) == tg, bar);
      __builtin_amdgcn_fence(__ATOMIC_ACQUIRE, "agent");
      xb_add(&bar[XB_XGEN(bx)], 1u);
      asm volatile("s_waitcnt vmcnt(0)" ::: "memory");
    } else {
      XB_SPIN(xb_ld(&bar[XB_XGEN(bx)]) == gen, bar);
      __builtin_amdgcn_fence(__ATOMIC_ACQUIRE, "agent");
      asm volatile("s_waitcnt vmcnt(0)" ::: "memory");
    }
  }
  __syncthreads();
}

#define GSYNC() xcd_barrier(xb, otid(wv) == 0)
__global__ void __launch_bounds__(512, 2) mega_fwd(Params p) {
  cg::grid_group grid = cg::this_grid();
  const int wv = __builtin_amdgcn_readfirstlane((int)threadIdx.x >> 6);
  unsigned char* ws = p.ws;
  XcdBarrier xb; xb.bar = (unsigned*)(ws + WS_BAR); xb.x = xb_xcc_id(); xb.st = (volatile LAS unsigned*)((LAS unsigned char*)g_lds + 131072);
  if (threadIdx.x == 0) { xb.st[0] = 0u; xb.st[1] = 0u; (void)xb_add(&xb.bar[XB_XCNT(xb.x)], 1u); }
  grid.sync();
  bf16_t* XB = (bf16_t*)(ws + WS_XB);
  bf16_t* AO = (bf16_t*)(ws + WS_AO);
  unsigned char* OV = ws + WS_OV;

#ifndef PM
#define PM 0xff
#endif
#ifndef DUP
#define DUP 0
#endif
  if (PM & 1) prologue(p, (char*)g_lds, wv);
  GSYNC();
#if (DUP & 32)
  prologue(p, (char*)g_lds, wv);
  GSYNC();
#endif

  { const int gtid = blockIdx.x * 512 + otid(wv);
    for (int i = gtid; i < 4 * 14336; i += gridDim.x * 512) {
      const int l = i / 14336, c = i % 14336;
      if (c < 6144 && !(l & 1)) continue;
      const float* pp = (const float*)(ws + WS_UVP) + (size_t)l * 16 * 16384 + c;
      float acc = 0.f;
#pragma unroll
      for (int kt = 0; kt < 16; ++kt) acc += pp[(size_t)kt * 16384];
      ((float*)(ws + WS_UV))[(size_t)l * 16384 + c] = acc;
    } }
#pragma unroll 1
  for (int l = 0; l < 4; ++l) {
    const bf16_t* wl = (const bf16_t*)(ws + WS_WT + (size_t)l * WT_LAYER);
    const int e = l >> 1;
    const bool odd = (l & 1) != 0;
    bf16_t* Hg = (bf16_t*)(OV + OV_HG); bf16_t* vT = (bf16_t*)(OV + OV_VT); bf16_t* kT = (bf16_t*)(OV + OV_KT);
    float* Ubuf = (float*)(OV + OV_U); float* decay = (float*)(ws + WS_DEC); float* Dseg = (float*)(ws + WS_DSEG);
#pragma unroll 1
    for (int st = 0; st < 9; ++st) {
      if (!odd && (st == 2 || st == 3)) continue;
      if (st == 5 || (st == 8 && l != 3)) {
        stat_finalize((const float*)(ws + WS_STATS) + (st == 8 ? 1048576 : 0), (float*)(ws + WS_MR) + (st == 8 ? 65536 : 0), wv);
        GSYNC();
        continue;
      }
      if (st == 0 || st == 4 || st == 6 || st == 7) {
        EpiArgs ea{};
        const bf16_t* A; const bf16_t* Bt; int N, K;
        const float* uv = (const float*)(ws + WS_UV) + (size_t)l * 16384;
        float* stats = (float*)(ws + WS_STATS);
        const float* mrb = (const float*)(ws + WS_MR);
        if (st == 0) {
          A = XB; Bt = wl; N = 3072; K = 1024;
          if (odd) { ea.stat_in = mrb + 65536; ea.u = uv + UV_U_IN; ea.v = uv + UV_V_IN; }
          else if (l > 0) { ln_bf16_phase(XB, AO, p.in[14] + (l - 1) * 1024, p.in[15] + (l - 1) * 1024, wv); GSYNC(); A = AO; }
          if (odd) { ea.kind = EPI_GLA; ea.H = Hg; ea.vt0 = vT; }
          else { ea.kind = EPI_EVEN; ea.H = (bf16_t*)(OV + OV_H); ea.vt0 = (bf16_t*)(OV + OV_DVT); ea.vt1 = (bf16_t*)(OV + OV_MVT); ea.kmsum = (float*)(ws + WS_KM) + (size_t)e * 65536; }
        } else if (st == 4) {
          A = AO; Bt = wl + 3 * 1024 * 1024; N = 1024; K = 1024; ea.kind = EPI_RES; ea.Y = XB; ea.X = p.X;
          if (l > 0) { ea.stat_prev = mrb + 65536; ea.gprev = p.in[14] + (l - 1) * 1024; ea.bprev = p.in[15] + (l - 1) * 1024; }
          ea.stat_new = stats;
        } else if (st == 6) {
          A = XB; Bt = wl + 4 * 1024 * 1024; N = 4096; K = 1024; ea.kind = EPI_FFN1; ea.Hff = (bf16_t*)OV;
          ea.stat_in = mrb; ea.u = uv + UV_U_F1; ea.v = uv + UV_V_F1;
        } else {
          A = (const bf16_t*)OV; Bt = wl + 8 * 1024 * 1024; N = 1024; K = 4096; ea.kind = EPI_RES; ea.Y = XB; ea.X = p.X;
          ea.stat_prev = mrb; ea.gprev = p.in[10] + l * 1024; ea.bprev = p.in[11] + l * 1024;
          ea.stat_new = stats + 1048576; ea.final_out = (l == 3);
        }
        if (PM & 2) gemm_phase(A, Bt, N, K, ea, wv);
#if (DUP & 2)
        if (st == 6) { GSYNC(); gemm_phase(A, Bt, N, K, ea, wv); }
#endif
      } else if (st == 1) {
        if (odd) {
#pragma unroll 1
          for (int it = blockIdx.x; it < 512; it += gridDim.x)
            if (PM & 8) gla_prep_item(it, XB, (const bf16_t*)(ws + WS_WGD) + (size_t)e * 16384, p.in[6] + e * 8192, p.in[7] + e * 512, Hg, kT, decay,
                                      (const float*)(ws + WS_MR) + 65536, (const float*)(ws + WS_UV) + (size_t)l * 16384 + UV_U_GD, (const float*)(ws + WS_UV) + (size_t)l * 16384 + UV_V_GD, wv);
        } else {
          if (PM & 4) attn_phase(p, e, wv);
#if (DUP & 1)
          GSYNC(); attn_phase(p, e, wv);
#endif
        }
      } else if (st == 2) {
#pragma unroll 1
        for (int it = blockIdx.x; it < 256; it += gridDim.x) if (PM & 16) gla_scan_item<0>(it, Hg, vT, kT, decay, Ubuf, Dseg, AO, p.in[8] + e * 256, wv);
#if (DUP & 4)
        GSYNC();
        for (int it = blockIdx.x; it < 256; it += gridDim.x) gla_scan_item<0>(it, Hg, vT, kT, decay, Ubuf, Dseg, AO, p.in[8] + e * 256, wv);
#endif
      } else if (st == 3) {
#pragma unroll 1
        for (int it = blockIdx.x; it < 256; it += gridDim.x) if (PM & 32) gla_scan_item<1>(it, Hg, vT, kT, decay, Ubuf, Dseg, AO, p.in[8] + e * 256, wv);
#if (DUP & 8)
        GSYNC();
        for (int it = blockIdx.x; it < 256; it += gridDim.x) gla_scan_item<1>(it, Hg, vT, kT, decay, Ubuf, Dseg, AO, p.in[8] + e * 256, wv);
#endif
      } else {
        if (PM & 64) ln_phase(p.X, XB, p.in[14] + l * 1024, p.in[15] + l * 1024, true, wv);
      }
      GSYNC();
#if (DUP & 16)
      GSYNC();
#endif
    }
  }
}

extern "C" void kernel_launch(void* const* d_in, const int* in_sizes, int n_in, void* d_out, int out_size, void* d_ws, size_t ws_size,
                              hipStream_t stream) {
  constexpr int LDS_BYTES = 131072 + 64;
  static int grid = 0;
  if (grid == 0) {
    if (n_in != 16 || out_size != NTOK * DM || ws_size < WS_END) {
      fprintf(stderr, "kernel_launch: unexpected shapes (n_in %d out %d ws %zu need %zu)\n", n_in, out_size, ws_size, (size_t)WS_END);
      grid = -1; return;
    }
    int dev = 0, cus = 0, per_cu = 0;
    hipGetDevice(&dev);
    hipDeviceGetAttribute(&cus, hipDeviceAttributeMultiprocessorCount, dev);
    hipFuncSetAttribute((const void*)mega_fwd, hipFuncAttributeMaxDynamicSharedMemorySize, LDS_BYTES);
    hipOccupancyMaxActiveBlocksPerMultiprocessor(&per_cu, (const void*)mega_fwd, 512, LDS_BYTES);
    if (per_cu < 1) per_cu = 1;
    grid = cus * per_cu;
    if (grid > 256) grid = 256;
    (void)hipGetLastError();
  }
  if (grid < 0) return;
  if (hipMemsetAsync((char*)d_ws + WS_BAR, 0, 16384, stream) != hipSuccess) { fprintf(stderr, "kernel_launch: memset of barrier words failed\n"); return; }
  Params p{};
  for (int i = 0; i < 16; ++i) p.in[i] = (const float*)d_in[i];
  p.X = (float*)d_out;
  p.ws = (unsigned char*)d_ws;
  void* args[] = {&p};
  hipError_t err = hipLaunchCooperativeKernel((const void*)mega_fwd, dim3(grid), dim3(512), args, LDS_BYTES, stream);
  if (err != hipSuccess) fprintf(stderr, "cooperative launch failed: %s (grid %d)\n", hipGetErrorString(err), grid);
}
```

```cpp
#include <hip/hip_runtime.h>
#include <hip/hip_cooperative_groups.h>
#include <cstdio>
#include <cstdint>
namespace cg = cooperative_groups;

typedef unsigned short bf16_t;
typedef short bf16x8 __attribute__((ext_vector_type(8)));
typedef float f32x4 __attribute__((ext_vector_type(4)));
typedef float f32x16 __attribute__((ext_vector_type(16)));
typedef unsigned u32x2 __attribute__((ext_vector_type(2)));
typedef unsigned u32x4 __attribute__((ext_vector_type(4)));

#define DEVI __device__ __forceinline__
#define NEG_INF (-__builtin_inff())

constexpr int SEQ = 8192, NTOK = 32768, DM = 1024;
constexpr float DN_ALPHA = 1.681792830507429f;

constexpr size_t MiB = 1024ull * 1024ull;
constexpr size_t WS_WT    = 4096;
constexpr size_t WT_LAYER = 24 * MiB;
constexpr size_t WS_WGD   = WS_WT + 4 * WT_LAYER;
constexpr size_t WS_XB    = WS_WGD + 65536;
constexpr size_t WS_AO    = WS_XB + 64 * MiB;
constexpr size_t WS_OV    = WS_AO + 64 * MiB;
constexpr size_t WS_KM    = WS_OV + 256 * MiB;
constexpr size_t WS_DEC   = WS_KM + 524288;
constexpr size_t WS_DSEG  = WS_DEC + 1 * MiB;
constexpr size_t WS_BAR   = WS_DSEG + 131072;
constexpr size_t WS_STATS = WS_BAR + 16384;
constexpr size_t WS_MR    = WS_STATS + 8 * MiB;
constexpr size_t WS_UV    = WS_MR + 524288;
constexpr size_t WS_UVP   = WS_UV + 262144;
constexpr size_t WS_END   = WS_UVP + 4 * MiB;
constexpr int UV_U_IN = 0, UV_V_IN = 3072, UV_U_F1 = 6144, UV_V_F1 = 10240, UV_U_GD = 14336, UV_V_GD = 14352;
constexpr size_t OV_H   = 0;
constexpr size_t OV_DVT = 192 * MiB;
constexpr size_t OV_MVT = 224 * MiB;
constexpr size_t OV_HG  = 0;
constexpr size_t OV_VT  = 128 * MiB;
constexpr size_t OV_KT  = 192 * MiB;
constexpr size_t OV_U   = 224 * MiB;

struct Params {
  const float* in[16];
  float* X;
  unsigned char* ws;
};

typedef __bf16 bf16x2_t __attribute__((ext_vector_type(2)));
DEVI unsigned pk_bf16(float lo, float hi) { bf16x2_t v = {(__bf16)lo, (__bf16)hi}; return __builtin_bit_cast(unsigned, v); }
DEVI bf16_t f2bf(float f) { return (bf16_t)(pk_bf16(f, 0.f) & 0xffffu); }
DEVI float bf2f(bf16_t v) { return __uint_as_float(((unsigned)v) << 16); }
DEVI float bflo(unsigned u) { return __uint_as_float(u << 16); }
DEVI float bfhi(unsigned u) { return __uint_as_float(u & 0xffff0000u); }
DEVI bf16x8 mk8(unsigned a, unsigned b, unsigned c, unsigned d) { u32x4 v = {a, b, c, d}; return __builtin_bit_cast(bf16x8, v); }
DEVI bf16x8 pack8(const f32x16& x, int s) {
  return s == 0 ? mk8(pk_bf16(x[0], x[1]), pk_bf16(x[2], x[3]), pk_bf16(x[4], x[5]), pk_bf16(x[6], x[7]))
                : mk8(pk_bf16(x[8], x[9]), pk_bf16(x[10], x[11]), pk_bf16(x[12], x[13]), pk_bf16(x[14], x[15]));
}
DEVI f32x16 mfma32(bf16x8 a, bf16x8 b, f32x16 c) { return __builtin_amdgcn_mfma_f32_32x32x16_bf16(a, b, c, 0, 0, 0); }
DEVI f32x4 mfma16(bf16x8 a, bf16x8 b, f32x4 c) { return __builtin_amdgcn_mfma_f32_16x16x32_bf16(a, b, c, 0, 0, 0); }
DEVI float ex2(float x) { return __builtin_amdgcn_exp2f(x); }

template <int X> DEVI float swz_xor(float v) { return __int_as_float(__builtin_amdgcn_ds_swizzle(__float_as_int(v), (X << 10) | 0x1f)); }
DEVI void halves(float v, float& lo, float& hi) {
  auto r = __builtin_amdgcn_permlane32_swap(__float_as_uint(v), __float_as_uint(v), false, false);
  lo = __uint_as_float(r[0]); hi = __uint_as_float(r[1]);
}
DEVI void halves_i(int v, int& lo, int& hi) {
  auto r = __builtin_amdgcn_permlane32_swap((unsigned)v, (unsigned)v, false, false);
  lo = (int)r[0]; hi = (int)r[1];
}
DEVI float hsum(float v) { float a, b; halves(v, a, b); return a + b; }
DEVI float hmax(float v) { float a, b; halves(v, a, b); return fmaxf(a, b); }
DEVI float sum16(float v) { v += swz_xor<1>(v); v += swz_xor<2>(v); v += swz_xor<4>(v); v += swz_xor<8>(v); return v; }
DEVI float sum64(float v) { v = sum16(v); v += swz_xor<16>(v); return hsum(v); }
DEVI int otid(int wv) { int t = wv * 64 + (int)__builtin_amdgcn_mbcnt_hi(~0u, __builtin_amdgcn_mbcnt_lo(~0u, 0u)); asm volatile("" : "+v"(t)); return t; }

constexpr double cexp_pos(double x) { double s = 1.0, t = 1.0; for (int i = 1; i < 100; ++i) { t *= x / i; s += t; } return s; }
constexpr float rope_inv(int p, int dim) { return (float)(1.0 / cexp_pos((2.0 * p / dim) * 9.210340371976184)); }
struct RopeTab { float d[32]; float m[64]; };
constexpr RopeTab make_rope_tab() { RopeTab t{}; for (int p = 0; p < 32; ++p) t.d[p] = rope_inv(p, 64); for (int p = 0; p < 64; ++p) t.m[p] = rope_inv(p, 128); return t; }
__device__ const RopeTab g_rope = make_rope_tab();

DEVI void sincos_f(float a, float& s, float& c) {
  float n = rintf(a * 0.636619772367581343f);
  float r = fmaf(-n, 1.5703125f, a);
  r = fmaf(-n, 4.837512969970703125e-4f, r);
  r = fmaf(-n, 7.54978995489188216e-8f, r);
  float r2 = r * r;
  float sp = r + r * r2 * (-1.66666667e-1f + r2 * (8.33333333e-3f + r2 * (-1.98412698e-4f + r2 * 2.75573192e-6f)));
  float cp = 1.f + r2 * (-0.5f + r2 * (4.16666667e-2f + r2 * (-1.38888889e-3f + r2 * (2.48015873e-5f + r2 * (-2.75573192e-7f)))));
  int q = ((int)n) & 3;
  float ss = (q & 1) ? cp : sp, cc = (q & 1) ? sp : cp;
  s = (q & 2) ? -ss : ss;
  c = ((q + 1) & 2) ? -cc : cc;
}

DEVI int perm_even(int c) {
  const int sec = c >> 9, cl = c & 511;
  if (sec == 0 || sec == 1) { const int mm = cl >> 6, j = cl & 63, second = j >> 5, p = j & 31; return sec * 512 + mm * 64 + (p >> 4) * 32 + second * 16 + (p & 15); }
  if (sec == 3 || sec == 4) { const int hh = cl >> 7, j = cl & 127, second = j >> 6, p = j & 63; return sec * 512 + hh * 128 + (p >> 4) * 32 + second * 16 + (p & 15); }
  return c;
}

DEVI int perm32_row(int c) {
  const int x = c & 31; return (c & ~31) + ((x >> 2) & 1) * 16 + (x >> 3) * 4 + (x & 3);
}
struct WJob { const float* W; int ldw; bf16_t* Wt; int K, k0, c0, perm; const float* gvec; const float* bvec; float* uvec; float* vvec; };
DEVI void wjob_load(const WJob& j, int t, f32x4& a, f32x4& b) {
  const float* src = j.W + (size_t)(j.k0 + (t >> 3)) * j.ldw + j.c0 + (t & 7) * 8;
  a = *(const f32x4*)src; b = *(const f32x4*)(src + 4);
}
DEVI void wtrans_tile(const WJob& jw, f32x4 a, f32x4 b, char* lds, int t) {
  bf16_t* Wt = jw.Wt; const int K = jw.K, k0 = jw.k0, c0 = jw.c0, perm = jw.perm;
  const float* gvec = jw.gvec; const float* bvec = jw.bvec; float* uvec = jw.uvec; float* vvec = jw.vvec;
  bf16_t* tl = (bf16_t*)lds;
  float* suw = (float*)(lds + 9216);
  const bool fold = gvec != nullptr;
  { const int kr = t >> 3, cc = (t & 7) * 8;
    if (fold) {
      const float gk = gvec[k0 + kr], bk = bvec[k0 + kr];
      float ua[8], va[8];
#pragma unroll
      for (int i = 0; i < 4; ++i) {
        const bf16_t ra = f2bf(a[i] * gk), rb = f2bf(b[i] * gk);
        tl[(cc + i) * 66 + kr] = ra; tl[(cc + 4 + i) * 66 + kr] = rb;
        ua[i] = bf2f(ra); ua[4 + i] = bf2f(rb); va[i] = a[i] * bk; va[4 + i] = b[i] * bk;
      }
#pragma unroll
      for (int i = 0; i < 8; ++i) {
        float x = ua[i], y = va[i];
        x += swz_xor<8>(x); y += swz_xor<8>(y);
        x += swz_xor<16>(x); y += swz_xor<16>(y);
        x = hsum(x); y = hsum(y);
        if ((t & 63) < 8) { suw[(t >> 6) * 128 + cc + i] = x; suw[(t >> 6) * 128 + 64 + cc + i] = y; }
      }
    } else {
#pragma unroll
      for (int i = 0; i < 4; ++i) { tl[(cc + i) * 66 + kr] = f2bf(a[i]); tl[(cc + 4 + i) * 66 + kr] = f2bf(b[i]); }
    } }
  __syncthreads();
  { const int c = t >> 3, kc = (t & 7) * 8;
    const unsigned* rp = (const unsigned*)(tl + c * 66 + kc);
    const u32x4 v = {rp[0], rp[1], rp[2], rp[3]};
    const int g = perm == 1 ? perm_even(c0 + c) : (perm == 2 || (perm == 3 && ((c0 + c) < 1024 || (c0 + c) >= 2048)) ? perm32_row(c0 + c) : (c0 + c));
    *(u32x4*)(Wt + (size_t)g * K + k0 + kc) = v; }
  if (fold && t < 128) {
    float acc = 0.f;
#pragma unroll
    for (int w8 = 0; w8 < 8; ++w8) acc += suw[w8 * 128 + t];
    const int c = t & 63;
    const int g = perm == 1 ? perm_even(c0 + c) : (perm == 2 || (perm == 3 && ((c0 + c) < 1024 || (c0 + c) >= 2048)) ? perm32_row(c0 + c) : (c0 + c));
    ((t < 64 ? uvec : vvec) + (size_t)(k0 >> 6) * 16384)[g] = acc;
  }
  __syncthreads();
}

DEVI void prologue(const Params& p, char* lds, int wv) {
  const int G = gridDim.x;
  unsigned char* ws = p.ws;
  auto decode = [&](int jb, WJob& j) {
    const int l = jb / 3072; int rem = jb % 3072;
    bf16_t* wl = (bf16_t*)(ws + WS_WT + (size_t)l * WT_LAYER);
    float* uv = (float*)(ws + WS_UVP) + (size_t)l * 16 * 16384;
    j.gvec = nullptr; j.bvec = nullptr; j.uvec = nullptr; j.vvec = nullptr;
    if (rem < 768) {
      const int kt = rem / 48, ct = rem % 48;
      j.K = 1024; j.k0 = kt * 64; j.c0 = ct * 64; j.Wt = wl;
      if (l & 1) { j.W = p.in[5] + (size_t)(l >> 1) * 1024 * 3088; j.ldw = 3088; j.perm = 3; j.gvec = p.in[14] + (l - 1) * 1024; j.bvec = p.in[15] + (l - 1) * 1024; j.uvec = uv + UV_U_IN; j.vvec = uv + UV_V_IN; }
      else       { j.W = p.in[1] + (size_t)(l >> 1) * 1024 * 3072; j.ldw = 3072; j.perm = 1; }
    } else if (rem < 1024) {
      rem -= 768; const int kt = rem / 16, ct = rem % 16;
      j.W = (l & 1) ? p.in[9] + (size_t)(l >> 1) * 1024 * 1024 : p.in[4] + (size_t)(l >> 1) * 1024 * 1024;
      j.ldw = 1024; j.Wt = wl + 3 * 1024 * 1024; j.K = 1024; j.k0 = kt * 64; j.c0 = ct * 64; j.perm = 2;
    } else if (rem < 2048) {
      rem -= 1024; const int kt = rem / 64, ct = rem % 64;
      j.W = p.in[12] + (size_t)l * 1024 * 4096; j.ldw = 4096; j.Wt = wl + 4 * 1024 * 1024; j.K = 1024; j.k0 = kt * 64; j.c0 = ct * 64; j.perm = 2;
      j.gvec = p.in[10] + l * 1024; j.bvec = p.in[11] + l * 1024; j.uvec = uv + UV_U_F1; j.vvec = uv + UV_V_F1;
    } else {
      rem -= 2048; const int kt = rem / 16, ct = rem % 16;
      j.W = p.in[13] + (size_t)l * 4096 * 1024; j.ldw = 1024; j.Wt = wl + 8 * 1024 * 1024; j.K = 4096; j.k0 = kt * 64; j.c0 = ct * 64; j.perm = 2;
    }
  };
  { const int tw = otid(wv);
    int jb = blockIdx.x;
    WJob cur{}, nxt{}; f32x4 ca = {}, cbv = {}, na = {}, nb = {};
    if (jb < 4 * 3072) { decode(jb, cur); wjob_load(cur, tw, ca, cbv); }
#pragma unroll 1
    while (jb < 4 * 3072) {
      const int jn = jb + G;
      if (jn < 4 * 3072) { decode(jn, nxt); wjob_load(nxt, tw, na, nb); }
      wtrans_tile(cur, ca, cbv, lds, tw);
      cur = nxt; ca = na; cbv = nb; jb = jn;
    } }
  const int gt = blockIdx.x * 512 + otid(wv), GT = G * 512;
  { const int t = otid(wv); const int gw = blockIdx.x * 8 + (t >> 6), lane = t & 63;
    if (gw < 32) {
      const int o = gw >> 4, rr = gw & 15, lsrc = 2 * o;
      const float* gv = p.in[14] + lsrc * 1024; const float* bv = p.in[15] + lsrc * 1024;
      float us = 0.f, vs = 0.f;
      for (int k = lane; k < 1024; k += 64) {
        const float wgt = p.in[5][(size_t)o * 1024 * 3088 + (size_t)k * 3088 + 3072 + rr];
        const bf16_t rb = f2bf(wgt * gv[k]);
        ((bf16_t*)(ws + WS_WGD))[(o * 16 + rr) * 1024 + k] = rb;
        us += bf2f(rb); vs += wgt * bv[k];
      }
      us = sum64(us); vs = sum64(vs);
      if (lane == 0) { float* uv = (float*)(ws + WS_UV) + (size_t)(2 * o + 1) * 16384; uv[UV_U_GD + rr] = us; uv[UV_V_GD + rr] = vs; }
    } }
  for (int i = gt; i < 131072; i += GT) ((float*)(ws + WS_KM))[i] = 0.f;
  for (int i = gt; i < NTOK * DM / 8; i += 4 * GT) {
    f32x4 a[4], b[4];
#pragma unroll
    for (int k = 0; k < 4; ++k) { if (i + k * GT < NTOK * DM / 8) { const size_t e8 = (size_t)(i + k * GT) * 8; a[k] = *(const f32x4*)(p.in[0] + e8); b[k] = *(const f32x4*)(p.in[0] + e8 + 4); } }
#pragma unroll
    for (int k = 0; k < 4; ++k) {
      if (i + k * GT < NTOK * DM / 8) {
        u32x4 v = {pk_bf16(a[k][0], a[k][1]), pk_bf16(a[k][2], a[k][3]), pk_bf16(b[k][0], b[k][1]), pk_bf16(b[k][2], b[k][3])};
        *(u32x4*)((bf16_t*)(ws + WS_XB) + (size_t)(i + k * GT) * 8) = v;
      }
    }
  }
}

#define LAS __attribute__((address_space(3)))
constexpr int BM = 256, BK = 64, HALF = 128, HTB = HALF * BK * 2, NXCD = 8, WGM = 4;
DEVI int lds_byte(int r, int c) { const int st = (r >> 4) * 2 + (c >> 5), rr = r & 15, cc = c & 31, ob = rr * 64 + cc * 2; return st * 1024 + (ob ^ (((ob >> 9) & 1) << 5)); }
DEVI void stage_rc(int b, int& R, int& C) { const int st = b / 1024, sb = b % 1024, swz = sb ^ (((sb >> 9) & 1) << 5); R = (st >> 1) * 16 + swz / 64; C = (st & 1) * 32 + (swz % 64) / 2; }

enum { EPI_EVEN = 0, EPI_GLA = 1, EPI_RES = 2, EPI_FFN1 = 3 };
struct EpiArgs {
  int kind;
  bf16_t* H; bf16_t* vt0; bf16_t* vt1; float* kmsum;
  bf16_t* Hff;
  const float* stat_in; const float* u; const float* v;
  bf16_t* Y; float* X;
  const float* stat_prev; const float* gprev; const float* bprev;
  float* stat_new; int final_out;
};
DEVI void row_sums(const float* raw, int row, float& s1, float& s2) {
  typedef float f32x2 __attribute__((ext_vector_type(2)));
  float a1 = 0.f, a2 = 0.f;
#pragma unroll
  for (int k = 0; k < 16; ++k) { const f32x2 p = *(const f32x2*)(raw + (size_t)k * 65536 + 2 * row); a1 += p[0]; a2 += p[1]; }
  s1 = a1; s2 = a2;
}
DEVI void stat_finalize(const float* raw, float* mr, int wv) {
  for (int row = blockIdx.x * 512 + otid(wv); row < NTOK; row += gridDim.x * 512) {
    float s1, s2; row_sums(raw, row, s1, s2);
    const float mu = s1 * (1.f / 1024.f);
    const float var = fmaxf(s2 * (1.f / 1024.f) - mu * mu, 0.f);
    mr[2 * row] = mu; mr[2 * row + 1] = rsqrtf(var + 1e-5f);
  }
}
DEVI void row_mu_rstd(const float* mr, int row, float& mu, float& rstd) { mu = mr[2 * row]; rstd = mr[2 * row + 1]; }
struct Unit { int brow, bcol, swap; };

DEVI bool unit_next(int i, int nN, int kind, Unit& u) {
  const int nM = NTOK / BM, nwg = nM * nN;
  const long L = (long)i * gridDim.x + blockIdx.x;
  if (L >= nwg) return false;
  int wgid = (int)L;
  { const int q = nwg / NXCD, r = nwg % NXCD, xcd = wgid % NXCD, off = wgid / NXCD; wgid = (xcd < r ? xcd * (q + 1) : r * (q + 1) + (xcd - r) * q) + off; }
  const int nig = WGM * nN, gid = wgid / nig, fm = gid * WGM, gsz = (nM - fm) < WGM ? (nM - fm) : WGM;
  const int pm = fm + ((wgid % nig) % gsz), pn = (wgid % nig) / gsz;
  u.brow = pm * BM; u.bcol = pn * BM;
  const int sec = u.bcol >> 9;
  u.swap = (kind == EPI_EVEN && (sec == 2 || sec == 5)) || (kind == EPI_GLA && (sec == 2 || sec == 3));
  return true;
}

DEVI void acc_init(f32x4 (&acc)[2][2][4][2], const Unit& un, int wr, int wc, int fr, int fq, const EpiArgs& e) {
  if (!e.stat_in) {
#pragma unroll
    for (int a = 0; a < 2; ++a)
#pragma unroll
      for (int b = 0; b < 2; ++b)
#pragma unroll
        for (int m = 0; m < 4; ++m)
#pragma unroll
          for (int n = 0; n < 2; ++n) acc[a][b][m][n] = (f32x4){0.f, 0.f, 0.f, 0.f};
  } else if (!un.swap) {
    float nmu[8];
#pragma unroll
    for (int q = 0; q < 8; ++q) nmu[q] = -e.stat_in[2 * (un.brow + (q >> 2) * 128 + wr * 64 + (q & 3) * 16 + fr)];
#pragma unroll
    for (int bj = 0; bj < 2; ++bj)
#pragma unroll
      for (int n = 0; n < 2; ++n) {
        const f32x4 u4 = *(const f32x4*)(e.u + un.bcol + bj * 128 + wc * 32 + n * 16 + 4 * fq);
#pragma unroll
        for (int q = 0; q < 8; ++q) acc[q >> 2][bj][q & 3][n] = u4 * nmu[q];
      }
  } else {
    float uc[8];
#pragma unroll
    for (int q = 0; q < 8; ++q) uc[q] = e.u[un.bcol + (q >> 2) * 128 + wr * 64 + (q & 3) * 16 + fr];
#pragma unroll
    for (int bj = 0; bj < 2; ++bj)
#pragma unroll
      for (int n = 0; n < 2; ++n) {
        const int tok = un.brow + bj * 128 + wc * 32 + n * 16 + 4 * fq;
        const f32x4 sa = *(const f32x4*)(e.stat_in + 2 * tok), sb = *(const f32x4*)(e.stat_in + 2 * tok + 4);
        const f32x4 nmu = {-sa[0], -sa[2], -sb[0], -sb[2]};
#pragma unroll
        for (int q = 0; q < 8; ++q) acc[q >> 2][bj][q & 3][n] = nmu * uc[q];
      }
  }
}
DEVI float row_rstd(const float* mr, int row) { return mr[2 * row + 1]; }
DEVI f32x4 rstd4(const float* mr, int tok) {
  const f32x4 sa = *(const f32x4*)(mr + 2 * tok), sb = *(const f32x4*)(mr + 2 * tok + 4);
  return (f32x4){sa[1], sa[3], sb[1], sb[3]};
}

template <bool FOLD>
DEVI void epi_vt(const f32x4 (&acc)[2][2][4][2], bf16_t* vt, int chan0, int tok0, int nchan, int wr, int wc, int fr, int fq, const EpiArgs& e, int gcol0) {
  const int b = tok0 >> 13, s0 = tok0 & 8191;
  f32x4 rs[2][2];
#pragma unroll
  for (int bj = 0; bj < 2; ++bj)
#pragma unroll
    for (int n = 0; n < 2; ++n) { if (FOLD) rs[bj][n] = rstd4(e.stat_in, tok0 + bj * 128 + wc * 32 + n * 16 + 4 * fq); else rs[bj][n] = (f32x4){1.f, 1.f, 1.f, 1.f}; }
  float vcs[8];
#pragma unroll
  for (int q = 0; q < 8; ++q) { if (FOLD) vcs[q] = e.v[gcol0 + (q >> 2) * 128 + wr * 64 + (q & 3) * 16 + fr]; else vcs[q] = 0.f; }
#pragma unroll
  for (int ai = 0; ai < 2; ++ai)
#pragma unroll
    for (int m = 0; m < 4; ++m) {
      bf16_t* rowp = (bf16_t*)((char*)vt + ((unsigned)(b * nchan + chan0 + ai * 128 + wr * 64 + m * 16 + fr) * 8192u + (unsigned)(s0 + wc * 32 + 4 * fq)) * 2u);
      const float vc = vcs[ai * 4 + m];
#pragma unroll
      for (int bj = 0; bj < 2; ++bj)
#pragma unroll
        for (int n = 0; n < 2; ++n) {
          const f32x4 v = acc[ai][bj][m][n] * rs[bj][n] + vc;
          u32x2 w2 = {pk_bf16(v[0], v[1]), pk_bf16(v[2], v[3])};
          *(u32x2*)(rowp + bj * 128 + n * 16) = w2;
        }
    }
}

DEVI void epi_even(const f32x4 (&acc)[2][2][4][2], const Unit& u, int wr, int wc, int fr, int fq, const EpiArgs& e) {
  const int sec = u.bcol >> 9;
  if (u.swap) { epi_vt<false>(acc, sec == 2 ? e.vt0 : e.vt1, u.bcol & 511, u.brow, 512, wr, wc, fr, fq, e, u.bcol); return; }
  const bool moba = sec >= 3;
  const int b = u.brow >> 13, sb = u.brow & 8191;
#pragma unroll
  for (int bj = 0; bj < 2; ++bj) {
    const int gl = (u.bcol & 511) + bj * 128 + wc * 32;
    int p0, c1, half;
    if (!moba) { const int mm = gl >> 6, grp = (gl >> 5) & 1; p0 = grp * 16 + 4 * fq; c1 = sec * 512 + mm * 64 + p0; half = 32; }
    else       { const int hh = gl >> 7, grp = (gl >> 5) & 3; p0 = grp * 16 + 4 * fq; c1 = sec * 512 + hh * 128 + p0; half = 64; }
    const f32x4 inv = moba ? *(const f32x4*)(g_rope.m + p0) : *(const f32x4*)(g_rope.d + p0);
    f32x4 ks1 = {0.f, 0.f, 0.f, 0.f}, ks2 = {0.f, 0.f, 0.f, 0.f};
#pragma unroll
    for (int ai = 0; ai < 2; ++ai)
#pragma unroll
      for (int m = 0; m < 4; ++m) {
        const int row = u.brow + ai * 128 + wr * 64 + m * 16 + fr;
        const float pos = (float)(row & 8191);
        const f32x4 x1 = acc[ai][bj][m][0], x2 = acc[ai][bj][m][1];
        f32x4 y1, y2;
#pragma unroll
        for (int j = 0; j < 4; ++j) {
          float sn, cs; sincos_f(pos * inv[j], sn, cs);
          y1[j] = x1[j] * cs - x2[j] * sn; y2[j] = x2[j] * cs + x1[j] * sn;
        }
        u32x2 w1 = {pk_bf16(y1[0], y1[1]), pk_bf16(y1[2], y1[3])}, w2 = {pk_bf16(y2[0], y2[1]), pk_bf16(y2[2], y2[3])};
        const unsigned hoff = (unsigned)row * 6144u + (unsigned)c1 * 2u;
        *(u32x2*)((char*)e.H + hoff) = w1;
        *(u32x2*)((char*)e.H + hoff + (unsigned)half * 2u) = w2;
        ks1 += y1; ks2 += y2;
        __builtin_amdgcn_sched_barrier(0);
      }
    if (sec == 4) {
#pragma unroll
      for (int j = 0; j < 4; ++j) {
        float a = ks1[j], c = ks2[j];
        a = sum16(a); c = sum16(c);
        if (fr == 0) {
          float* kp = e.kmsum + (size_t)(b * 32 + (sb >> 8)) * 512 + (c1 - 2048) + j;
          atomicAdd(kp, a); atomicAdd(kp + 64, c);
        }
      }
    }
  }
}

DEVI void epi_gla(const f32x4 (&acc)[2][2][4][2], const Unit& u, int wr, int wc, int fr, int fq, const EpiArgs& e) {
  if (u.swap) { epi_vt<true>(acc, e.vt0, u.bcol - 1024, u.brow, 1024, wr, wc, fr, fq, e, u.bcol); return; }
  const int cb = (u.bcol < 1024) ? u.bcol : u.bcol - 1024;
  f32x4 v4[2][2];
#pragma unroll
  for (int bj = 0; bj < 2; ++bj)
#pragma unroll
    for (int n = 0; n < 2; ++n) v4[bj][n] = *(const f32x4*)(e.v + u.bcol + bj * 128 + wc * 32 + n * 16 + 4 * fq);
  float rsq[8];
#pragma unroll
  for (int q = 0; q < 8; ++q) rsq[q] = row_rstd(e.stat_in, u.brow + (q >> 2) * 128 + wr * 64 + (q & 3) * 16 + fr);
#pragma unroll
  for (int ai = 0; ai < 2; ++ai)
#pragma unroll
    for (int m = 0; m < 4; ++m) {
      bf16_t* rowp = (bf16_t*)((char*)e.H + ((unsigned)(u.brow + ai * 128 + wr * 64 + m * 16 + fr) * 2048u + (unsigned)(cb + wc * 32 + 8 * fq)) * 2u);
      const float rsr = rsq[ai * 4 + m];
#pragma unroll
      for (int bj = 0; bj < 2; ++bj) {
        const f32x4 v0 = acc[ai][bj][m][0] * rsr + v4[bj][0], v1 = acc[ai][bj][m][1] * rsr + v4[bj][1];
        u32x4 w4 = {pk_bf16(v0[0], v0[1]), pk_bf16(v0[2], v0[3]), pk_bf16(v1[0], v1[1]), pk_bf16(v1[2], v1[3])};
        *(u32x4*)(rowp + bj * 128) = w4;
      }
    }
}

DEVI void epi_res(const f32x4 (&acc)[2][2][4][2], const Unit& u, int wr, int wc, int fr, int fq, const EpiArgs& e) {
  float mus[8], rsd[8]; f32x4 g4[2][2], b4[2][2];
  const bool ln = e.stat_prev != nullptr;
  if (ln) {
#pragma unroll
    for (int q = 0; q < 8; ++q) row_mu_rstd(e.stat_prev, u.brow + (q >> 2) * 128 + wr * 64 + (q & 3) * 16 + fr, mus[q], rsd[q]);
#pragma unroll
    for (int bj = 0; bj < 2; ++bj)
#pragma unroll
      for (int n = 0; n < 2; ++n) {
        const int c = u.bcol + bj * 128 + wc * 32 + 8 * fq + 4 * n;
        g4[bj][n] = *(const f32x4*)(e.gprev + c); b4[bj][n] = *(const f32x4*)(e.bprev + c);
      }
  } else {
#pragma unroll
    for (int q = 0; q < 8; ++q) { mus[q] = 0.f; rsd[q] = 1.f; }
#pragma unroll
    for (int bj = 0; bj < 2; ++bj)
#pragma unroll
      for (int n = 0; n < 2; ++n) { g4[bj][n] = (f32x4){1.f, 1.f, 1.f, 1.f}; b4[bj][n] = (f32x4){0.f, 0.f, 0.f, 0.f}; }
  }
#pragma unroll
  for (int ai = 0; ai < 2; ++ai)
#pragma unroll
    for (int m = 0; m < 4; ++m) {
      const int row = u.brow + ai * 128 + wr * 64 + m * 16 + fr;
      const unsigned o0 = (unsigned)row * 1024u + (unsigned)(u.bcol + wc * 32 + 8 * fq);
      const float mu = mus[ai * 4 + m], rstd = rsd[ai * 4 + m];
      u32x4 rb[2];
#pragma unroll
      for (int bj = 0; bj < 2; ++bj) rb[bj] = *(const u32x4*)((const char*)e.Y + (o0 + bj * 128) * 2u);
      float s1 = 0.f, s2 = 0.f;
#pragma unroll
      for (int bj = 0; bj < 2; ++bj) {
        const unsigned o = o0 + bj * 128;
        f32x4 r0 = {bflo(rb[bj][0]), bfhi(rb[bj][0]), bflo(rb[bj][1]), bfhi(rb[bj][1])};
        f32x4 r1 = {bflo(rb[bj][2]), bfhi(rb[bj][2]), bflo(rb[bj][3]), bfhi(rb[bj][3])};
        r0 = (r0 - mu) * rstd * g4[bj][0] + b4[bj][0];
        r1 = (r1 - mu) * rstd * g4[bj][1] + b4[bj][1];
        const f32x4 y0 = r0 * DN_ALPHA + acc[ai][bj][m][0], y1 = r1 * DN_ALPHA + acc[ai][bj][m][1];
        u32x4 w4 = {pk_bf16(y0[0], y0[1]), pk_bf16(y0[2], y0[3]), pk_bf16(y1[0], y1[1]), pk_bf16(y1[2], y1[3])};
        *(u32x4*)((char*)e.Y + o * 2u) = w4;
        if (e.final_out) { *(f32x4*)((char*)e.X + o * 4u) = y0; *(f32x4*)((char*)e.X + o * 4u + 16) = y1; }
        s1 += ((y0[0] + y0[1]) + (y0[2] + y0[3])) + ((y1[0] + y1[1]) + (y1[2] + y1[3]));
        s2 += ((y0[0] * y0[0] + y0[1] * y0[1]) + (y0[2] * y0[2] + y0[3] * y0[3])) + ((y1[0] * y1[0] + y1[1] * y1[1]) + (y1[2] * y1[2] + y1[3] * y1[3]));
      }
      s1 += swz_xor<16>(s1); s2 += swz_xor<16>(s2);
      s1 = hsum(s1); s2 = hsum(s2);
      if (fq == 0) { float* sp = e.stat_new + (size_t)((u.bcol >> 8) * 4 + wc) * 65536 + 2 * row; sp[0] = s1; sp[1] = s2; }
    }
}

DEVI void epi_ffn1(const f32x4 (&acc)[2][2][4][2], const Unit& u, int wr, int wc, int fr, int fq, const EpiArgs& e) {
  float rs[8]; f32x4 v4[2][2];
#pragma unroll
  for (int q = 0; q < 8; ++q) rs[q] = row_rstd(e.stat_in, u.brow + (q >> 2) * 128 + wr * 64 + (q & 3) * 16 + fr);
#pragma unroll
  for (int bj = 0; bj < 2; ++bj)
#pragma unroll
    for (int n = 0; n < 2; ++n) v4[bj][n] = *(const f32x4*)(e.v + u.bcol + bj * 128 + wc * 32 + n * 16 + 4 * fq);
#pragma unroll
  for (int ai = 0; ai < 2; ++ai)
#pragma unroll
    for (int m = 0; m < 4; ++m) {
      bf16_t* rowp = (bf16_t*)((char*)e.Hff + ((unsigned)(u.brow + ai * 128 + wr * 64 + m * 16 + fr) * 4096u + (unsigned)(u.bcol + wc * 32 + 8 * fq)) * 2u);
      const float rsr = rs[ai * 4 + m];
#pragma unroll
      for (int bj = 0; bj < 2; ++bj) {
        f32x4 v0 = acc[ai][bj][m][0] * rsr + v4[bj][0], v1 = acc[ai][bj][m][1] * rsr + v4[bj][1];
#pragma unroll
        for (int j = 0; j < 4; ++j) { const float t0 = fmaxf(v0[j], 0.f), t1 = fmaxf(v1[j], 0.f); v0[j] = t0 * t0; v1[j] = t1 * t1; }
        u32x4 w4 = {pk_bf16(v0[0], v0[1]), pk_bf16(v0[2], v0[3]), pk_bf16(v1[0], v1[1]), pk_bf16(v1[2], v1[3])};
        *(u32x4*)(rowp + bj * 128) = w4;
      }
    }
}

extern __shared__ __attribute__((aligned(16))) unsigned char g_lds[];

DEVI void gemm_phase(const bf16_t* A, const bf16_t* Bt, int N, int K, const EpiArgs& e, int wv) {
  LAS unsigned char* lds = (LAS unsigned char*)g_lds;
  const int tid = otid(wv), wid = __builtin_amdgcn_readfirstlane(tid >> 6), lane = tid & 63, wr = wid >> 2, wc = wid & 3, fr = lane & 15, fq = lane >> 4;
  const int nt = K / BK, nN = N / BM;
  unsigned voff[2];
#pragma unroll
  for (int i = 0; i < 2; ++i) { int R, C; stage_rc(tid * 16 + i * 8192, R, C); voff[i] = (unsigned)(R * K + C) * 2u; }
  const size_t kstep = (size_t)(BK * 2);
  const size_t hstep = (size_t)HALF * K * 2;
  const size_t tstep = 2 * hstep;
  const unsigned ldsw = (unsigned)wid * 1024u;
  const int aoff = lds_byte(wr * 64 + fr, fq * 8), boff = lds_byte(wc * 32 + fr, fq * 8);
#define PG8_SA(b, h) (((b) * 2 + (h)) * HTB)
#define PG8_SB(b, h) ((4 + (b) * 2 + (h)) * HTB)
#define PG8_STAGE(bufoff, gbase) do { _Pragma("unroll") for (int _i = 0; _i < 2; ++_i) \
    __builtin_amdgcn_global_load_lds((const unsigned*)((const char*)(gbase) + voff[_i]), (LAS unsigned*)(lds + (bufoff) + ldsw + _i * 8192), 16, 0, 0); } while (0)
#define PG8_LDA(dst, b, h) do { _Pragma("unroll") for (int m = 0; m < 4; ++m) _Pragma("unroll") for (int k = 0; k < 2; ++k) dst[m][k] = *(const LAS bf16x8*)(lds + PG8_SA(b, h) + aoff + m * 2048 + k * 1024); } while (0)
#define PG8_LDB(dst, b, h) do { _Pragma("unroll") for (int n = 0; n < 2; ++n) _Pragma("unroll") for (int k = 0; k < 2; ++k) dst[n][k] = *(const LAS bf16x8*)(lds + PG8_SB(b, h) + boff + n * 2048 + k * 1024); } while (0)
#define PG8_MMA(ai, bj, At, Bt_) do { __builtin_amdgcn_s_setprio(1); _Pragma("unroll") for (int m = 0; m < 4; ++m) _Pragma("unroll") for (int n = 0; n < 2; ++n) _Pragma("unroll") for (int k = 0; k < 2; ++k) \
    acc[ai][bj][m][n] = __builtin_amdgcn_mfma_f32_16x16x32_bf16(Bt_[n][k], At[m][k], acc[ai][bj][m][n], 0, 0, 0); __builtin_amdgcn_s_setprio(0); } while (0)
#define PG8_WAIT_V(n) asm volatile("s_waitcnt vmcnt(" #n ")" ::: "memory")
#define PG8_WAIT_L(n) asm volatile("s_waitcnt lgkmcnt(" #n ")" ::: "memory")
#define PG8_BAR __builtin_amdgcn_s_barrier()
#define PG8_SCHED __builtin_amdgcn_sched_barrier(0)
#define UNIT_P(u) ((const char*)((u).swap ? Bt : A) + (size_t)(((u).swap ? (u).bcol : (u).brow) >> 8) * tstep)
#define UNIT_Q(u) ((const char*)((u).swap ? A : Bt) + (size_t)(((u).swap ? (u).brow : (u).bcol) >> 8) * tstep)
  Unit cur, nxt; int ui = 0;
  if (!unit_next(0, nN, e.kind, cur)) return;
  f32x4 acc[2][2][4][2];
  acc_init(acc, cur, wr, wc, fr, fq, e);
  bf16x8 At[4][2], B0[2][2], B1[2][2];
  const char* cA = UNIT_P(cur); const char* cB = UNIT_Q(cur);
  PG8_STAGE(PG8_SB(0, 0), cB); PG8_STAGE(PG8_SB(0, 1), cB + hstep); PG8_STAGE(PG8_SA(0, 0), cA); PG8_STAGE(PG8_SA(0, 1), cA + hstep);
  if (wr == 1) PG8_BAR;
  PG8_WAIT_V(2); PG8_BAR;
  PG8_STAGE(PG8_SB(1, 0), cB + kstep); PG8_STAGE(PG8_SA(1, 0), cA + kstep); PG8_STAGE(PG8_SB(1, 1), cB + hstep + kstep);
  PG8_WAIT_V(6); PG8_BAR;
  for (;;) {
    const bool has_next = unit_next(ui + 1, nN, e.kind, nxt);
    const char* nA = has_next ? UNIT_P(nxt) : cA; const char* nB = has_next ? UNIT_Q(nxt) : cB;
#pragma unroll 1
    for (int t = 0; t < nt; t += 2) {
      const bool last = (t == nt - 2);
      const char* a1 = cA + (size_t)(t + 1) * kstep;
      const char* a2 = last ? nA : cA + (size_t)(t + 2) * kstep; const char* b2 = last ? nB : cB + (size_t)(t + 2) * kstep;
      const char* a3 = a2 + kstep; const char* b3 = b2 + kstep;
      PG8_LDB(B0, 0, 0); PG8_LDB(B1, 0, 1); PG8_SCHED; PG8_LDA(At, 0, 0); PG8_STAGE(PG8_SA(1, 1), a1 + hstep);
      PG8_WAIT_V(8); PG8_WAIT_L(0); PG8_BAR; PG8_MMA(0, 0, At, B0); PG8_MMA(0, 1, At, B1); PG8_BAR; PG8_SCHED;
      PG8_LDA(At, 0, 1); PG8_STAGE(PG8_SB(0, 0), b2); PG8_STAGE(PG8_SB(0, 1), b2 + hstep); PG8_STAGE(PG8_SA(0, 0), a2);
      PG8_WAIT_V(8); PG8_WAIT_L(0); PG8_BAR; PG8_MMA(1, 0, At, B0); PG8_MMA(1, 1, At, B1); PG8_BAR; PG8_SCHED;
      PG8_LDB(B0, 1, 0); PG8_LDB(B1, 1, 1); PG8_SCHED; PG8_LDA(At, 1, 0); PG8_STAGE(PG8_SA(0, 1), a2 + hstep);
      PG8_WAIT_V(8); PG8_WAIT_L(0); PG8_BAR; PG8_MMA(0, 0, At, B0); PG8_MMA(0, 1, At, B1); PG8_BAR; PG8_SCHED;
      PG8_LDA(At, 1, 1); PG8_STAGE(PG8_SB(1, 0), b3); PG8_STAGE(PG8_SB(1, 1), b3 + hstep); PG8_STAGE(PG8_SA(1, 0), a3);
      PG8_WAIT_V(8); PG8_WAIT_L(0); PG8_BAR; PG8_MMA(1, 0, At, B0); PG8_MMA(1, 1, At, B1); PG8_BAR; PG8_SCHED;
    }
    if (wr == 0) PG8_BAR;
    {
      const int tid_e = otid(wv);
      const int wid_e = __builtin_amdgcn_readfirstlane(tid_e >> 6), lane_e = tid_e & 63;
      const int wr_e = wid_e >> 2, wc_e = wid_e & 3, fr_e = lane_e & 15, fq_e = lane_e >> 4;
      if (e.kind == EPI_EVEN) epi_even(acc, cur, wr_e, wc_e, fr_e, fq_e, e);
      else if (e.kind == EPI_GLA) epi_gla(acc, cur, wr_e, wc_e, fr_e, fq_e, e);
      else if (e.kind == EPI_RES) epi_res(acc, cur, wr_e, wc_e, fr_e, fq_e, e);
      else epi_ffn1(acc, cur, wr_e, wc_e, fr_e, fq_e, e);
    }
    if (!has_next) break;
    cur = nxt; cA = nA; cB = nB; ++ui;
    { const int tid_i = otid(wv); const int wid_i = __builtin_amdgcn_readfirstlane(tid_i >> 6), lane_i = tid_i & 63;
      acc_init(acc, cur, wid_i >> 2, wid_i & 3, lane_i & 15, lane_i >> 4, e); }
    if (wr == 1) PG8_BAR;
  }
  PG8_WAIT_V(0);
  PG8_BAR;
#undef PG8_SA
#undef PG8_SB
#undef PG8_STAGE
#undef PG8_LDA
#undef PG8_LDB
#undef PG8_MMA
}

DEVI void ln_phase(float* X, bf16_t* XB, const float* g, const float* bt, bool final_out, int wv) {
  const int tidl = otid(wv); const int w = tidl >> 6, lane = tidl & 63;
  const int stride = gridDim.x * 8;
  int row = blockIdx.x * 8 + w;
  f32x4 v[4], vn[4];
  if (row < NTOK) {
#pragma unroll
    for (int i = 0; i < 4; ++i) v[i] = *(const f32x4*)(X + (size_t)row * 1024 + i * 256 + lane * 4);
  }
  for (; row < NTOK; row += stride) {
    float* xr = X + (size_t)row * 1024;
    if (row + stride < NTOK) {
#pragma unroll
      for (int i = 0; i < 4; ++i) vn[i] = *(const f32x4*)(X + (size_t)(row + stride) * 1024 + i * 256 + lane * 4);
    }
    float s = 0.f;
#pragma unroll
    for (int i = 0; i < 4; ++i) s += (v[i][0] + v[i][1]) + (v[i][2] + v[i][3]);
    s = sum64(s);
    const float mu = s * (1.f / 1024.f);
    float q = 0.f;
#pragma unroll
    for (int i = 0; i < 4; ++i) { const f32x4 d = v[i] - mu; q += (d[0] * d[0] + d[1] * d[1]) + (d[2] * d[2] + d[3] * d[3]); }
    q = sum64(q);
    const float rstd = rsqrtf(q * (1.f / 1024.f) + 1e-5f);
#pragma unroll
    for (int i = 0; i < 4; ++i) {
      const int c = i * 256 + lane * 4;
      const f32x4 gg = *(const f32x4*)(g + c), bb = *(const f32x4*)(bt + c);
      const f32x4 y = (v[i] - mu) * rstd * gg + bb;
      if (final_out) *(f32x4*)(xr + c) = y;
      else { u32x2 pkd = {pk_bf16(y[0], y[1]), pk_bf16(y[2], y[3])}; *(u32x2*)(XB + (size_t)row * 1024 + c) = pkd; }
    }
#pragma unroll
    for (int i = 0; i < 4; ++i) v[i] = vn[i];
  }
}

DEVI void ln_bf16_phase(const bf16_t* Y, bf16_t* XN, const float* g, const float* bt, int wv) {
  const int tidl = otid(wv); const int w = tidl >> 6, lane = tidl & 63;
  const int stride = gridDim.x * 8;
  int row = blockIdx.x * 8 + w;
  u32x4 ra = {}, rb = {}, na = {}, nb = {};
  if (row < NTOK) { ra = *(const u32x4*)(Y + (size_t)row * 1024 + lane * 8); rb = *(const u32x4*)(Y + (size_t)row * 1024 + 512 + lane * 8); }
  for (; row < NTOK; row += stride, ra = na, rb = nb) {
    if (row + stride < NTOK) { na = *(const u32x4*)(Y + (size_t)(row + stride) * 1024 + lane * 8); nb = *(const u32x4*)(Y + (size_t)(row + stride) * 1024 + 512 + lane * 8); }
    float v[16];
#pragma unroll
    for (int i = 0; i < 4; ++i) { v[2 * i] = bflo(ra[i]); v[2 * i + 1] = bfhi(ra[i]); v[8 + 2 * i] = bflo(rb[i]); v[8 + 2 * i + 1] = bfhi(rb[i]); }
    float sacc = 0.f;
#pragma unroll
    for (int i = 0; i < 16; ++i) sacc += v[i];
    sacc = sum64(sacc);
    const float mu = sacc * (1.f / 1024.f);
    float q = 0.f;
#pragma unroll
    for (int i = 0; i < 16; ++i) { const float d = v[i] - mu; q += d * d; }
    q = sum64(q);
    const float rstd = rsqrtf(q * (1.f / 1024.f) + 1e-5f);
#pragma unroll
    for (int hf = 0; hf < 2; ++hf) {
      const int c = hf * 512 + lane * 8;
      const f32x4 g0 = *(const f32x4*)(g + c), g1 = *(const f32x4*)(g + c + 4), b0 = *(const f32x4*)(bt + c), b1 = *(const f32x4*)(bt + c + 4);
      float y[8];
#pragma unroll
      for (int i = 0; i < 4; ++i) { y[i] = (v[hf * 8 + i] - mu) * rstd * g0[i] + b0[i]; y[4 + i] = (v[hf * 8 + 4 + i] - mu) * rstd * g1[i] + b1[i]; }
      u32x4 o = {pk_bf16(y[0], y[1]), pk_bf16(y[2], y[3]), pk_bf16(y[4], y[5]), pk_bf16(y[6], y[7])};
      *(u32x4*)(XN + (size_t)row * 1024 + c) = o;
    }
  }
}

constexpr int AT_BUF = 34816;
struct TileRegs { u32x4 k0, k1, v0, v1; };
DEVI void at_gload(TileRegs& r, const bf16_t* Kbase, const bf16_t* VTbase, int key0, int t) {
  r.k0 = *(const u32x4*)(Kbase + (size_t)(key0 + (t >> 4)) * 3072 + (t & 15) * 8);
  r.k1 = *(const u32x4*)(Kbase + (size_t)(key0 + 32 + (t >> 4)) * 3072 + (t & 15) * 8);
  r.v0 = *(const u32x4*)(VTbase + (size_t)(t >> 3) * 8192 + key0 + (t & 7) * 8);
  r.v1 = *(const u32x4*)(VTbase + (size_t)(64 + (t >> 3)) * 8192 + key0 + (t & 7) * 8);
}
DEVI void at_lstore(const TileRegs& r, unsigned char* buf, int t) {
  *(u32x4*)(buf + (t >> 4) * 272 + (t & 15) * 16) = r.k0;
  *(u32x4*)(buf + (32 + (t >> 4)) * 272 + (t & 15) * 16) = r.k1;
  unsigned char* vb = buf + 17408;
  u32x2* p0 = (u32x2*)(vb + (t >> 3) * 136 + (t & 7) * 16);
  u32x2 a = {r.v0[0], r.v0[1]}, b = {r.v0[2], r.v0[3]}; p0[0] = a; p0[1] = b;
  u32x2* p1 = (u32x2*)(vb + (64 + (t >> 3)) * 136 + (t & 7) * 16);
  u32x2 c = {r.v1[0], r.v1[1]}, d = {r.v1[2], r.v1[3]}; p1[0] = c; p1[1] = d;
}

template <int MODE>
DEVI void attn_item(const bf16_t* H, const bf16_t* vT, const float* kmsum, bf16_t* AO, int b, int hh, int qi,
                    float lam_full, float one_m_linit, const float* subln, int wv) {
  constexpr int NKS = MODE ? 8 : 4;
  unsigned char* lds = g_lds;
  const int tid = otid(wv), w = tid >> 6, lane = tid & 63, r = lane & 31, h = lane >> 5;
  const int map = MODE ? 0 : (w & 1);
  const int q0 = MODE ? qi * 256 + w * 32 : qi * 128 + (w >> 1) * 32;
  const int ntiles = MODE ? 4 * (qi + 1) : 2 * qi + 2;
  const size_t tokbase = (size_t)b * 8192;
#ifdef MOBA_ON_DIFF
  const int qcol = MODE ? hh * 128 : hh * 128 + map * 64;
  const int kcol = 512 + hh * 128;
#else
  const int qcol = MODE ? 1536 + hh * 128 : hh * 128 + map * 64;
  const int kcol = MODE ? 2048 + hh * 128 : 512 + hh * 128;
#endif
  const bf16_t* Kbase = H + tokbase * 3072 + kcol;
  const bf16_t* VTbase = vT + (size_t)(b * 512 + hh * 128) * 8192;
  const float cs = (MODE ? 0.08838834764831845f : 0.125f) * 1.4426950408889634f;
  const int kboff = MODE ? 0 : map * 128;

  bf16x8 qf[NKS];
  { const bf16_t* qp = H + (tokbase + q0 + r) * 3072 + qcol + 8 * h;
#pragma unroll
    for (int ks = 0; ks < NKS; ++ks) qf[ks] = *(const bf16x8*)(qp + 16 * ks); }

  unsigned sel = 0;
  if (MODE) {
    f32x16 gt = {};
    const float* kmp = kmsum + (size_t)(b * 32 + r) * 512 + hh * 128 + 8 * h;
    f32x4 kma[8], kmc[8];
#pragma unroll
    for (int ks = 0; ks < 8; ++ks) { kma[ks] = *(const f32x4*)(kmp + 16 * ks); kmc[ks] = *(const f32x4*)(kmp + 16 * ks + 4); }
#pragma unroll
    for (int ks = 0; ks < 8; ++ks) {
      const f32x4 a = kma[ks] * (1.f / 256.f), c = kmc[ks] * (1.f / 256.f);
      gt = mfma32(mk8(pk_bf16(a[0], a[1]), pk_bf16(a[2], a[3]), pk_bf16(c[0], c[1]), pk_bf16(c[2], c[3])), qf[ks < NKS ? ks : 0], gt);
    }
    float gv[16];
#pragma unroll
    for (int rg = 0; rg < 16; ++rg) { const int blk = (rg & 3) + 8 * (rg >> 2) + 4 * h; gv[rg] = (blk < qi) ? gt[rg] : NEG_INF; }
#pragma unroll
    for (int round = 0; round < 3; ++round) {
      float best = NEG_INF; int bi = 99;
#pragma unroll
      for (int rg = 0; rg < 16; ++rg) { const int blk = (rg & 3) + 8 * (rg >> 2) + 4 * h; if (gv[rg] > best) { best = gv[rg]; bi = blk; } }
      float b_lo, b_hi; int i_lo, i_hi; halves(best, b_lo, b_hi); halves_i(bi, i_lo, i_hi);
      const bool lowin = (b_lo > b_hi) || (b_lo == b_hi && i_lo < i_hi);
      const float wval = lowin ? b_lo : b_hi; const int wi = lowin ? i_lo : i_hi;
      if (wval > NEG_INF) sel |= 1u << wi;
#pragma unroll
      for (int rg = 0; rg < 16; ++rg) { const int blk = (rg & 3) + 8 * (rg >> 2) + 4 * h; if (blk == wi) gv[rg] = NEG_INF; }
    }
  }

#ifdef SELFIX
  if (MODE) sel = (qi >= 3) ? 7u : ((1u << qi) - 1u);
#endif
  f32x16 o[4] = {};
  float m = NEG_INF, l = 0.f;
  TileRegs tr;
  at_gload(tr, Kbase, VTbase, 0, tid); at_lstore(tr, lds, tid); __syncthreads();
#pragma unroll 1
  for (int tt = 0; tt < ntiles; ++tt) {
    const unsigned char* buf = lds + (tt & 1) * AT_BUF;
    const int key0 = tt * 64;
    if (tt + 1 < ntiles) at_gload(tr, Kbase, VTbase, key0 + 64, tid);
    bool active, needmask, lanesel = true;
    if (MODE && (tt >> 2) < qi) { lanesel = (sel >> (tt >> 2)) & 1u; active = __any(lanesel ? 1 : 0) != 0; needmask = false; }
    else { active = key0 <= q0 + 31; needmask = key0 + 63 > q0; }
    if (active) {
      f32x16 st[2];
      {
        bf16x8 kfa[NKS], kfb[NKS];
        const unsigned char* kp0 = buf + r * 272 + kboff + h * 16;
#pragma unroll
        for (int ks = 0; ks < NKS; ++ks) kfa[ks] = *(const bf16x8*)(kp0 + ks * 32);
#pragma unroll
        for (int ks = 0; ks < NKS; ++ks) kfb[ks] = *(const bf16x8*)(kp0 + 32 * 272 + ks * 32);
        __builtin_amdgcn_sched_barrier(0);
        f32x16 a0 = {}, a1 = {};
#pragma unroll
        for (int ks = 0; ks < NKS; ++ks) a0 = mfma32(kfa[ks], qf[ks], a0);
#pragma unroll
        for (int ks = 0; ks < NKS; ++ks) a1 = mfma32(kfb[ks], qf[ks], a1);
        st[0] = a0; st[1] = a1;
      }
      if (needmask) {
#pragma unroll
        for (int T = 0; T < 2; ++T)
#pragma unroll
          for (int rg = 0; rg < 16; ++rg) { const int key = key0 + 32 * T + 8 * (rg >> 2) + 4 * h + (rg & 3); if (key > q0 + r) st[T][rg] = NEG_INF; }
      }
      float mxr = NEG_INF;
#pragma unroll
      for (int T = 0; T < 2; ++T)
#pragma unroll
        for (int rg = 0; rg < 16; ++rg) mxr = fmaxf(mxr, st[T][rg]);
      mxr = hmax(mxr);
      const float mxs = lanesel ? mxr * cs : NEG_INF;
      if (__any((mxs > m + 8.0f) ? 1 : 0)) {
        const float mn = fmaxf(m, mxs);
        const float mu2 = (mn == NEG_INF) ? 0.f : mn;
        const float alpha = ex2(m - mu2);
        m = mn;
        l *= alpha;
#pragma unroll
        for (int dt = 0; dt < 4; ++dt) o[dt] = o[dt] * alpha;
      }
      const float nb = lanesel ? ((m == NEG_INF) ? 0.f : -m) : NEG_INF;
      float ps = 0.f;
#pragma unroll
      for (int T = 0; T < 2; ++T)
#pragma unroll
        for (int rg = 0; rg < 16; ++rg) { const float pv = ex2(fmaf(st[T][rg], cs, nb)); st[T][rg] = pv; ps += pv; }
      l += ps;
      {
        const unsigned char* vb0 = buf + 17408 + r * 136 + 8 * h;
        u32x2 vlo[2][4], vhi[2][4];
#pragma unroll
        for (int dt = 0; dt < 4; ++dt) { const unsigned char* vp = vb0 + dt * 32 * 136; vlo[0][dt] = *(const u32x2*)vp; vhi[0][dt] = *(const u32x2*)(vp + 16); }
#pragma unroll
        for (int step = 0; step < 4; ++step) {
          const int T = step >> 1, sx = step & 1;
          if (step < 3) {
#pragma unroll
            for (int dt = 0; dt < 4; ++dt) { const unsigned char* vp = vb0 + dt * 32 * 136 + (step + 1) * 32; vlo[(step + 1) & 1][dt] = *(const u32x2*)vp; vhi[(step + 1) & 1][dt] = *(const u32x2*)(vp + 16); }
          }
          const bf16x8 pb = pack8(st[T], sx);
#pragma unroll
          for (int dt = 0; dt < 4; ++dt) o[dt] = mfma32(mk8(vlo[step & 1][dt][0], vlo[step & 1][dt][1], vhi[step & 1][dt][0], vhi[step & 1][dt][1]), pb, o[dt]);
          __builtin_amdgcn_sched_barrier(0);
        }
      }
    }
    if (tt + 1 < ntiles) at_lstore(tr, lds + ((tt + 1) & 1) * AT_BUF, tid);
    __syncthreads();
  }
  const float lt = hsum(l);
  const float il = 1.f / lt;
  const size_t token = tokbase + q0 + r;
  if (MODE) {
#pragma unroll
    for (int dt = 0; dt < 4; ++dt)
#pragma unroll
      for (int g = 0; g < 4; ++g) {
        const int dv = 32 * dt + 8 * g + 4 * h;
        u32x2 pkd = {pk_bf16(o[dt][4 * g] * il, o[dt][4 * g + 1] * il), pk_bf16(o[dt][4 * g + 2] * il, o[dt][4 * g + 3] * il)};
        *(u32x2*)(AO + token * 1024 + 512 + hh * 128 + dv) = pkd;
      }
  } else {
    float* ex = (float*)lds;
    const int rgp = w >> 1;
    if (map == 1) {
      const float f = il * lam_full;
#pragma unroll
      for (int dt = 0; dt < 4; ++dt)
#pragma unroll
        for (int rg = 0; rg < 16; ++rg) ex[((rgp * 4 + dt) * 16 + rg) * 64 + lane] = o[dt][rg] * f;
    }
    __syncthreads();
    if (map == 0) {
      float ss = 0.f;
#pragma unroll
      for (int dt = 0; dt < 4; ++dt)
#pragma unroll
        for (int rg = 0; rg < 16; ++rg) { const float d = o[dt][rg] * il - ex[((rgp * 4 + dt) * 16 + rg) * 64 + lane]; o[dt][rg] = d; ss += d * d; }
      ss = hsum(ss);
      const float rinv = rsqrtf(ss * (1.f / 128.f) + 1e-5f) * one_m_linit;
#pragma unroll
      for (int dt = 0; dt < 4; ++dt)
#pragma unroll
        for (int g = 0; g < 4; ++g) {
          const int dv = 32 * dt + 8 * g + 4 * h;
          const f32x4 sl = *(const f32x4*)(lds + 130048 + dv * 4);
          u32x2 pkd = {pk_bf16(o[dt][4 * g] * rinv * sl[0], o[dt][4 * g + 1] * rinv * sl[1]), pk_bf16(o[dt][4 * g + 2] * rinv * sl[2], o[dt][4 * g + 3] * rinv * sl[3])};
          *(u32x2*)(AO + token * 1024 + hh * 128 + dv) = pkd;
        }
    }
    __syncthreads();
  }
}

#ifndef AM
#define AM 3
#endif
DEVI void attn_phase(const Params& p, int e, int wv) {
  asm volatile("" : "+s"(e));
  unsigned char* ws = p.ws;
  const bf16_t* H = (const bf16_t*)(ws + WS_OV + OV_H);
  const bf16_t* dvT = (const bf16_t*)(ws + WS_OV + OV_DVT);
  const bf16_t* mvT = (const bf16_t*)(ws + WS_OV + OV_MVT);
  const float* kmsum = (const float*)(ws + WS_KM) + (size_t)e * 65536;
  bf16_t* AO = (bf16_t*)(ws + WS_AO);
  const float* lam = p.in[2] + e * 256;
  float s1 = 0.f, s2 = 0.f;
  for (int i = 0; i < 64; ++i) { s1 += lam[i] * lam[64 + i]; s2 += lam[128 + i] * lam[192 + i]; }
  const float linit = (e == 0) ? 0.2f : 0.47071301834358413f;
  const float lam_full = __expf(s1) - __expf(s2) + linit;
  const float* subln = p.in[3] + e * 128;
  { const int t0 = otid(wv); if (t0 < 128) ((float*)(g_lds + 130048))[t0] = subln[t0]; __syncthreads(); }
  const int vb = (gridDim.x == 256) ? (int)((blockIdx.x & 7) * 32 + (blockIdx.x >> 3)) : (int)blockIdx.x;
#pragma unroll 1
  for (int u = vb; u < 768; u += gridDim.x) {
    if (u < 512) {
      if (!(AM & 1)) continue;
      const int pidx = (u & 255) * 2 + (u >> 8); const int bh = pidx >> 5, ip = pidx & 31;
      attn_item<0>(H, dvT, kmsum, AO, bh >> 2, bh & 3, 63 - ip, lam_full, 1.f - linit, subln, wv);
      attn_item<0>(H, dvT, kmsum, AO, bh >> 2, bh & 3, ip, lam_full, 1.f - linit, subln, wv);
    } else {
      if (!(AM & 2)) continue;
      const int pp = u - 512, bh = pp >> 4, jp = pp & 15;
#ifdef MOBA_ON_DIFF
#define MVT_SRC dvT
#else
#define MVT_SRC mvT
#endif
      attn_item<1>(H, MVT_SRC, kmsum, AO, bh >> 2, bh & 3, 31 - jp, lam_full, 1.f - linit, subln, wv);
      attn_item<1>(H, MVT_SRC, kmsum, AO, bh >> 2, bh & 3, jp, lam_full, 1.f - linit, subln, wv);
    }
  }
}

DEVI void gla_prep_item(int item, const bf16_t* XB, const bf16_t* WgdT, const float* Wup, const float* bgate,
                        bf16_t* Hg, bf16_t* kT, float* decay, const float* stat_in, const float* ugd, const float* vgd, int wv) {
  const int tid = otid(wv), w = tid >> 6, lane = tid & 63;
  const int b = item >> 7, ch = item & 127;
  const size_t tok0 = (size_t)b * 8192 + ch * 64;
  float* gd = (float*)g_lds;
  if (w < 4) {
    const int fr = lane & 15, fq = lane >> 4;
    f32x4 acc = {};
    const bf16_t* ap = XB + (tok0 + 16 * w + fr) * 1024 + 8 * fq;
    const bf16_t* bp = WgdT + fr * 1024 + 8 * fq;
#pragma unroll 1
    for (int k0 = 0; k0 < 32; k0 += 8) {
      bf16x8 af[8], bfr[8];
#pragma unroll
      for (int i = 0; i < 8; ++i) { af[i] = *(const bf16x8*)(ap + 32 * (k0 + i)); bfr[i] = *(const bf16x8*)(bp + 32 * (k0 + i)); }
#pragma unroll
      for (int i = 0; i < 8; ++i) acc = mfma16(af[i], bfr[i], acc);
    }
    const float ug = ugd[fr], vg = vgd[fr];
#pragma unroll
    for (int j = 0; j < 4; ++j) {
      float mu, rstd; row_mu_rstd(stat_in, (int)tok0 + 16 * w + 4 * fq + j, mu, rstd);
      gd[(16 * w + 4 * fq + j) * 16 + fr] = rstd * (acc[j] - mu * ug) + vg;
    }
  }
  __syncthreads();
  const int c = tid;
  float wup[16];
#pragma unroll
  for (int rr = 0; rr < 16; ++rr) wup[rr] = Wup[rr * 512 + c];
  const float bias = bgate[c];
  float bsum = 0.f;
  bf16_t* qp = Hg + tok0 * 2048 + c;
  bf16_t* kp = qp + 512;
  bf16_t* ktp = kT + (size_t)(b * 512 + c) * 8192 + ch * 64;
  bf16_t qv[8], kv[8], qn[8], kn[8];
#pragma unroll
  for (int tt = 0; tt < 8; ++tt) { qv[tt] = qp[(size_t)tt * 2048]; kv[tt] = kp[(size_t)tt * 2048]; }
#pragma unroll 1
  for (int t8 = 0; t8 < 8; ++t8) {
    if (t8 < 7) {
#pragma unroll
      for (int tt = 0; tt < 8; ++tt) { qn[tt] = qp[(size_t)((t8 + 1) * 8 + tt) * 2048]; kn[tt] = kp[(size_t)((t8 + 1) * 8 + tt) * 2048]; }
    }
    unsigned short kb[8];
#pragma unroll
    for (int tt = 0; tt < 8; ++tt) {
      const int t = t8 * 8 + tt;
      const f32x4* g4 = (const f32x4*)(gd + t * 16);
      float z = bias;
#pragma unroll
      for (int i = 0; i < 4; ++i) { const f32x4 gg = g4[i]; z += gg[0] * wup[4 * i] + gg[1] * wup[4 * i + 1] + gg[2] * wup[4 * i + 2] + gg[3] * wup[4 * i + 3]; }
      const float ls = fminf(z, 0.f) - __logf(1.f + __expf(-fabsf(z)));
      bsum += ls * 0.0625f;
      const float eb = __expf(bsum), en = __expf(-bsum);
      const float q = bf2f(qv[tt]), k = bf2f(kv[tt]);
      qp[(size_t)t * 2048] = f2bf(q * eb * 0.08838834764831845f);
      const bf16_t kk = f2bf(k * en);
      kp[(size_t)t * 2048] = kk;
      kb[tt] = kk;
    }
    u32x4 pk = {(unsigned)kb[0] | ((unsigned)kb[1] << 16), (unsigned)kb[2] | ((unsigned)kb[3] << 16),
                (unsigned)kb[4] | ((unsigned)kb[5] << 16), (unsigned)kb[6] | ((unsigned)kb[7] << 16)};
    *(u32x4*)(ktp + t8 * 8) = pk;
#pragma unroll
    for (int tt = 0; tt < 8; ++tt) { qv[tt] = qn[tt]; kv[tt] = kn[tt]; }
  }
  decay[(size_t)(b * 128 + ch) * 512 + c] = __expf(bsum);
  __syncthreads();
}

constexpr int GL_Q = 0, GL_K = 17408, GL_KT = 34816, GL_BUF = 53248, GL_RED = 2 * GL_BUF;

template <int PASS>
DEVI void gla_scan_item(int item, const bf16_t* Hg, const bf16_t* vT, const bf16_t* kT, const float* decay,
                        float* Ubuf, float* Dseg, bf16_t* AO, const float* normg, int wv) {
  const int tid = otid(wv), w = tid >> 6, lane = tid & 63, r = lane & 31, h = lane >> 5;
  const int bh = item >> 4, seg = item & 15, b = bh >> 2, hd = bh & 3;
  unsigned char* lds = g_lds;
  const bf16_t* hq = Hg + ((size_t)b * 8192 + seg * 512 + (tid >> 4)) * 2048 + hd * 128 + (tid & 15) * 8;
  const bf16_t* kts = kT + (size_t)(b * 512 + hd * 128 + (tid >> 3)) * 8192 + seg * 512 + (tid & 7) * 8;
  u32x4 rq0, rq1, rk0, rk1, rt0, rt1;
#define GL_GLOAD(cc) do { \
    if (PASS == 1) { const bf16_t* _p = hq + (size_t)(cc) * 64 * 2048; rq0 = *(const u32x4*)_p; rq1 = *(const u32x4*)(_p + 32 * 2048); \
                     rk0 = *(const u32x4*)(_p + 512); rk1 = *(const u32x4*)(_p + 32 * 2048 + 512); } \
    rt0 = *(const u32x4*)(kts + (cc) * 64); rt1 = *(const u32x4*)(kts + (size_t)64 * 8192 + (cc) * 64); } while (0)
#define GL_LSTORE(bufp) do { \
    if (PASS == 1) { unsigned char* _q = (bufp) + GL_Q + (tid >> 4) * 272 + (tid & 15) * 16; *(u32x4*)_q = rq0; *(u32x4*)(_q + 32 * 272) = rq1; \
                     *(u32x4*)(_q + GL_K) = rk0; *(u32x4*)(_q + GL_K + 32 * 272) = rk1; } \
    unsigned char* _t = (bufp) + GL_KT + (tid >> 3) * 144 + (tid & 7) * 16; *(u32x4*)_t = rt0; *(u32x4*)(_t + 64 * 144) = rt1; } while (0)
  GL_GLOAD(0);
  f32x16 S[4] = {};
  if (PASS == 1) {
#pragma unroll 1
    for (int js = 0; js < seg; ++js) {
      const int it2 = bh * 16 + js;
      const float* up = Ubuf + ((size_t)(it2 * 8 + w) * 4) * 1024 + lane;
      const float* dp = Dseg + it2 * 128 + 4 * h;
#pragma unroll
      for (int dkt = 0; dkt < 4; ++dkt)
#pragma unroll
        for (int g = 0; g < 4; ++g) {
          const f32x4 d4 = *(const f32x4*)(dp + 32 * dkt + 8 * g);
#pragma unroll
          for (int i = 0; i < 4; ++i) S[dkt][4 * g + i] = S[dkt][4 * g + i] * d4[i] + up[(dkt * 16 + 4 * g + i) * 64];
        }
    }
  }
  GL_LSTORE(lds);
  __syncthreads();
  const bf16_t* vrow = vT + (size_t)(b * 1024 + hd * 256 + 32 * w + r) * 8192;
#pragma unroll 1
  for (int cc = 0; cc < 8; ++cc) {
    const int ch = seg * 8 + cc, tc0 = ch * 64;
    const size_t tokabs0 = (size_t)b * 8192 + tc0;
    const unsigned char* buf = lds + (cc & 1) * GL_BUF;
    if (cc + 1 < 8) GL_GLOAD(cc + 1);
    bf16x8 vnat[4];
#pragma unroll
    for (int ks = 0; ks < 4; ++ks) vnat[ks] = *(const bf16x8*)(vrow + tc0 + 16 * ks + 8 * h);
    f32x16 o0 = {}, o1 = {};
    if (PASS == 1) {
      f32x16 X00 = {}, X01 = {}, X11 = {};
      { const unsigned char* qL = buf + GL_Q + r * 272 + h * 16; const unsigned char* kL = buf + GL_K + r * 272 + h * 16;
#pragma unroll
        for (int ks = 0; ks < 8; ++ks) {
          const bf16x8 k0 = *(const bf16x8*)(kL + ks * 32), k1 = *(const bf16x8*)(kL + 32 * 272 + ks * 32);
          const bf16x8 q0 = *(const bf16x8*)(qL + ks * 32), q1 = *(const bf16x8*)(qL + 32 * 272 + ks * 32);
          X00 = mfma32(k0, q0, X00); X01 = mfma32(k0, q1, X01); X11 = mfma32(k1, q1, X11);
        } }
      u32x2 vpa[4], vpb[4];
      { const bf16_t* vp = vrow + tc0 + 4 * h;
#pragma unroll
        for (int q = 0; q < 4; ++q) { vpa[q] = *(const u32x2*)(vp + 16 * q); vpb[q] = *(const u32x2*)(vp + 16 * q + 8); } }
#pragma unroll
      for (int rg = 0; rg < 16; ++rg) { const int j = (rg & 3) + 8 * (rg >> 2) + 4 * h; if (r < j) { X00[rg] = 0.f; X11[rg] = 0.f; } }
      { const unsigned char* qP = buf + GL_Q + r * 272 + 8 * h;
#pragma unroll
        for (int dkt = 0; dkt < 4; ++dkt)
#pragma unroll
          for (int sx = 0; sx < 2; ++sx) {
            const bf16x8 sa = pack8(S[dkt], sx);
            const unsigned char* qq = qP + (32 * dkt + 16 * sx) * 2;
            const u32x2 a0 = *(const u32x2*)qq, a1 = *(const u32x2*)(qq + 16);
            const u32x2 c0 = *(const u32x2*)(qq + 32 * 272), c1 = *(const u32x2*)(qq + 32 * 272 + 16);
            o0 = mfma32(sa, mk8(a0[0], a0[1], a1[0], a1[1]), o0);
            o1 = mfma32(sa, mk8(c0[0], c0[1], c1[0], c1[1]), o1);
          } }
#pragma unroll
      for (int sx = 0; sx < 2; ++sx) {
        const bf16x8 v0 = mk8(vpa[sx][0], vpa[sx][1], vpb[sx][0], vpb[sx][1]), v1 = mk8(vpa[2 + sx][0], vpa[2 + sx][1], vpb[2 + sx][0], vpb[2 + sx][1]);
        o0 = mfma32(v0, pack8(X00, sx), o0);
        o1 = mfma32(v0, pack8(X01, sx), o1);
        o1 = mfma32(v1, pack8(X11, sx), o1);
      }
      float ss0 = 0.f, ss1 = 0.f;
#pragma unroll
      for (int rg = 0; rg < 16; ++rg) { ss0 += o0[rg] * o0[rg]; ss1 += o1[rg] * o1[rg]; }
      ss0 = hsum(ss0); ss1 = hsum(ss1);
      float* red = (float*)(lds + GL_RED) + (cc & 1) * 512;
      if (h == 0) { red[w * 64 + r] = ss0; red[w * 64 + 32 + r] = ss1; }
    }
    { const unsigned char* ktL = buf + GL_KT + r * 144 + h * 16;
#pragma unroll
      for (int ks = 0; ks < 4; ++ks)
#pragma unroll
        for (int dkt = 0; dkt < 4; ++dkt) S[dkt] = mfma32(*(const bf16x8*)(ktL + dkt * 32 * 144 + ks * 32), vnat[ks], S[dkt]); }
    { const float* dcp = decay + (size_t)(b * 128 + ch) * 512 + hd * 128 + 4 * h;
#pragma unroll
      for (int dkt = 0; dkt < 4; ++dkt)
#pragma unroll
        for (int g = 0; g < 4; ++g) {
          const f32x4 d4 = *(const f32x4*)(dcp + 32 * dkt + 8 * g);
#pragma unroll
          for (int i = 0; i < 4; ++i) S[dkt][4 * g + i] *= d4[i];
        } }
    if (cc + 1 < 8) GL_LSTORE(lds + ((cc + 1) & 1) * GL_BUF);
    __syncthreads();
    if (PASS == 1) {
      const float* red = (const float*)(lds + GL_RED) + (cc & 1) * 512;
      float t0 = 0.f, t1 = 0.f;
#pragma unroll
      for (int ww = 0; ww < 8; ++ww) { t0 += red[ww * 64 + r]; t1 += red[ww * 64 + 32 + r]; }
      const float ri0 = rsqrtf(t0 * (1.f / 256.f) + 1e-5f), ri1 = rsqrtf(t1 * (1.f / 256.f) + 1e-5f);
      u32x2 r4s[2][4]; f32x4 gns[4];
#pragma unroll
      for (int g = 0; g < 4; ++g) {
        gns[g] = *(const f32x4*)(normg + 32 * w + 8 * g + 4 * h);
#pragma unroll
        for (int it = 0; it < 2; ++it) r4s[it][g] = *(const u32x2*)(Hg + (tokabs0 + 32 * it + r) * 2048 + 1024 + hd * 256 + 32 * w + 8 * g + 4 * h);
      }
#pragma unroll
      for (int it = 0; it < 2; ++it)
#pragma unroll
        for (int g = 0; g < 4; ++g) {
          const int dv0 = 32 * w + 8 * g + 4 * h;
          const size_t tok = tokabs0 + 32 * it + r;
          const u32x2 r4 = r4s[it][g];
          const f32x4 gn = gns[g];
          const float rv[4] = {bflo(r4[0]), bfhi(r4[0]), bflo(r4[1]), bfhi(r4[1])};
          float ov[4];
#pragma unroll
          for (int i = 0; i < 4; ++i) {
            const float oo = it ? o1[4 * g + i] : o0[4 * g + i];
            const float sg = rv[i] / (1.f + __expf(-rv[i]));
            ov[i] = oo * (it ? ri1 : ri0) * gn[i] * sg;
          }
          u32x2 pkd = {pk_bf16(ov[0], ov[1]), pk_bf16(ov[2], ov[3])};
          *(u32x2*)(AO + tok * 1024 + hd * 256 + dv0) = pkd;
        }
    }
  }
#undef GL_GLOAD
#undef GL_LSTORE
  if (PASS == 0) {
    float* up = Ubuf + ((size_t)(item * 8 + w) * 4) * 1024 + lane;
#pragma unroll
    for (int dkt = 0; dkt < 4; ++dkt)
#pragma unroll
      for (int rg = 0; rg < 16; ++rg) up[(dkt * 16 + rg) * 64] = S[dkt][rg];
    if (tid < 128) {
      float dv8[8];
#pragma unroll
      for (int cc = 0; cc < 8; ++cc) dv8[cc] = decay[(size_t)(b * 128 + seg * 8 + cc) * 512 + hd * 128 + tid];
      float d = 1.f;
#pragma unroll
      for (int cc = 0; cc < 8; ++cc) d *= dv8[cc];
      Dseg[item * 128 + tid] = d;
    }
  }
  __syncthreads();
}

#define XB_TMO      128
#define XB_XCNT(j)  (256  + 64 * (j))
#define XB_XSUB(j)  (1280 + 64 * (j))
#define XB_XGEN(j)  (2304 + 64 * (j))
#define XB_TOP      3328
#define XB_TOPGEN   3392
#define XCD_BAR_WORDS 3456
#define XB_SPIN_CAP (1u << 20)
DEVI unsigned xb_ld(unsigned* p)              { return __hip_atomic_load(p, __ATOMIC_RELAXED, __HIP_MEMORY_SCOPE_AGENT); }
DEVI unsigned xb_add(unsigned* p, unsigned v) { return __hip_atomic_fetch_add(p, v, __ATOMIC_RELAXED, __HIP_MEMORY_SCOPE_AGENT); }
DEVI unsigned xb_xcc_id() { return (unsigned)__builtin_amdgcn_s_getreg((3 << 11) | 20) & 0xFu; }
#define XB_SPIN(cond, bar) do { unsigned _sp = 0; while (cond) { __builtin_amdgcn_s_sleep(1); \
    if ((++_sp & 255u) == 0u) { if (xb_ld(&(bar)[XB_TMO])) break; if (_sp > XB_SPIN_CAP) { atomicAdd(&(bar)[XB_TMO], 1u); break; } } } } while (0)
struct XcdBarrier { unsigned* bar; unsigned x; volatile LAS unsigned* st; };
DEVI void xcd_barrier_complete(unsigned* bar, unsigned x, unsigned& nloc, unsigned& nx) {
  const unsigned G = gridDim.x * gridDim.y * gridDim.z;
  unsigned sum, cnt, mine, sp = 0u;
  for (;;) {
    sum = 0u; cnt = 0u; mine = 0u;
#pragma unroll
    for (unsigned j = 0; j < 16; ++j) { const unsigned c = xb_ld(&bar[XB_XCNT(j)]); sum += c; cnt += (c > 0u) ? 1u : 0u; mine = (j == x) ? c : mine; }
    if (sum == G) break;
    __builtin_amdgcn_s_sleep(1);
    if ((++sp & 255u) == 0u) { if (xb_ld(&bar[XB_TMO])) break; if (sp > XB_SPIN_CAP) { atomicAdd(&bar[XB_TMO], 1u); break; } }
  }
  nloc = mine > 0u ? mine : 1u; nx = cnt > 0u ? cnt : 1u;
}
DEVI void xcd_barrier(const XcdBarrier& b, bool leader) {
  asm volatile("s_waitcnt vmcnt(0)" ::: "memory");
  __syncthreads();
  if (leader) {
    unsigned* bar = b.bar;
    __builtin_amdgcn_s_waitcnt(0);
    unsigned bx = xb_xcc_id(); asm volatile("" : "+s"(bx));
    unsigned nloc = b.st[0], nx = b.st[1];
    if (nloc == 0u) { xcd_barrier_complete(bar, bx, nloc, nx); b.st[0] = nloc; b.st[1] = nx; }
    const unsigned old = xb_add(&bar[XB_XSUB(bx)], 1u);
    const unsigned gen = old / nloc;
    if (old + 1u == (gen + 1u) * nloc) {
      __builtin_amdgcn_fence(__ATOMIC_RELEASE, "agent");
      asm volatile("s_waitcnt vmcnt(0)" ::: "memory");
      const unsigned og = xb_add(&bar[XB_TOP], 1u);
      const unsigned tg = og / nx;
      if (og + 1u == (tg + 1u) * nx) xb_add(&bar[XB_TOPGEN], 1u);
      else XB_SPIN(xb_ld(&bar[XB_TOPGEN]) == tg, bar);
      __builtin_amdgcn_fence(__ATOMIC_ACQUIRE, "agent");
      xb_add(&bar[XB_XGEN(bx)], 1u);
      asm volatile("s_waitcnt vmcnt(0)" ::: "memory");
    } else {
      XB_SPIN(xb_ld(&bar[XB_XGEN(bx)]) == gen, bar);
      __builtin_amdgcn_fence(__ATOMIC_ACQUIRE, "agent");
      asm volatile("s_waitcnt vmcnt(0)" ::: "memory");
    }
  }
  __syncthreads();
}

#define GSYNC() xcd_barrier(xb, otid(wv) == 0)
__global__ void __launch_bounds__(512, 2) mega_fwd(Params p) {
  cg::grid_group grid = cg::this_grid();
  const int wv = __builtin_amdgcn_readfirstlane((int)threadIdx.x >> 6);
  unsigned char* ws = p.ws;
  XcdBarrier xb; xb.bar = (unsigned*)(ws + WS_BAR); xb.x = xb_xcc_id(); xb.st = (volatile LAS unsigned*)((LAS unsigned char*)g_lds + 131072);
  if (threadIdx.x == 0) { xb.st[0] = 0u; xb.st[1] = 0u; (void)xb_add(&xb.bar[XB_XCNT(xb.x)], 1u); }
  grid.sync();
  bf16_t* XB = (bf16_t*)(ws + WS_XB);
  bf16_t* AO = (bf16_t*)(ws + WS_AO);
  unsigned char* OV = ws + WS_OV;

#ifndef PM
#define PM 0xff
#endif
#ifndef DUP
#define DUP 0
#endif
  if (PM & 1) prologue(p, (char*)g_lds, wv);
  GSYNC();
#if (DUP & 32)
  prologue(p, (char*)g_lds, wv);
  GSYNC();
#endif

  { const int gtid = blockIdx.x * 512 + otid(wv);
    for (int i = gtid; i < 4 * 14336; i += gridDim.x * 512) {
      const int l = i / 14336, c = i % 14336;
      if (c < 6144 && !(l & 1)) continue;
      const float* pp = (const float*)(ws + WS_UVP) + (size_t)l * 16 * 16384 + c;
      float acc = 0.f;
#pragma unroll
      for (int kt = 0; kt < 16; ++kt) acc += pp[(size_t)kt * 16384];
      ((float*)(ws + WS_UV))[(size_t)l * 16384 + c] = acc;
    } }
#pragma unroll 1
  for (int l = 0; l < 4; ++l) {
    const bf16_t* wl = (const bf16_t*)(ws + WS_WT + (size_t)l * WT_LAYER);
    const int e = l >> 1;
    const bool odd = (l & 1) != 0;
    bf16_t* Hg = (bf16_t*)(OV + OV_HG); bf16_t* vT = (bf16_t*)(OV + OV_VT); bf16_t* kT = (bf16_t*)(OV + OV_KT);
    float* Ubuf = (float*)(OV + OV_U); float* decay = (float*)(ws + WS_DEC); float* Dseg = (float*)(ws + WS_DSEG);
#pragma unroll 1
    for (int st = 0; st < 9; ++st) {
      if (!odd && (st == 2 || st == 3)) continue;
      if (st == 5 || (st == 8 && l != 3)) {
        stat_finalize((const float*)(ws + WS_STATS) + (st == 8 ? 1048576 : 0), (float*)(ws + WS_MR) + (st == 8 ? 65536 : 0), wv);
        GSYNC();
        continue;
      }
      if (st == 0 || st == 4 || st == 6 || st == 7) {
        EpiArgs ea{};
        const bf16_t* A; const bf16_t* Bt; int N, K;
        const float* uv = (const float*)(ws + WS_UV) + (size_t)l * 16384;
        float* stats = (float*)(ws + WS_STATS);
        const float* mrb = (const float*)(ws + WS_MR);
        if (st == 0) {
          A = XB; Bt = wl; N = 3072; K = 1024;
          if (odd) { ea.stat_in = mrb + 65536; ea.u = uv + UV_U_IN; ea.v = uv + UV_V_IN; }
          else if (l > 0) { ln_bf16_phase(XB, AO, p.in[14] + (l - 1) * 1024, p.in[15] + (l - 1) * 1024, wv); GSYNC(); A = AO; }
          if (odd) { ea.kind = EPI_GLA; ea.H = Hg; ea.vt0 = vT; }
          else { ea.kind = EPI_EVEN; ea.H = (bf16_t*)(OV + OV_H); ea.vt0 = (bf16_t*)(OV + OV_DVT); ea.vt1 = (bf16_t*)(OV + OV_MVT); ea.kmsum = (float*)(ws + WS_KM) + (size_t)e * 65536; }
        } else if (st == 4) {
          A = AO; Bt = wl + 3 * 1024 * 1024; N = 1024; K = 1024; ea.kind = EPI_RES; ea.Y = XB; ea.X = p.X;
          if (l > 0) { ea.stat_prev = mrb + 65536; ea.gprev = p.in[14] + (l - 1) * 1024; ea.bprev = p.in[15] + (l - 1) * 1024; }
          ea.stat_new = stats;
        } else if (st == 6) {
          A = XB; Bt = wl + 4 * 1024 * 1024; N = 4096; K = 1024; ea.kind = EPI_FFN1; ea.Hff = (bf16_t*)OV;
          ea.stat_in = mrb; ea.u = uv + UV_U_F1; ea.v = uv + UV_V_F1;
        } else {
          A = (const bf16_t*)OV; Bt = wl + 8 * 1024 * 1024; N = 1024; K = 4096; ea.kind = EPI_RES; ea.Y = XB; ea.X = p.X;
          ea.stat_prev = mrb; ea.gprev = p.in[10] + l * 1024; ea.bprev = p.in[11] + l * 1024;
          ea.stat_new = stats + 1048576; ea.final_out = (l == 3);
        }
        if (PM & 2) gemm_phase(A, Bt, N, K, ea, wv);
#if (DUP & 2)
        if (st == 6) { GSYNC(); gemm_phase(A, Bt, N, K, ea, wv); }
#endif
      } else if (st == 1) {
        if (odd) {
#pragma unroll 1
          for (int it = blockIdx.x; it < 512; it += gridDim.x)
            if (PM & 8) gla_prep_item(it, XB, (const bf16_t*)(ws + WS_WGD) + (size_t)e * 16384, p.in[6] + e * 8192, p.in[7] + e * 512, Hg, kT, decay,
                                      (const float*)(ws + WS_MR) + 65536, (const float*)(ws + WS_UV) + (size_t)l * 16384 + UV_U_GD, (const float*)(ws + WS_UV) + (size_t)l * 16384 + UV_V_GD, wv);
        } else {
          if (PM & 4) attn_phase(p, e, wv);
#if (DUP & 1)
          GSYNC(); attn_phase(p, e, wv);
#endif
        }
      } else if (st == 2) {
#pragma unroll 1
        for (int it = blockIdx.x; it < 256; it += gridDim.x) if (PM & 16) gla_scan_item<0>(it, Hg, vT, kT, decay, Ubuf, Dseg, AO, p.in[8] + e * 256, wv);
#if (DUP & 4)
        GSYNC();
        for (int it = blockIdx.x; it < 256; it += gridDim.x) gla_scan_item<0>(it, Hg, vT, kT, decay, Ubuf, Dseg, AO, p.in[8] + e * 256, wv);
#endif
      } else if (st == 3) {
#pragma unroll 1
        for (int it = blockIdx.x; it < 256; it += gridDim.x) if (PM & 32) gla_scan_item<1>(it, Hg, vT, kT, decay, Ubuf, Dseg, AO, p.in[8] + e * 256, wv);
#if (DUP & 8)
        GSYNC();
        for (int it = blockIdx.x; it < 256; it += gridDim.x) gla_scan_item<1>(it, Hg, vT, kT, decay, Ubuf, Dseg, AO, p.in[8] + e * 256, wv);
#endif
      } else {
        if (PM & 64) ln_phase(p.X, XB, p.in[14] + l * 1024, p.in[15] + l * 1024, true, wv);
      }
      GSYNC();
#if (DUP & 16)
      GSYNC();
#endif
    }
  }
}

extern "C" void kernel_launch(void* const* d_in, const int* in_sizes, int n_in, void* d_out, int out_size, void* d_ws, size_t ws_size,
                              hipStream_t stream) {
  constexpr int LDS_BYTES = 131072 + 64;
  static int grid = 0;
  if (grid == 0) {
    if (n_in != 16 || out_size != NTOK * DM || ws_size < WS_END) {
      fprintf(stderr, "kernel_launch: unexpected shapes (n_in %d out %d ws %zu need %zu)\n", n_in, out_size, ws_size, (size_t)WS_END);
      grid = -1; return;
    }
    int dev = 0, cus = 0, per_cu = 0;
    hipGetDevice(&dev);
    hipDeviceGetAttribute(&cus, hipDeviceAttributeMultiprocessorCount, dev);
    hipFuncSetAttribute((const void*)mega_fwd, hipFuncAttributeMaxDynamicSharedMemorySize, LDS_BYTES);
    hipOccupancyMaxActiveBlocksPerMultiprocessor(&per_cu, (const void*)mega_fwd, 512, LDS_BYTES);
    if (per_cu < 1) per_cu = 1;
    grid = cus * per_cu;
    if (grid > 256) grid = 256;
    (void)hipGetLastError();
  }
  if (grid < 0) return;
  if (hipMemsetAsync((char*)d_ws + WS_BAR, 0, 16384, stream) != hipSuccess) { fprintf(stderr, "kernel_launch: memset of barrier words failed\n"); return; }
  Params p{};
  for (int i = 0; i < 16; ++i) p.in[i] = (const float*)d_in[i];
  p.X = (float*)d_out;
  p.ws = (unsigned char*)d_ws;
  void* args[] = {&p};
  hipError_t err = hipLaunchCooperativeKernel((const void*)mega_fwd, dim3(grid), dim3(512), args, LDS_BYTES, stream);
  if (err != hipSuccess) fprintf(stderr, "cooperative launch failed: %s (grid %d)\n", hipGetErrorString(err), grid);
}
```

```cpp
#include <hip/hip_runtime.h>
#include <hip/hip_cooperative_groups.h>
#include <cstdio>
#include <cstdint>
namespace cg = cooperative_groups;

typedef unsigned short bf16_t;
typedef short bf16x8 __attribute__((ext_vector_type(8)));
typedef float f32x4 __attribute__((ext_vector_type(4)));
typedef float f32x16 __attribute__((ext_vector_type(16)));
typedef unsigned u32x2 __attribute__((ext_vector_type(2)));
typedef unsigned u32x4 __attribute__((ext_vector_type(4)));

#define DEVI __device__ __forceinline__
#define NEG_INF (-__builtin_inff())

constexpr int SEQ = 8192, NTOK = 32768, DM = 1024;
constexpr float DN_ALPHA = 1.681792830507429f;

constexpr size_t MiB = 1024ull * 1024ull;
constexpr size_t WS_WT    = 4096;
constexpr size_t WT_LAYER = 24 * MiB;
constexpr size_t WS_WGD   = WS_WT + 4 * WT_LAYER;
constexpr size_t WS_XB    = WS_WGD + 65536;
constexpr size_t WS_AO    = WS_XB + 64 * MiB;
constexpr size_t WS_OV    = WS_AO + 64 * MiB;
constexpr size_t WS_KM    = WS_OV + 256 * MiB;
constexpr size_t WS_DEC   = WS_KM + 524288;
constexpr size_t WS_DSEG  = WS_DEC + 1 * MiB;
constexpr size_t WS_BAR   = WS_DSEG + 131072;
constexpr size_t WS_STATS = WS_BAR + 16384;
constexpr size_t WS_MR    = WS_STATS + 8 * MiB;
constexpr size_t WS_UV    = WS_MR + 524288;
constexpr size_t WS_UVP   = WS_UV + 262144;
constexpr size_t WS_END   = WS_UVP + 4 * MiB;
constexpr int UV_U_IN = 0, UV_V_IN = 3072, UV_U_F1 = 6144, UV_V_F1 = 10240, UV_U_GD = 14336, UV_V_GD = 14352;
constexpr size_t OV_H   = 0;
constexpr size_t OV_DVT = 192 * MiB;
constexpr size_t OV_MVT = 224 * MiB;
constexpr size_t OV_HG  = 0;
constexpr size_t OV_VT  = 128 * MiB;
constexpr size_t OV_KT  = 192 * MiB;
constexpr size_t OV_U   = 224 * MiB;

struct Params {
  const float* in[16];
  float* X;
  unsigned char* ws;
};

typedef __bf16 bf16x2_t __attribute__((ext_vector_type(2)));
DEVI unsigned pk_bf16(float lo, float hi) { bf16x2_t v = {(__bf16)lo, (__bf16)hi}; return __builtin_bit_cast(unsigned, v); }
DEVI bf16_t f2bf(float f) { return (bf16_t)(pk_bf16(f, 0.f) & 0xffffu); }
DEVI float bf2f(bf16_t v) { return __uint_as_float(((unsigned)v) << 16); }
DEVI float bflo(unsigned u) { return __uint_as_float(u << 16); }
DEVI float bfhi(unsigned u) { return __uint_as_float(u & 0xffff0000u); }
DEVI bf16x8 mk8(unsigned a, unsigned b, unsigned c, unsigned d) { u32x4 v = {a, b, c, d}; return __builtin_bit_cast(bf16x8, v); }
DEVI bf16x8 pack8(const f32x16& x, int s) {
  return s == 0 ? mk8(pk_bf16(x[0], x[1]), pk_bf16(x[2], x[3]), pk_bf16(x[4], x[5]), pk_bf16(x[6], x[7]))
                : mk8(pk_bf16(x[8], x[9]), pk_bf16(x[10], x[11]), pk_bf16(x[12], x[13]), pk_bf16(x[14], x[15]));
}
DEVI f32x16 mfma32(bf16x8 a, bf16x8 b, f32x16 c) { return __builtin_amdgcn_mfma_f32_32x32x16_bf16(a, b, c, 0, 0, 0); }
DEVI f32x4 mfma16(bf16x8 a, bf16x8 b, f32x4 c) { return __builtin_amdgcn_mfma_f32_16x16x32_bf16(a, b, c, 0, 0, 0); }
DEVI float ex2(float x) { return __builtin_amdgcn_exp2f(x); }

template <int X> DEVI float swz_xor(float v) { return __int_as_float(__builtin_amdgcn_ds_swizzle(__float_as_int(v), (X << 10) | 0x1f)); }
DEVI void halves(float v, float& lo, float& hi) {
  auto r = __builtin_amdgcn_permlane32_swap(__float_as_uint(v), __float_as_uint(v), false, false);
  lo = __uint_as_float(r[0]); hi = __uint_as_float(r[1]);
}
DEVI void halves_i(int v, int& lo, int& hi) {
  auto r = __builtin_amdgcn_permlane32_swap((unsigned)v, (unsigned)v, false, false);
  lo = (int)r[0]; hi = (int)r[1];
}
DEVI float hsum(float v) { float a, b; halves(v, a, b); return a + b; }
DEVI float hmax(float v) { float a, b; halves(v, a, b); return fmaxf(a, b); }
DEVI float sum16(float v) { v += swz_xor<1>(v); v += swz_xor<2>(v); v += swz_xor<4>(v); v += swz_xor<8>(v); return v; }
DEVI float sum64(float v) { v = sum16(v); v += swz_xor<16>(v); return hsum(v); }

DEVI u32x4 widen_pair(u32x2 a0, u32x2 a1, int h) {
  const unsigned sx = h ? a0[0] : a1[0], sy = h ? a0[1] : a1[1];
  const auto rx = __builtin_amdgcn_permlane32_swap(sx, sx, false, false);
  const auto ry = __builtin_amdgcn_permlane32_swap(sy, sy, false, false);
  const unsigned px = h ? rx[0] : rx[1], py = h ? ry[0] : ry[1];
  return h ? (u32x4){px, py, a1[0], a1[1]} : (u32x4){a0[0], a0[1], px, py};
}
DEVI int otid(int wv) { int t = wv * 64 + (int)__builtin_amdgcn_mbcnt_hi(~0u, __builtin_amdgcn_mbcnt_lo(~0u, 0u)); asm volatile("" : "+v"(t)); return t; }

constexpr double cexp_pos(double x) { double s = 1.0, t = 1.0; for (int i = 1; i < 100; ++i) { t *= x / i; s += t; } return s; }
constexpr float rope_inv(int p, int dim) { return (float)(1.0 / cexp_pos((2.0 * p / dim) * 9.210340371976184)); }
struct RopeTab { float d[32]; float m[64]; };
constexpr RopeTab make_rope_tab() { RopeTab t{}; for (int p = 0; p < 32; ++p) t.d[p] = rope_inv(p, 64); for (int p = 0; p < 64; ++p) t.m[p] = rope_inv(p, 128); return t; }
__device__ const RopeTab g_rope = make_rope_tab();

DEVI void sincos_f(float a, float& s, float& c) {
  float n = rintf(a * 0.636619772367581343f);
  float r = fmaf(-n, 1.5703125f, a);
  r = fmaf(-n, 4.837512969970703125e-4f, r);
  r = fmaf(-n, 7.54978995489188216e-8f, r);
  float r2 = r * r;
  float sp = r + r * r2 * (-1.66666667e-1f + r2 * (8.33333333e-3f + r2 * (-1.98412698e-4f + r2 * 2.75573192e-6f)));
  float cp = 1.f + r2 * (-0.5f + r2 * (4.16666667e-2f + r2 * (-1.38888889e-3f + r2 * (2.48015873e-5f + r2 * (-2.75573192e-7f)))));
  int q = ((int)n) & 3;
  float ss = (q & 1) ? cp : sp, cc = (q & 1) ? sp : cp;
  s = (q & 2) ? -ss : ss;
  c = ((q + 1) & 2) ? -cc : cc;
}

DEVI int perm_even(int c) {
  const int sec = c >> 9, cl = c & 511;
  if (sec == 0 || sec == 1) { const int mm = cl >> 6, j = cl & 63, second = j >> 5, p = j & 31; return sec * 512 + mm * 64 + (p >> 4) * 32 + second * 16 + (p & 15); }
  if (sec == 3 || sec == 4) { const int hh = cl >> 7, j = cl & 127, second = j >> 6, p = j & 63; return sec * 512 + hh * 128 + (p >> 4) * 32 + second * 16 + (p & 15); }
  return c;
}

DEVI int perm32_row(int c) {
  const int x = c & 31; return (c & ~31) + ((x >> 2) & 1) * 16 + (x >> 3) * 4 + (x & 3);
}
struct WJob { const float* W; int ldw; bf16_t* Wt; int K, k0, c0, perm; const float* gvec; const float* bvec; float* uvec; float* vvec; };
DEVI void wjob_load(const WJob& j, int t, f32x4& a, f32x4& b) {
  const float* src = j.W + (size_t)(j.k0 + (t >> 3)) * j.ldw + j.c0 + (t & 7) * 8;
  a = *(const f32x4*)src; b = *(const f32x4*)(src + 4);
}
DEVI void wtrans_tile(const WJob& jw, f32x4 a, f32x4 b, char* lds, int t) {
  bf16_t* Wt = jw.Wt; const int K = jw.K, k0 = jw.k0, c0 = jw.c0, perm = jw.perm;
  const float* gvec = jw.gvec; const float* bvec = jw.bvec; float* uvec = jw.uvec; float* vvec = jw.vvec;
  bf16_t* tl = (bf16_t*)lds;
  float* suw = (float*)(lds + 9216);
  const bool fold = gvec != nullptr;
  { const int kr = t >> 3, cc = (t & 7) * 8;
    if (fold) {
      const float gk = gvec[k0 + kr], bk = bvec[k0 + kr];
      float ua[8], va[8];
#pragma unroll
      for (int i = 0; i < 4; ++i) {
        const bf16_t ra = f2bf(a[i] * gk), rb = f2bf(b[i] * gk);
        tl[(cc + i) * 66 + kr] = ra; tl[(cc + 4 + i) * 66 + kr] = rb;
        ua[i] = bf2f(ra); ua[4 + i] = bf2f(rb); va[i] = a[i] * bk; va[4 + i] = b[i] * bk;
      }
#pragma unroll
      for (int i = 0; i < 8; ++i) {
        float x = ua[i], y = va[i];
        x += swz_xor<8>(x); y += swz_xor<8>(y);
        x += swz_xor<16>(x); y += swz_xor<16>(y);
        x = hsum(x); y = hsum(y);
        if ((t & 63) < 8) { suw[(t >> 6) * 128 + cc + i] = x; suw[(t >> 6) * 128 + 64 + cc + i] = y; }
      }
    } else {
#pragma unroll
      for (int i = 0; i < 4; ++i) { tl[(cc + i) * 66 + kr] = f2bf(a[i]); tl[(cc + 4 + i) * 66 + kr] = f2bf(b[i]); }
    } }
  __syncthreads();
  { const int c = t >> 3, kc = (t & 7) * 8;
    const unsigned* rp = (const unsigned*)(tl + c * 66 + kc);
    const u32x4 v = {rp[0], rp[1], rp[2], rp[3]};
    const int g = perm == 1 ? perm_even(c0 + c) : (perm == 2 || (perm == 3 && ((c0 + c) < 1024 || (c0 + c) >= 2048)) ? perm32_row(c0 + c) : (c0 + c));
    *(u32x4*)(Wt + (size_t)g * K + k0 + kc) = v; }
  if (fold && t < 128) {
    float acc = 0.f;
#pragma unroll
    for (int w8 = 0; w8 < 8; ++w8) acc += suw[w8 * 128 + t];
    const int c = t & 63;
    const int g = perm == 1 ? perm_even(c0 + c) : (perm == 2 || (perm == 3 && ((c0 + c) < 1024 || (c0 + c) >= 2048)) ? perm32_row(c0 + c) : (c0 + c));
    ((t < 64 ? uvec : vvec) + (size_t)(k0 >> 6) * 16384)[g] = acc;
  }
  __syncthreads();
}

DEVI void prologue(const Params& p, char* lds, int wv) {
  const int G = gridDim.x;
  unsigned char* ws = p.ws;
  auto decode = [&](int jb, WJob& j) {
    const int l = jb / 3072; int rem = jb % 3072;
    bf16_t* wl = (bf16_t*)(ws + WS_WT + (size_t)l * WT_LAYER);
    float* uv = (float*)(ws + WS_UVP) + (size_t)l * 16 * 16384;
    j.gvec = nullptr; j.bvec = nullptr; j.uvec = nullptr; j.vvec = nullptr;
    if (rem < 768) {
      const int kt = rem / 48, ct = rem % 48;
      j.K = 1024; j.k0 = kt * 64; j.c0 = ct * 64; j.Wt = wl;
      if (l & 1) { j.W = p.in[5] + (size_t)(l >> 1) * 1024 * 3088; j.ldw = 3088; j.perm = 3; j.gvec = p.in[14] + (l - 1) * 1024; j.bvec = p.in[15] + (l - 1) * 1024; j.uvec = uv + UV_U_IN; j.vvec = uv + UV_V_IN; }
      else       { j.W = p.in[1] + (size_t)(l >> 1) * 1024 * 3072; j.ldw = 3072; j.perm = 1; }
    } else if (rem < 1024) {
      rem -= 768; const int kt = rem / 16, ct = rem % 16;
      j.W = (l & 1) ? p.in[9] + (size_t)(l >> 1) * 1024 * 1024 : p.in[4] + (size_t)(l >> 1) * 1024 * 1024;
      j.ldw = 1024; j.Wt = wl + 3 * 1024 * 1024; j.K = 1024; j.k0 = kt * 64; j.c0 = ct * 64; j.perm = 2;
    } else if (rem < 2048) {
      rem -= 1024; const int kt = rem / 64, ct = rem % 64;
      j.W = p.in[12] + (size_t)l * 1024 * 4096; j.ldw = 4096; j.Wt = wl + 4 * 1024 * 1024; j.K = 1024; j.k0 = kt * 64; j.c0 = ct * 64; j.perm = 2;
      j.gvec = p.in[10] + l * 1024; j.bvec = p.in[11] + l * 1024; j.uvec = uv + UV_U_F1; j.vvec = uv + UV_V_F1;
    } else {
      rem -= 2048; const int kt = rem / 16, ct = rem % 16;
      j.W = p.in[13] + (size_t)l * 4096 * 1024; j.ldw = 1024; j.Wt = wl + 8 * 1024 * 1024; j.K = 4096; j.k0 = kt * 64; j.c0 = ct * 64; j.perm = 2;
    }
  };
  { const int tw = otid(wv);
    int jb = blockIdx.x;
    WJob cur{}, nxt{}; f32x4 ca = {}, cbv = {}, na = {}, nb = {};
    if (jb < 4 * 3072) { decode(jb, cur); wjob_load(cur, tw, ca, cbv); }
#pragma unroll 1
    while (jb < 4 * 3072) {
      const int jn = jb + G;
      if (jn < 4 * 3072) { decode(jn, nxt); wjob_load(nxt, tw, na, nb); }
      wtrans_tile(cur, ca, cbv, lds, tw);
      cur = nxt; ca = na; cbv = nb; jb = jn;
    } }
  const int gt = blockIdx.x * 512 + otid(wv), GT = G * 512;
  { const int t = otid(wv); const int gw = blockIdx.x * 8 + (t >> 6), lane = t & 63;
    if (gw < 32) {
      const int o = gw >> 4, rr = gw & 15, lsrc = 2 * o;
      const float* gv = p.in[14] + lsrc * 1024; const float* bv = p.in[15] + lsrc * 1024;
      float us = 0.f, vs = 0.f;
      for (int k = lane; k < 1024; k += 64) {
        const float wgt = p.in[5][(size_t)o * 1024 * 3088 + (size_t)k * 3088 + 3072 + rr];
        const bf16_t rb = f2bf(wgt * gv[k]);
        ((bf16_t*)(ws + WS_WGD))[(o * 16 + rr) * 1024 + k] = rb;
        us += bf2f(rb); vs += wgt * bv[k];
      }
      us = sum64(us); vs = sum64(vs);
      if (lane == 0) { float* uv = (float*)(ws + WS_UV) + (size_t)(2 * o + 1) * 16384; uv[UV_U_GD + rr] = us; uv[UV_V_GD + rr] = vs; }
    } }
  for (int i = gt; i < 131072; i += GT) ((float*)(ws + WS_KM))[i] = 0.f;
  for (int i = gt; i < NTOK * DM / 8; i += 4 * GT) {
    f32x4 a[4], b[4];
#pragma unroll
    for (int k = 0; k < 4; ++k) { if (i + k * GT < NTOK * DM / 8) { const size_t e8 = (size_t)(i + k * GT) * 8; a[k] = *(const f32x4*)(p.in[0] + e8); b[k] = *(const f32x4*)(p.in[0] + e8 + 4); } }
#pragma unroll
    for (int k = 0; k < 4; ++k) {
      if (i + k * GT < NTOK * DM / 8) {
        u32x4 v = {pk_bf16(a[k][0], a[k][1]), pk_bf16(a[k][2], a[k][3]), pk_bf16(b[k][0], b[k][1]), pk_bf16(b[k][2], b[k][3])};
        *(u32x4*)((bf16_t*)(ws + WS_XB) + (size_t)(i + k * GT) * 8) = v;
      }
    }
  }
}

#define LAS __attribute__((address_space(3)))
constexpr int BM = 256, BK = 64, HALF = 128, HTB = HALF * BK * 2, NXCD = 8, WGM = 4;
DEVI int lds_byte(int r, int c) { const int st = (r >> 4) * 2 + (c >> 5), rr = r & 15, cc = c & 31, ob = rr * 64 + cc * 2; return st * 1024 + (ob ^ (((ob >> 9) & 1) << 5)); }
DEVI void stage_rc(int b, int& R, int& C) { const int st = b / 1024, sb = b % 1024, swz = sb ^ (((sb >> 9) & 1) << 5); R = (st >> 1) * 16 + swz / 64; C = (st & 1) * 32 + (swz % 64) / 2; }

enum { EPI_EVEN = 0, EPI_GLA = 1, EPI_RES = 2, EPI_FFN1 = 3 };
struct EpiArgs {
  int kind;
  bf16_t* H; bf16_t* vt0; bf16_t* vt1; float* kmsum;
  bf16_t* Hff;
  const float* stat_in; const float* u; const float* v;
  bf16_t* Y; float* X;
  const float* stat_prev; const float* gprev; const float* bprev;
  float* stat_new; int final_out;
};
DEVI void row_sums(const float* raw, int row, float& s1, float& s2) {
  typedef float f32x2 __attribute__((ext_vector_type(2)));
  float a1 = 0.f, a2 = 0.f;
#pragma unroll
  for (int k = 0; k < 16; ++k) { const f32x2 p = *(const f32x2*)(raw + (size_t)k * 65536 + 2 * row); a1 += p[0]; a2 += p[1]; }
  s1 = a1; s2 = a2;
}
DEVI void stat_finalize(const float* raw, float* mr, int wv) {
  for (int row = blockIdx.x * 512 + otid(wv); row < NTOK; row += gridDim.x * 512) {
    float s1, s2; row_sums(raw, row, s1, s2);
    const float mu = s1 * (1.f / 1024.f);
    const float var = fmaxf(s2 * (1.f / 1024.f) - mu * mu, 0.f);
    mr[2 * row] = mu; mr[2 * row + 1] = rsqrtf(var + 1e-5f);
  }
}
DEVI void row_mu_rstd(const float* mr, int row, float& mu, float& rstd) { mu = mr[2 * row]; rstd = mr[2 * row + 1]; }
struct Unit { int brow, bcol, swap; };

DEVI bool unit_next(int i, int nN, int kind, Unit& u) {
  const int nM = NTOK / BM, nwg = nM * nN;
  const long L = (long)i * gridDim.x + blockIdx.x;
  if (L >= nwg) return false;
  int wgid = (int)L;
  { const int q = nwg / NXCD, r = nwg % NXCD, xcd = wgid % NXCD, off = wgid / NXCD; wgid = (xcd < r ? xcd * (q + 1) : r * (q + 1) + (xcd - r) * q) + off; }
  const int nig = WGM * nN, gid = wgid / nig, fm = gid * WGM, gsz = (nM - fm) < WGM ? (nM - fm) : WGM;
  const int pm = fm + ((wgid % nig) % gsz), pn = (wgid % nig) / gsz;
  u.brow = pm * BM; u.bcol = pn * BM;
  const int sec = u.bcol >> 9;
  u.swap = (kind == EPI_EVEN && (sec == 2 || sec == 5)) || (kind == EPI_GLA && (sec == 2 || sec == 3));
  return true;
}

DEVI void acc_init(f32x4 (&acc)[2][2][4][2], const Unit& un, int wr, int wc, int fr, int fq, const EpiArgs& e) {
  if (!e.stat_in) {
#pragma unroll
    for (int a = 0; a < 2; ++a)
#pragma unroll
      for (int b = 0; b < 2; ++b)
#pragma unroll
        for (int m = 0; m < 4; ++m)
#pragma unroll
          for (int n = 0; n < 2; ++n) acc[a][b][m][n] = (f32x4){0.f, 0.f, 0.f, 0.f};
  } else if (!un.swap) {
    float nmu[8];
#pragma unroll
    for (int q = 0; q < 8; ++q) nmu[q] = -e.stat_in[2 * (un.brow + (q >> 2) * 128 + wr * 64 + (q & 3) * 16 + fr)];
#pragma unroll
    for (int bj = 0; bj < 2; ++bj)
#pragma unroll
      for (int n = 0; n < 2; ++n) {
        const f32x4 u4 = *(const f32x4*)(e.u + un.bcol + bj * 128 + wc * 32 + n * 16 + 4 * fq);
#pragma unroll
        for (int q = 0; q < 8; ++q) acc[q >> 2][bj][q & 3][n] = u4 * nmu[q];
      }
  } else {
    float uc[8];
#pragma unroll
    for (int q = 0; q < 8; ++q) uc[q] = e.u[un.bcol + (q >> 2) * 128 + wr * 64 + (q & 3) * 16 + fr];
#pragma unroll
    for (int bj = 0; bj < 2; ++bj)
#pragma unroll
      for (int n = 0; n < 2; ++n) {
        const int tok = un.brow + bj * 128 + wc * 32 + n * 16 + 4 * fq;
        const f32x4 sa = *(const f32x4*)(e.stat_in + 2 * tok), sb = *(const f32x4*)(e.stat_in + 2 * tok + 4);
        const f32x4 nmu = {-sa[0], -sa[2], -sb[0], -sb[2]};
#pragma unroll
        for (int q = 0; q < 8; ++q) acc[q >> 2][bj][q & 3][n] = nmu * uc[q];
      }
  }
}
DEVI float row_rstd(const float* mr, int row) { return mr[2 * row + 1]; }
DEVI f32x4 rstd4(const float* mr, int tok) {
  const f32x4 sa = *(const f32x4*)(mr + 2 * tok), sb = *(const f32x4*)(mr + 2 * tok + 4);
  return (f32x4){sa[1], sa[3], sb[1], sb[3]};
}

template <bool FOLD>
DEVI void epi_vt(const f32x4 (&acc)[2][2][4][2], bf16_t* vt, int chan0, int tok0, int nchan, int wr, int wc, int fr, int fq, const EpiArgs& e, int gcol0) {
  const int b = tok0 >> 13, s0 = tok0 & 8191;
  f32x4 rs[2][2];
#pragma unroll
  for (int bj = 0; bj < 2; ++bj)
#pragma unroll
    for (int n = 0; n < 2; ++n) { if (FOLD) rs[bj][n] = rstd4(e.stat_in, tok0 + bj * 128 + wc * 32 + n * 16 + 4 * fq); else rs[bj][n] = (f32x4){1.f, 1.f, 1.f, 1.f}; }
  float vcs[8];
#pragma unroll
  for (int q = 0; q < 8; ++q) { if (FOLD) vcs[q] = e.v[gcol0 + (q >> 2) * 128 + wr * 64 + (q & 3) * 16 + fr]; else vcs[q] = 0.f; }
#pragma unroll
  for (int ai = 0; ai < 2; ++ai)
#pragma unroll
    for (int m = 0; m < 4; ++m) {
      bf16_t* rowp = (bf16_t*)((char*)vt + ((unsigned)(b * nchan + chan0 + ai * 128 + wr * 64 + m * 16 + fr) * 8192u + (unsigned)(s0 + wc * 32 + 4 * fq)) * 2u);
      const float vc = vcs[ai * 4 + m];
#pragma unroll
      for (int bj = 0; bj < 2; ++bj)
#pragma unroll
        for (int n = 0; n < 2; ++n) {
          const f32x4 v = acc[ai][bj][m][n] * rs[bj][n] + vc;
          u32x2 w2 = {pk_bf16(v[0], v[1]), pk_bf16(v[2], v[3])};
          *(u32x2*)(rowp + bj * 128 + n * 16) = w2;
        }
    }
}

DEVI void epi_even(const f32x4 (&acc)[2][2][4][2], const Unit& u, int wr, int wc, int fr, int fq, const EpiArgs& e) {
  const int sec = u.bcol >> 9;
  if (u.swap) { epi_vt<false>(acc, sec == 2 ? e.vt0 : e.vt1, u.bcol & 511, u.brow, 512, wr, wc, fr, fq, e, u.bcol); return; }
  const bool moba = sec >= 3;
  const int b = u.brow >> 13, sb = u.brow & 8191;
#pragma unroll
  for (int bj = 0; bj < 2; ++bj) {
    const int gl = (u.bcol & 511) + bj * 128 + wc * 32;
    int p0, c1, half;
    if (!moba) { const int mm = gl >> 6, grp = (gl >> 5) & 1; p0 = grp * 16 + 4 * fq; c1 = sec * 512 + mm * 64 + p0; half = 32; }
    else       { const int hh = gl >> 7, grp = (gl >> 5) & 3; p0 = grp * 16 + 4 * fq; c1 = sec * 512 + hh * 128 + p0; half = 64; }
    const f32x4 inv = moba ? *(const f32x4*)(g_rope.m + p0) : *(const f32x4*)(g_rope.d + p0);
    f32x4 ks1 = {0.f, 0.f, 0.f, 0.f}, ks2 = {0.f, 0.f, 0.f, 0.f};
#pragma unroll
    for (int ai = 0; ai < 2; ++ai)
#pragma unroll
      for (int m = 0; m < 4; ++m) {
        const int row = u.brow + ai * 128 + wr * 64 + m * 16 + fr;
        const float pos = (float)(row & 8191);
        const f32x4 x1 = acc[ai][bj][m][0], x2 = acc[ai][bj][m][1];
        f32x4 y1, y2;
#pragma unroll
        for (int j = 0; j < 4; ++j) {
          float sn, cs; sincos_f(pos * inv[j], sn, cs);
          y1[j] = x1[j] * cs - x2[j] * sn; y2[j] = x2[j] * cs + x1[j] * sn;
        }
        u32x2 w1 = {pk_bf16(y1[0], y1[1]), pk_bf16(y1[2], y1[3])}, w2 = {pk_bf16(y2[0], y2[1]), pk_bf16(y2[2], y2[3])};
        const unsigned hoff = (unsigned)row * 6144u + (unsigned)c1 * 2u;
        *(u32x2*)((char*)e.H + hoff) = w1;
        *(u32x2*)((char*)e.H + hoff + (unsigned)half * 2u) = w2;
        ks1 += y1; ks2 += y2;
        __builtin_amdgcn_sched_barrier(0);
      }
    if (sec == 4) {
#pragma unroll
      for (int j = 0; j < 4; ++j) {
        float a = ks1[j], c = ks2[j];
        a = sum16(a); c = sum16(c);
        if (fr == 0) {
          float* kp = e.kmsum + (size_t)(b * 32 + (sb >> 8)) * 512 + (c1 - 2048) + j;
          atomicAdd(kp, a); atomicAdd(kp + 64, c);
        }
      }
    }
  }
}

DEVI void epi_gla(const f32x4 (&acc)[2][2][4][2], const Unit& u, int wr, int wc, int fr, int fq, const EpiArgs& e) {
  if (u.swap) { epi_vt<true>(acc, e.vt0, u.bcol - 1024, u.brow, 1024, wr, wc, fr, fq, e, u.bcol); return; }
  const int cb = (u.bcol < 1024) ? u.bcol : u.bcol - 1024;
  f32x4 v4[2][2];
#pragma unroll
  for (int bj = 0; bj < 2; ++bj)
#pragma unroll
    for (int n = 0; n < 2; ++n) v4[bj][n] = *(const f32x4*)(e.v + u.bcol + bj * 128 + wc * 32 + n * 16 + 4 * fq);
  float rsq[8];
#pragma unroll
  for (int q = 0; q < 8; ++q) rsq[q] = row_rstd(e.stat_in, u.brow + (q >> 2) * 128 + wr * 64 + (q & 3) * 16 + fr);
#pragma unroll
  for (int ai = 0; ai < 2; ++ai)
#pragma unroll
    for (int m = 0; m < 4; ++m) {
      bf16_t* rowp = (bf16_t*)((char*)e.H + ((unsigned)(u.brow + ai * 128 + wr * 64 + m * 16 + fr) * 2048u + (unsigned)(cb + wc * 32 + 8 * fq)) * 2u);
      const float rsr = rsq[ai * 4 + m];
#pragma unroll
      for (int bj = 0; bj < 2; ++bj) {
        const f32x4 v0 = acc[ai][bj][m][0] * rsr + v4[bj][0], v1 = acc[ai][bj][m][1] * rsr + v4[bj][1];
        u32x4 w4 = {pk_bf16(v0[0], v0[1]), pk_bf16(v0[2], v0[3]), pk_bf16(v1[0], v1[1]), pk_bf16(v1[2], v1[3])};
        *(u32x4*)(rowp + bj * 128) = w4;
      }
    }
}

DEVI void epi_res(const f32x4 (&acc)[2][2][4][2], const Unit& u, int wr, int wc, int fr, int fq, const EpiArgs& e) {
  float mus[8], rsd[8]; f32x4 g4[2][2], b4[2][2];
  const bool ln = e.stat_prev != nullptr;
  if (ln) {
#pragma unroll
    for (int q = 0; q < 8; ++q) row_mu_rstd(e.stat_prev, u.brow + (q >> 2) * 128 + wr * 64 + (q & 3) * 16 + fr, mus[q], rsd[q]);
#pragma unroll
    for (int bj = 0; bj < 2; ++bj)
#pragma unroll
      for (int n = 0; n < 2; ++n) {
        const int c = u.bcol + bj * 128 + wc * 32 + 8 * fq + 4 * n;
        g4[bj][n] = *(const f32x4*)(e.gprev + c); b4[bj][n] = *(const f32x4*)(e.bprev + c);
      }
  } else {
#pragma unroll
    for (int q = 0; q < 8; ++q) { mus[q] = 0.f; rsd[q] = 1.f; }
#pragma unroll
    for (int bj = 0; bj < 2; ++bj)
#pragma unroll
      for (int n = 0; n < 2; ++n) { g4[bj][n] = (f32x4){1.f, 1.f, 1.f, 1.f}; b4[bj][n] = (f32x4){0.f, 0.f, 0.f, 0.f}; }
  }
#pragma unroll
  for (int ai = 0; ai < 2; ++ai)
#pragma unroll
    for (int m = 0; m < 4; ++m) {
      const int row = u.brow + ai * 128 + wr * 64 + m * 16 + fr;
      const unsigned o0 = (unsigned)row * 1024u + (unsigned)(u.bcol + wc * 32 + 8 * fq);
      const float mu = mus[ai * 4 + m], rstd = rsd[ai * 4 + m];
      u32x4 rb[2];
#pragma unroll
      for (int bj = 0; bj < 2; ++bj) rb[bj] = *(const u32x4*)((const char*)e.Y + (o0 + bj * 128) * 2u);
      float s1 = 0.f, s2 = 0.f;
#pragma unroll
      for (int bj = 0; bj < 2; ++bj) {
        const unsigned o = o0 + bj * 128;
        f32x4 r0 = {bflo(rb[bj][0]), bfhi(rb[bj][0]), bflo(rb[bj][1]), bfhi(rb[bj][1])};
        f32x4 r1 = {bflo(rb[bj][2]), bfhi(rb[bj][2]), bflo(rb[bj][3]), bfhi(rb[bj][3])};
        r0 = (r0 - mu) * rstd * g4[bj][0] + b4[bj][0];
        r1 = (r1 - mu) * rstd * g4[bj][1] + b4[bj][1];
        const f32x4 y0 = r0 * DN_ALPHA + acc[ai][bj][m][0], y1 = r1 * DN_ALPHA + acc[ai][bj][m][1];
        u32x4 w4 = {pk_bf16(y0[0], y0[1]), pk_bf16(y0[2], y0[3]), pk_bf16(y1[0], y1[1]), pk_bf16(y1[2], y1[3])};
        *(u32x4*)((char*)e.Y + o * 2u) = w4;
        if (e.final_out) { *(f32x4*)((char*)e.X + o * 4u) = y0; *(f32x4*)((char*)e.X + o * 4u + 16) = y1; }
        s1 += ((y0[0] + y0[1]) + (y0[2] + y0[3])) + ((y1[0] + y1[1]) + (y1[2] + y1[3]));
        s2 += ((y0[0] * y0[0] + y0[1] * y0[1]) + (y0[2] * y0[2] + y0[3] * y0[3])) + ((y1[0] * y1[0] + y1[1] * y1[1]) + (y1[2] * y1[2] + y1[3] * y1[3]));
      }
      s1 += swz_xor<16>(s1); s2 += swz_xor<16>(s2);
      s1 = hsum(s1); s2 = hsum(s2);
      if (fq == 0) { float* sp = e.stat_new + (size_t)((u.bcol >> 8) * 4 + wc) * 65536 + 2 * row; sp[0] = s1; sp[1] = s2; }
    }
}

DEVI void epi_ffn1(const f32x4 (&acc)[2][2][4][2], const Unit& u, int wr, int wc, int fr, int fq, const EpiArgs& e) {
  float rs[8]; f32x4 v4[2][2];
#pragma unroll
  for (int q = 0; q < 8; ++q) rs[q] = row_rstd(e.stat_in, u.brow + (q >> 2) * 128 + wr * 64 + (q & 3) * 16 + fr);
#pragma unroll
  for (int bj = 0; bj < 2; ++bj)
#pragma unroll
    for (int n = 0; n < 2; ++n) v4[bj][n] = *(const f32x4*)(e.v + u.bcol + bj * 128 + wc * 32 + n * 16 + 4 * fq);
#pragma unroll
  for (int ai = 0; ai < 2; ++ai)
#pragma unroll
    for (int m = 0; m < 4; ++m) {
      bf16_t* rowp = (bf16_t*)((char*)e.Hff + ((unsigned)(u.brow + ai * 128 + wr * 64 + m * 16 + fr) * 4096u + (unsigned)(u.bcol + wc * 32 + 8 * fq)) * 2u);
      const float rsr = rs[ai * 4 + m];
#pragma unroll
      for (int bj = 0; bj < 2; ++bj) {
        f32x4 v0 = acc[ai][bj][m][0] * rsr + v4[bj][0], v1 = acc[ai][bj][m][1] * rsr + v4[bj][1];
#pragma unroll
        for (int j = 0; j < 4; ++j) { const float t0 = fmaxf(v0[j], 0.f), t1 = fmaxf(v1[j], 0.f); v0[j] = t0 * t0; v1[j] = t1 * t1; }
        u32x4 w4 = {pk_bf16(v0[0], v0[1]), pk_bf16(v0[2], v0[3]), pk_bf16(v1[0], v1[1]), pk_bf16(v1[2], v1[3])};
        *(u32x4*)(rowp + bj * 128) = w4;
      }
    }
}

extern __shared__ __attribute__((aligned(16))) unsigned char g_lds[];

DEVI void gemm_phase(const bf16_t* A, const bf16_t* Bt, int N, int K, const EpiArgs& e, int wv) {
  LAS unsigned char* lds = (LAS unsigned char*)g_lds;
  const int tid = otid(wv), wid = __builtin_amdgcn_readfirstlane(tid >> 6), lane = tid & 63, wr = wid >> 2, wc = wid & 3, fr = lane & 15, fq = lane >> 4;
  const int nt = K / BK, nN = N / BM;
  unsigned voff[2];
#pragma unroll
  for (int i = 0; i < 2; ++i) { int R, C; stage_rc(tid * 16 + i * 8192, R, C); voff[i] = (unsigned)(R * K + C) * 2u; }
  const size_t kstep = (size_t)(BK * 2);
  const size_t hstep = (size_t)HALF * K * 2;
  const size_t tstep = 2 * hstep;
  const unsigned ldsw = (unsigned)wid * 1024u;
  const int aoff = lds_byte(wr * 64 + fr, fq * 8), boff = lds_byte(wc * 32 + fr, fq * 8);
#define PG8_SA(b, h) (((b) * 2 + (h)) * HTB)
#define PG8_SB(b, h) ((4 + (b) * 2 + (h)) * HTB)
#define PG8_STAGE(bufoff, gbase) do { _Pragma("unroll") for (int _i = 0; _i < 2; ++_i) \
    __builtin_amdgcn_global_load_lds((const unsigned*)((const char*)(gbase) + voff[_i]), (LAS unsigned*)(lds + (bufoff) + ldsw + _i * 8192), 16, 0, 0); } while (0)
#define PG8_LDA(dst, b, h) do { _Pragma("unroll") for (int m = 0; m < 4; ++m) _Pragma("unroll") for (int k = 0; k < 2; ++k) dst[m][k] = *(const LAS bf16x8*)(lds + PG8_SA(b, h) + aoff + m * 2048 + k * 1024); } while (0)
#define PG8_LDB(dst, b, h) do { _Pragma("unroll") for (int n = 0; n < 2; ++n) _Pragma("unroll") for (int k = 0; k < 2; ++k) dst[n][k] = *(const LAS bf16x8*)(lds + PG8_SB(b, h) + boff + n * 2048 + k * 1024); } while (0)
#define PG8_MMA(ai, bj, At, Bt_) do { __builtin_amdgcn_s_setprio(1); _Pragma("unroll") for (int m = 0; m < 4; ++m) _Pragma("unroll") for (int n = 0; n < 2; ++n) _Pragma("unroll") for (int k = 0; k < 2; ++k) \
    acc[ai][bj][m][n] = __builtin_amdgcn_mfma_f32_16x16x32_bf16(Bt_[n][k], At[m][k], acc[ai][bj][m][n], 0, 0, 0); __builtin_amdgcn_s_setprio(0); } while (0)
#define PG8_WAIT_V(n) asm volatile("s_waitcnt vmcnt(" #n ")" ::: "memory")
#define PG8_WAIT_L(n) asm volatile("s_waitcnt lgkmcnt(" #n ")" ::: "memory")
#define PG8_BAR __builtin_amdgcn_s_barrier()
#define PG8_SCHED __builtin_amdgcn_sched_barrier(0)
#define UNIT_P(u) ((const char*)((u).swap ? Bt : A) + (size_t)(((u).swap ? (u).bcol : (u).brow) >> 8) * tstep)
#define UNIT_Q(u) ((const char*)((u).swap ? A : Bt) + (size_t)(((u).swap ? (u).brow : (u).bcol) >> 8) * tstep)
  Unit cur, nxt; int ui = 0;
  if (!unit_next(0, nN, e.kind, cur)) return;
  f32x4 acc[2][2][4][2];
  acc_init(acc, cur, wr, wc, fr, fq, e);
  bf16x8 At[4][2], B0[2][2], B1[2][2];
  const char* cA = UNIT_P(cur); const char* cB = UNIT_Q(cur);
  PG8_STAGE(PG8_SB(0, 0), cB); PG8_STAGE(PG8_SB(0, 1), cB + hstep); PG8_STAGE(PG8_SA(0, 0), cA); PG8_STAGE(PG8_SA(0, 1), cA + hstep);
  if (wr == 1) PG8_BAR;
  PG8_WAIT_V(2); PG8_BAR;
  PG8_STAGE(PG8_SB(1, 0), cB + kstep); PG8_STAGE(PG8_SA(1, 0), cA + kstep); PG8_STAGE(PG8_SB(1, 1), cB + hstep + kstep);
  PG8_WAIT_V(6); PG8_BAR;
  for (;;) {
    const bool has_next = unit_next(ui + 1, nN, e.kind, nxt);
    const char* nA = has_next ? UNIT_P(nxt) : cA; const char* nB = has_next ? UNIT_Q(nxt) : cB;
#pragma unroll 1
    for (int t = 0; t < nt; t += 2) {
      const bool last = (t == nt - 2);
      const char* a1 = cA + (size_t)(t + 1) * kstep;
      const char* a2 = last ? nA : cA + (size_t)(t + 2) * kstep; const char* b2 = last ? nB : cB + (size_t)(t + 2) * kstep;
      const char* a3 = a2 + kstep; const char* b3 = b2 + kstep;
      PG8_LDB(B0, 0, 0); PG8_LDB(B1, 0, 1); PG8_SCHED; PG8_LDA(At, 0, 0); PG8_STAGE(PG8_SA(1, 1), a1 + hstep);
      PG8_WAIT_V(8); PG8_WAIT_L(0); PG8_BAR; PG8_MMA(0, 0, At, B0); PG8_MMA(0, 1, At, B1); PG8_BAR; PG8_SCHED;
      PG8_LDA(At, 0, 1); PG8_STAGE(PG8_SB(0, 0), b2); PG8_STAGE(PG8_SB(0, 1), b2 + hstep); PG8_STAGE(PG8_SA(0, 0), a2);
      PG8_WAIT_V(8); PG8_WAIT_L(0); PG8_BAR; PG8_MMA(1, 0, At, B0); PG8_MMA(1, 1, At, B1); PG8_BAR; PG8_SCHED;
      PG8_LDB(B0, 1, 0); PG8_LDB(B1, 1, 1); PG8_SCHED; PG8_LDA(At, 1, 0); PG8_STAGE(PG8_SA(0, 1), a2 + hstep);
      PG8_WAIT_V(8); PG8_WAIT_L(0); PG8_BAR; PG8_MMA(0, 0, At, B0); PG8_MMA(0, 1, At, B1); PG8_BAR; PG8_SCHED;
      PG8_LDA(At, 1, 1); PG8_STAGE(PG8_SB(1, 0), b3); PG8_STAGE(PG8_SB(1, 1), b3 + hstep); PG8_STAGE(PG8_SA(1, 0), a3);
      PG8_WAIT_V(8); PG8_WAIT_L(0); PG8_BAR; PG8_MMA(1, 0, At, B0); PG8_MMA(1, 1, At, B1); PG8_BAR; PG8_SCHED;
    }
    if (wr == 0) PG8_BAR;
    {
      const int tid_e = otid(wv);
      const int wid_e = __builtin_amdgcn_readfirstlane(tid_e >> 6), lane_e = tid_e & 63;
      const int wr_e = wid_e >> 2, wc_e = wid_e & 3, fr_e = lane_e & 15, fq_e = lane_e >> 4;
      if (e.kind == EPI_EVEN) epi_even(acc, cur, wr_e, wc_e, fr_e, fq_e, e);
      else if (e.kind == EPI_GLA) epi_gla(acc, cur, wr_e, wc_e, fr_e, fq_e, e);
      else if (e.kind == EPI_RES) epi_res(acc, cur, wr_e, wc_e, fr_e, fq_e, e);
      else epi_ffn1(acc, cur, wr_e, wc_e, fr_e, fq_e, e);
    }
    if (!has_next) break;
    cur = nxt; cA = nA; cB = nB; ++ui;
    { const int tid_i = otid(wv); const int wid_i = __builtin_amdgcn_readfirstlane(tid_i >> 6), lane_i = tid_i & 63;
      acc_init(acc, cur, wid_i >> 2, wid_i & 3, lane_i & 15, lane_i >> 4, e); }
    if (wr == 1) PG8_BAR;
  }
  PG8_WAIT_V(0);
  PG8_BAR;
#undef PG8_SA
#undef PG8_SB
#undef PG8_STAGE
#undef PG8_LDA
#undef PG8_LDB
#undef PG8_MMA
}

DEVI void ln_phase(float* X, bf16_t* XB, const float* g, const float* bt, bool final_out, int wv) {
  const int tidl = otid(wv); const int w = tidl >> 6, lane = tidl & 63;
  const int stride = gridDim.x * 8;
  int row = blockIdx.x * 8 + w;
  f32x4 v[4], vn[4];
  if (row < NTOK) {
#pragma unroll
    for (int i = 0; i < 4; ++i) v[i] = *(const f32x4*)(X + (size_t)row * 1024 + i * 256 + lane * 4);
  }
  for (; row < NTOK; row += stride) {
    float* xr = X + (size_t)row * 1024;
    if (row + stride < NTOK) {
#pragma unroll
      for (int i = 0; i < 4; ++i) vn[i] = *(const f32x4*)(X + (size_t)(row + stride) * 1024 + i * 256 + lane * 4);
    }
    float s = 0.f;
#pragma unroll
    for (int i = 0; i < 4; ++i) s += (v[i][0] + v[i][1]) + (v[i][2] + v[i][3]);
    s = sum64(s);
    const float mu = s * (1.f / 1024.f);
    float q = 0.f;
#pragma unroll
    for (int i = 0; i < 4; ++i) { const f32x4 d = v[i] - mu; q += (d[0] * d[0] + d[1] * d[1]) + (d[2] * d[2] + d[3] * d[3]); }
    q = sum64(q);
    const float rstd = rsqrtf(q * (1.f / 1024.f) + 1e-5f);
#pragma unroll
    for (int i = 0; i < 4; ++i) {
      const int c = i * 256 + lane * 4;
      const f32x4 gg = *(const f32x4*)(g + c), bb = *(const f32x4*)(bt + c);
      const f32x4 y = (v[i] - mu) * rstd * gg + bb;
      if (final_out) *(f32x4*)(xr + c) = y;
      else { u32x2 pkd = {pk_bf16(y[0], y[1]), pk_bf16(y[2], y[3])}; *(u32x2*)(XB + (size_t)row * 1024 + c) = pkd; }
    }
#pragma unroll
    for (int i = 0; i < 4; ++i) v[i] = vn[i];
  }
}

DEVI void ln_bf16_phase(const bf16_t* Y, bf16_t* XN, const float* g, const float* bt, int wv) {
  const int tidl = otid(wv); const int w = tidl >> 6, lane = tidl & 63;
  const int stride = gridDim.x * 8;
  int row = blockIdx.x * 8 + w;
  u32x4 ra = {}, rb = {}, na = {}, nb = {};
  if (row < NTOK) { ra = *(const u32x4*)(Y + (size_t)row * 1024 + lane * 8); rb = *(const u32x4*)(Y + (size_t)row * 1024 + 512 + lane * 8); }
  for (; row < NTOK; row += stride, ra = na, rb = nb) {
    if (row + stride < NTOK) { na = *(const u32x4*)(Y + (size_t)(row + stride) * 1024 + lane * 8); nb = *(const u32x4*)(Y + (size_t)(row + stride) * 1024 + 512 + lane * 8); }
    float v[16];
#pragma unroll
    for (int i = 0; i < 4; ++i) { v[2 * i] = bflo(ra[i]); v[2 * i + 1] = bfhi(ra[i]); v[8 + 2 * i] = bflo(rb[i]); v[8 + 2 * i + 1] = bfhi(rb[i]); }
    float sacc = 0.f;
#pragma unroll
    for (int i = 0; i < 16; ++i) sacc += v[i];
    sacc = sum64(sacc);
    const float mu = sacc * (1.f / 1024.f);
    float q = 0.f;
#pragma unroll
    for (int i = 0; i < 16; ++i) { const float d = v[i] - mu; q += d * d; }
    q = sum64(q);
    const float rstd = rsqrtf(q * (1.f / 1024.f) + 1e-5f);
#pragma unroll
    for (int hf = 0; hf < 2; ++hf) {
      const int c = hf * 512 + lane * 8;
      const f32x4 g0 = *(const f32x4*)(g + c), g1 = *(const f32x4*)(g + c + 4), b0 = *(const f32x4*)(bt + c), b1 = *(const f32x4*)(bt + c + 4);
      float y[8];
#pragma unroll
      for (int i = 0; i < 4; ++i) { y[i] = (v[hf * 8 + i] - mu) * rstd * g0[i] + b0[i]; y[4 + i] = (v[hf * 8 + 4 + i] - mu) * rstd * g1[i] + b1[i]; }
      u32x4 o = {pk_bf16(y[0], y[1]), pk_bf16(y[2], y[3]), pk_bf16(y[4], y[5]), pk_bf16(y[6], y[7])};
      *(u32x4*)(XN + (size_t)row * 1024 + c) = o;
    }
  }
}

constexpr int AT_BUF = 34816;
struct TileRegs { u32x4 k0, k1, v0, v1; };
DEVI void at_gload(TileRegs& r, const bf16_t* Kbase, const bf16_t* VTbase, int key0, int t) {
  r.k0 = *(const u32x4*)(Kbase + (size_t)(key0 + (t >> 4)) * 3072 + (t & 15) * 8);
  r.k1 = *(const u32x4*)(Kbase + (size_t)(key0 + 32 + (t >> 4)) * 3072 + (t & 15) * 8);
  r.v0 = *(const u32x4*)(VTbase + (size_t)(t >> 3) * 8192 + key0 + (t & 7) * 8);
  r.v1 = *(const u32x4*)(VTbase + (size_t)(64 + (t >> 3)) * 8192 + key0 + (t & 7) * 8);
}
DEVI void at_lstore(const TileRegs& r, unsigned char* buf, int t) {
  *(u32x4*)(buf + (t >> 4) * 272 + (t & 15) * 16) = r.k0;
  *(u32x4*)(buf + (32 + (t >> 4)) * 272 + (t & 15) * 16) = r.k1;
  unsigned char* vb = buf + 17408;
  u32x2* p0 = (u32x2*)(vb + (t >> 3) * 136 + (t & 7) * 16);
  u32x2 a = {r.v0[0], r.v0[1]}, b = {r.v0[2], r.v0[3]}; p0[0] = a; p0[1] = b;
  u32x2* p1 = (u32x2*)(vb + (64 + (t >> 3)) * 136 + (t & 7) * 16);
  u32x2 c = {r.v1[0], r.v1[1]}, d = {r.v1[2], r.v1[3]}; p1[0] = c; p1[1] = d;
}

template <int MODE>
DEVI void attn_item(const bf16_t* H, const bf16_t* vT, const float* kmsum, bf16_t* AO, int b, int hh, int qi,
                    float lam_full, float one_m_linit, const float* subln, int wv) {
  constexpr int NKS = MODE ? 8 : 4;
  unsigned char* lds = g_lds;
  const int tid = otid(wv), w = tid >> 6, lane = tid & 63, r = lane & 31, h = lane >> 5;
  const int map = MODE ? 0 : (w & 1);
  const int q0 = MODE ? qi * 256 + w * 32 : qi * 128 + (w >> 1) * 32;
  const int ntiles = MODE ? 4 * (qi + 1) : 2 * qi + 2;
  const size_t tokbase = (size_t)b * 8192;
#ifdef MOBA_ON_DIFF
  const int qcol = MODE ? hh * 128 : hh * 128 + map * 64;
  const int kcol = 512 + hh * 128;
#else
  const int qcol = MODE ? 1536 + hh * 128 : hh * 128 + map * 64;
  const int kcol = MODE ? 2048 + hh * 128 : 512 + hh * 128;
#endif
  const bf16_t* Kbase = H + tokbase * 3072 + kcol;
  const bf16_t* VTbase = vT + (size_t)(b * 512 + hh * 128) * 8192;
  const float cs = (MODE ? 0.08838834764831845f : 0.125f) * 1.4426950408889634f;
  const int kboff = MODE ? 0 : map * 128;

  bf16x8 qf[NKS];
  { const bf16_t* qp = H + (tokbase + q0 + r) * 3072 + qcol + 8 * h;
#pragma unroll
    for (int ks = 0; ks < NKS; ++ks) qf[ks] = *(const bf16x8*)(qp + 16 * ks); }

  unsigned sel = 0;
  if (MODE) {
    f32x16 gt = {};
    const float* kmp = kmsum + (size_t)(b * 32 + r) * 512 + hh * 128 + 8 * h;
    f32x4 kma[8], kmc[8];
#pragma unroll
    for (int ks = 0; ks < 8; ++ks) { kma[ks] = *(const f32x4*)(kmp + 16 * ks); kmc[ks] = *(const f32x4*)(kmp + 16 * ks + 4); }
#pragma unroll
    for (int ks = 0; ks < 8; ++ks) {
      const f32x4 a = kma[ks] * (1.f / 256.f), c = kmc[ks] * (1.f / 256.f);
      gt = mfma32(mk8(pk_bf16(a[0], a[1]), pk_bf16(a[2], a[3]), pk_bf16(c[0], c[1]), pk_bf16(c[2], c[3])), qf[ks < NKS ? ks : 0], gt);
    }
    float gv[16];
#pragma unroll
    for (int rg = 0; rg < 16; ++rg) { const int blk = (rg & 3) + 8 * (rg >> 2) + 4 * h; gv[rg] = (blk < qi) ? gt[rg] : NEG_INF; }
#pragma unroll
    for (int round = 0; round < 3; ++round) {
      float best = NEG_INF; int bi = 99;
#pragma unroll
      for (int rg = 0; rg < 16; ++rg) { const int blk = (rg & 3) + 8 * (rg >> 2) + 4 * h; if (gv[rg] > best) { best = gv[rg]; bi = blk; } }
      float b_lo, b_hi; int i_lo, i_hi; halves(best, b_lo, b_hi); halves_i(bi, i_lo, i_hi);
      const bool lowin = (b_lo > b_hi) || (b_lo == b_hi && i_lo < i_hi);
      const float wval = lowin ? b_lo : b_hi; const int wi = lowin ? i_lo : i_hi;
      if (wval > NEG_INF) sel |= 1u << wi;
#pragma unroll
      for (int rg = 0; rg < 16; ++rg) { const int blk = (rg & 3) + 8 * (rg >> 2) + 4 * h; if (blk == wi) gv[rg] = NEG_INF; }
    }
  }

#ifdef SELFIX
  if (MODE) sel = (qi >= 3) ? 7u : ((1u << qi) - 1u);
#endif
  f32x16 o[4] = {};
  float m = NEG_INF, l = 0.f;
  TileRegs tr;
  at_gload(tr, Kbase, VTbase, 0, tid); at_lstore(tr, lds, tid); __syncthreads();
#pragma unroll 1
  for (int tt = 0; tt < ntiles; ++tt) {
    const unsigned char* buf = lds + (tt & 1) * AT_BUF;
    const int key0 = tt * 64;
    if (tt + 1 < ntiles) at_gload(tr, Kbase, VTbase, key0 + 64, tid);
    bool active, needmask, lanesel = true;
    if (MODE && (tt >> 2) < qi) { lanesel = (sel >> (tt >> 2)) & 1u; active = __any(lanesel ? 1 : 0) != 0; needmask = false; }
    else { active = key0 <= q0 + 31; needmask = key0 + 63 > q0; }
    if (active) {
      f32x16 st[2];
      {
        bf16x8 kfa[NKS], kfb[NKS];
        const unsigned char* kp0 = buf + r * 272 + kboff + h * 16;
#pragma unroll
        for (int ks = 0; ks < NKS; ++ks) kfa[ks] = *(const bf16x8*)(kp0 + ks * 32);
#pragma unroll
        for (int ks = 0; ks < NKS; ++ks) kfb[ks] = *(const bf16x8*)(kp0 + 32 * 272 + ks * 32);
        __builtin_amdgcn_sched_barrier(0);
        f32x16 a0 = {}, a1 = {};
#pragma unroll
        for (int ks = 0; ks < NKS; ++ks) a0 = mfma32(kfa[ks], qf[ks], a0);
#pragma unroll
        for (int ks = 0; ks < NKS; ++ks) a1 = mfma32(kfb[ks], qf[ks], a1);
        st[0] = a0; st[1] = a1;
      }
      if (needmask) {
#pragma unroll
        for (int T = 0; T < 2; ++T)
#pragma unroll
          for (int rg = 0; rg < 16; ++rg) { const int key = key0 + 32 * T + 8 * (rg >> 2) + 4 * h + (rg & 3); if (key > q0 + r) st[T][rg] = NEG_INF; }
      }
      float mxr = NEG_INF;
#pragma unroll
      for (int T = 0; T < 2; ++T)
#pragma unroll
        for (int rg = 0; rg < 16; ++rg) mxr = fmaxf(mxr, st[T][rg]);
      mxr = hmax(mxr);
      const float mxs = lanesel ? mxr * cs : NEG_INF;
      if (__any((mxs > m + 8.0f) ? 1 : 0)) {
        const float mn = fmaxf(m, mxs);
        const float mu2 = (mn == NEG_INF) ? 0.f : mn;
        const float alpha = ex2(m - mu2);
        m = mn;
        l *= alpha;
#pragma unroll
        for (int dt = 0; dt < 4; ++dt) o[dt] = o[dt] * alpha;
      }
      const float nb = lanesel ? ((m == NEG_INF) ? 0.f : -m) : NEG_INF;
      float ps = 0.f;
#pragma unroll
      for (int T = 0; T < 2; ++T)
#pragma unroll
        for (int rg = 0; rg < 16; ++rg) { const float pv = ex2(fmaf(st[T][rg], cs, nb)); st[T][rg] = pv; ps += pv; }
      l += ps;
      {
        const unsigned char* vb0 = buf + 17408 + r * 136 + 8 * h;
        u32x2 vlo[2][4], vhi[2][4];
#pragma unroll
        for (int dt = 0; dt < 4; ++dt) { const unsigned char* vp = vb0 + dt * 32 * 136; vlo[0][dt] = *(const u32x2*)vp; vhi[0][dt] = *(const u32x2*)(vp + 16); }
#pragma unroll
        for (int step = 0; step < 4; ++step) {
          const int T = step >> 1, sx = step & 1;
          if (step < 3) {
#pragma unroll
            for (int dt = 0; dt < 4; ++dt) { const unsigned char* vp = vb0 + dt * 32 * 136 + (step + 1) * 32; vlo[(step + 1) & 1][dt] = *(const u32x2*)vp; vhi[(step + 1) & 1][dt] = *(const u32x2*)(vp + 16); }
          }
          const bf16x8 pb = pack8(st[T], sx);
#pragma unroll
          for (int dt = 0; dt < 4; ++dt) o[dt] = mfma32(mk8(vlo[step & 1][dt][0], vlo[step & 1][dt][1], vhi[step & 1][dt][0], vhi[step & 1][dt][1]), pb, o[dt]);
          __builtin_amdgcn_sched_barrier(0);
        }
      }
    }
    if (tt + 1 < ntiles) at_lstore(tr, lds + ((tt + 1) & 1) * AT_BUF, tid);
    __syncthreads();
  }
  const float lt = hsum(l);
  const float il = 1.f / lt;
  const size_t token = tokbase + q0 + r;
  if (MODE) {
#pragma unroll
    for (int dt = 0; dt < 4; ++dt)
#pragma unroll
      for (int gp = 0; gp < 2; ++gp) {
        const int g0 = 2 * gp, g1 = g0 + 1;
        const u32x2 a0 = {pk_bf16(o[dt][4 * g0] * il, o[dt][4 * g0 + 1] * il), pk_bf16(o[dt][4 * g0 + 2] * il, o[dt][4 * g0 + 3] * il)};
        const u32x2 a1 = {pk_bf16(o[dt][4 * g1] * il, o[dt][4 * g1 + 1] * il), pk_bf16(o[dt][4 * g1 + 2] * il, o[dt][4 * g1 + 3] * il)};
        *(u32x4*)(AO + token * 1024 + 512 + hh * 128 + 32 * dt + 8 * (g0 + h)) = widen_pair(a0, a1, h);
      }
  } else {
    float* ex = (float*)lds;
    const int rgp = w >> 1;
    if (map == 1) {
      const float f = il * lam_full;
#pragma unroll
      for (int dt = 0; dt < 4; ++dt)
#pragma unroll
        for (int rg = 0; rg < 16; ++rg) ex[((rgp * 4 + dt) * 16 + rg) * 64 + lane] = o[dt][rg] * f;
    }
    __syncthreads();
    if (map == 0) {
      float ss = 0.f;
#pragma unroll
      for (int dt = 0; dt < 4; ++dt)
#pragma unroll
        for (int rg = 0; rg < 16; ++rg) { const float d = o[dt][rg] * il - ex[((rgp * 4 + dt) * 16 + rg) * 64 + lane]; o[dt][rg] = d; ss += d * d; }
      ss = hsum(ss);
      const float rinv = rsqrtf(ss * (1.f / 128.f) + 1e-5f) * one_m_linit;
#pragma unroll
      for (int dt = 0; dt < 4; ++dt)
#pragma unroll
        for (int gp = 0; gp < 2; ++gp) {
          u32x2 a[2];
#pragma unroll
          for (int k = 0; k < 2; ++k) {
            const int g = 2 * gp + k, dv = 32 * dt + 8 * g + 4 * h;
            const f32x4 sl = *(const f32x4*)(lds + 130048 + dv * 4);
            a[k] = (u32x2){pk_bf16(o[dt][4 * g] * rinv * sl[0], o[dt][4 * g + 1] * rinv * sl[1]), pk_bf16(o[dt][4 * g + 2] * rinv * sl[2], o[dt][4 * g + 3] * rinv * sl[3])};
          }
          *(u32x4*)(AO + token * 1024 + hh * 128 + 32 * dt + 8 * (2 * gp + h)) = widen_pair(a[0], a[1], h);
        }
    }
    __syncthreads();
  }
}

#ifndef AM
#define AM 3
#endif
DEVI void attn_phase(const Params& p, int e, int wv) {
  asm volatile("" : "+s"(e));
  unsigned char* ws = p.ws;
  const bf16_t* H = (const bf16_t*)(ws + WS_OV + OV_H);
  const bf16_t* dvT = (const bf16_t*)(ws + WS_OV + OV_DVT);
  const bf16_t* mvT = (const bf16_t*)(ws + WS_OV + OV_MVT);
  const float* kmsum = (const float*)(ws + WS_KM) + (size_t)e * 65536;
  bf16_t* AO = (bf16_t*)(ws + WS_AO);
  const float* lam = p.in[2] + e * 256;
  float s1 = 0.f, s2 = 0.f;
  for (int i = 0; i < 64; ++i) { s1 += lam[i] * lam[64 + i]; s2 += lam[128 + i] * lam[192 + i]; }
  const float linit = (e == 0) ? 0.2f : 0.47071301834358413f;
  const float lam_full = __expf(s1) - __expf(s2) + linit;
  const float* subln = p.in[3] + e * 128;
  { const int t0 = otid(wv); if (t0 < 128) ((float*)(g_lds + 130048))[t0] = subln[t0]; __syncthreads(); }
  const int vb = (gridDim.x == 256) ? (int)((blockIdx.x & 7) * 32 + (blockIdx.x >> 3)) : (int)blockIdx.x;
#pragma unroll 1
  for (int u = vb; u < 768; u += gridDim.x) {
    if (u < 512) {
      if (!(AM & 1)) continue;
      const int pidx = (u & 255) * 2 + (u >> 8); const int bh = pidx >> 5, ip = pidx & 31;
      attn_item<0>(H, dvT, kmsum, AO, bh >> 2, bh & 3, 63 - ip, lam_full, 1.f - linit, subln, wv);
      attn_item<0>(H, dvT, kmsum, AO, bh >> 2, bh & 3, ip, lam_full, 1.f - linit, subln, wv);
    } else {
      if (!(AM & 2)) continue;
      const int pp = u - 512, bh = pp >> 4, jp = pp & 15;
#ifdef MOBA_ON_DIFF
#define MVT_SRC dvT
#else
#define MVT_SRC mvT
#endif
      attn_item<1>(H, MVT_SRC, kmsum, AO, bh >> 2, bh & 3, 31 - jp, lam_full, 1.f - linit, subln, wv);
      attn_item<1>(H, MVT_SRC, kmsum, AO, bh >> 2, bh & 3, jp, lam_full, 1.f - linit, subln, wv);
    }
  }
}

DEVI void gla_prep_item(int item, const bf16_t* XB, const bf16_t* WgdT, const float* Wup, const float* bgate,
                        bf16_t* Hg, bf16_t* kT, float* decay, const float* stat_in, const float* ugd, const float* vgd, int wv) {
  const int tid = otid(wv), w = tid >> 6, lane = tid & 63;
  const int b = item >> 7, ch = item & 127;
  const size_t tok0 = (size_t)b * 8192 + ch * 64;
  float* gd = (float*)g_lds;
  if (w < 4) {
    const int fr = lane & 15, fq = lane >> 4;
    f32x4 acc = {};
    const bf16_t* ap = XB + (tok0 + 16 * w + fr) * 1024 + 8 * fq;
    const bf16_t* bp = WgdT + fr * 1024 + 8 * fq;
#pragma unroll 1
    for (int k0 = 0; k0 < 32; k0 += 8) {
      bf16x8 af[8], bfr[8];
#pragma unroll
      for (int i = 0; i < 8; ++i) { af[i] = *(const bf16x8*)(ap + 32 * (k0 + i)); bfr[i] = *(const bf16x8*)(bp + 32 * (k0 + i)); }
#pragma unroll
      for (int i = 0; i < 8; ++i) acc = mfma16(af[i], bfr[i], acc);
    }
    const float ug = ugd[fr], vg = vgd[fr];
#pragma unroll
    for (int j = 0; j < 4; ++j) {
      float mu, rstd; row_mu_rstd(stat_in, (int)tok0 + 16 * w + 4 * fq + j, mu, rstd);
      gd[(16 * w + 4 * fq + j) * 16 + fr] = rstd * (acc[j] - mu * ug) + vg;
    }
  }
  __syncthreads();
  const int c = tid;
  float wup[16];
#pragma unroll
  for (int rr = 0; rr < 16; ++rr) wup[rr] = Wup[rr * 512 + c];
  const float bias = bgate[c];
  float bsum = 0.f;
  bf16_t* qp = Hg + tok0 * 2048 + c;
  bf16_t* kp = qp + 512;
  bf16_t* ktp = kT + (size_t)(b * 512 + c) * 8192 + ch * 64;
  bf16_t qv[8], kv[8], qn[8], kn[8];
#pragma unroll
  for (int tt = 0; tt < 8; ++tt) { qv[tt] = qp[(size_t)tt * 2048]; kv[tt] = kp[(size_t)tt * 2048]; }
#pragma unroll 1
  for (int t8 = 0; t8 < 8; ++t8) {
    if (t8 < 7) {
#pragma unroll
      for (int tt = 0; tt < 8; ++tt) { qn[tt] = qp[(size_t)((t8 + 1) * 8 + tt) * 2048]; kn[tt] = kp[(size_t)((t8 + 1) * 8 + tt) * 2048]; }
    }
    unsigned short kb[8];
#pragma unroll
    for (int tt = 0; tt < 8; ++tt) {
      const int t = t8 * 8 + tt;
      const f32x4* g4 = (const f32x4*)(gd + t * 16);
      float z = bias;
#pragma unroll
      for (int i = 0; i < 4; ++i) { const f32x4 gg = g4[i]; z += gg[0] * wup[4 * i] + gg[1] * wup[4 * i + 1] + gg[2] * wup[4 * i + 2] + gg[3] * wup[4 * i + 3]; }
      const float ls = fminf(z, 0.f) - __logf(1.f + __expf(-fabsf(z)));
      bsum += ls * 0.0625f;
      const float eb = __expf(bsum), en = __expf(-bsum);
      const float q = bf2f(qv[tt]), k = bf2f(kv[tt]);
      qp[(size_t)t * 2048] = f2bf(q * eb * 0.08838834764831845f);
      const bf16_t kk = f2bf(k * en);
      kp[(size_t)t * 2048] = kk;
      kb[tt] = kk;
    }
    u32x4 pk = {(unsigned)kb[0] | ((unsigned)kb[1] << 16), (unsigned)kb[2] | ((unsigned)kb[3] << 16),
                (unsigned)kb[4] | ((unsigned)kb[5] << 16), (unsigned)kb[6] | ((unsigned)kb[7] << 16)};
    *(u32x4*)(ktp + t8 * 8) = pk;
#pragma unroll
    for (int tt = 0; tt < 8; ++tt) { qv[tt] = qn[tt]; kv[tt] = kn[tt]; }
  }
  decay[(size_t)(b * 128 + ch) * 512 + c] = __expf(bsum);
  __syncthreads();
}

constexpr int GL_Q = 0, GL_K = 17408, GL_KT = 34816, GL_BUF = 53248, GL_RED = 2 * GL_BUF;

template <int PASS>
DEVI void gla_scan_item(int item, const bf16_t* Hg, const bf16_t* vT, const bf16_t* kT, const float* decay,
                        float* Ubuf, float* Dseg, bf16_t* AO, const float* normg, int wv) {
  const int tid = otid(wv), w = tid >> 6, lane = tid & 63, r = lane & 31, h = lane >> 5;
  const int bh = item >> 4, seg = item & 15, b = bh >> 2, hd = bh & 3;
  unsigned char* lds = g_lds;
  const bf16_t* hq = Hg + ((size_t)b * 8192 + seg * 512 + (tid >> 4)) * 2048 + hd * 128 + (tid & 15) * 8;
  const bf16_t* kts = kT + (size_t)(b * 512 + hd * 128 + (tid >> 3)) * 8192 + seg * 512 + (tid & 7) * 8;
  u32x4 rq0, rq1, rk0, rk1, rt0, rt1;
#define GL_GLOAD(cc) do { \
    if (PASS == 1) { const bf16_t* _p = hq + (size_t)(cc) * 64 * 2048; rq0 = *(const u32x4*)_p; rq1 = *(const u32x4*)(_p + 32 * 2048); \
                     rk0 = *(const u32x4*)(_p + 512); rk1 = *(const u32x4*)(_p + 32 * 2048 + 512); } \
    rt0 = *(const u32x4*)(kts + (cc) * 64); rt1 = *(const u32x4*)(kts + (size_t)64 * 8192 + (cc) * 64); } while (0)
#define GL_LSTORE(bufp) do { \
    if (PASS == 1) { unsigned char* _q = (bufp) + GL_Q + (tid >> 4) * 272 + (tid & 15) * 16; *(u32x4*)_q = rq0; *(u32x4*)(_q + 32 * 272) = rq1; \
                     *(u32x4*)(_q + GL_K) = rk0; *(u32x4*)(_q + GL_K + 32 * 272) = rk1; } \
    unsigned char* _t = (bufp) + GL_KT + (tid >> 3) * 144 + (tid & 7) * 16; *(u32x4*)_t = rt0; *(u32x4*)(_t + 64 * 144) = rt1; } while (0)
  GL_GLOAD(0);
  f32x16 S[4] = {};
  if (PASS == 1) {
#pragma unroll 1
    for (int js = 0; js < seg; ++js) {
      const int it2 = bh * 16 + js;
      const float* up = Ubuf + ((size_t)(it2 * 8 + w) * 4) * 1024 + lane;
      const float* dp = Dseg + it2 * 128 + 4 * h;
#pragma unroll
      for (int dkt = 0; dkt < 4; ++dkt)
#pragma unroll
        for (int g = 0; g < 4; ++g) {
          const f32x4 d4 = *(const f32x4*)(dp + 32 * dkt + 8 * g);
#pragma unroll
          for (int i = 0; i < 4; ++i) S[dkt][4 * g + i] = S[dkt][4 * g + i] * d4[i] + up[(dkt * 16 + 4 * g + i) * 64];
        }
    }
  }
  GL_LSTORE(lds);
  __syncthreads();
  const bf16_t* vrow = vT + (size_t)(b * 1024 + hd * 256 + 32 * w + r) * 8192;
#pragma unroll 1
  for (int cc = 0; cc < 8; ++cc) {
    const int ch = seg * 8 + cc, tc0 = ch * 64;
    const size_t tokabs0 = (size_t)b * 8192 + tc0;
    const unsigned char* buf = lds + (cc & 1) * GL_BUF;
    if (cc + 1 < 8) GL_GLOAD(cc + 1);
    bf16x8 vnat[4];
#pragma unroll
    for (int ks = 0; ks < 4; ++ks) vnat[ks] = *(const bf16x8*)(vrow + tc0 + 16 * ks + 8 * h);
    f32x16 o0 = {}, o1 = {};
    if (PASS == 1) {
      f32x16 X00 = {}, X01 = {}, X11 = {};
      { const unsigned char* qL = buf + GL_Q + r * 272 + h * 16; const unsigned char* kL = buf + GL_K + r * 272 + h * 16;
#pragma unroll
        for (int ks = 0; ks < 8; ++ks) {
          const bf16x8 k0 = *(const bf16x8*)(kL + ks * 32), k1 = *(const bf16x8*)(kL + 32 * 272 + ks * 32);
          const bf16x8 q0 = *(const bf16x8*)(qL + ks * 32), q1 = *(const bf16x8*)(qL + 32 * 272 + ks * 32);
          X00 = mfma32(k0, q0, X00); X01 = mfma32(k0, q1, X01); X11 = mfma32(k1, q1, X11);
        } }
      u32x2 vpa[4], vpb[4];
      { const bf16_t* vp = vrow + tc0 + 4 * h;
#pragma unroll
        for (int q = 0; q < 4; ++q) { vpa[q] = *(const u32x2*)(vp + 16 * q); vpb[q] = *(const u32x2*)(vp + 16 * q + 8); } }
#pragma unroll
      for (int rg = 0; rg < 16; ++rg) { const int j = (rg & 3) + 8 * (rg >> 2) + 4 * h; if (r < j) { X00[rg] = 0.f; X11[rg] = 0.f; } }
      { const unsigned char* qP = buf + GL_Q + r * 272 + 8 * h;
#pragma unroll
        for (int dkt = 0; dkt < 4; ++dkt)
#pragma unroll
          for (int sx = 0; sx < 2; ++sx) {
            const bf16x8 sa = pack8(S[dkt], sx);
            const unsigned char* qq = qP + (32 * dkt + 16 * sx) * 2;
            const u32x2 a0 = *(const u32x2*)qq, a1 = *(const u32x2*)(qq + 16);
            const u32x2 c0 = *(const u32x2*)(qq + 32 * 272), c1 = *(const u32x2*)(qq + 32 * 272 + 16);
            o0 = mfma32(sa, mk8(a0[0], a0[1], a1[0], a1[1]), o0);
            o1 = mfma32(sa, mk8(c0[0], c0[1], c1[0], c1[1]), o1);
          } }
#pragma unroll
      for (int sx = 0; sx < 2; ++sx) {
        const bf16x8 v0 = mk8(vpa[sx][0], vpa[sx][1], vpb[sx][0], vpb[sx][1]), v1 = mk8(vpa[2 + sx][0], vpa[2 + sx][1], vpb[2 + sx][0], vpb[2 + sx][1]);
        o0 = mfma32(v0, pack8(X00, sx), o0);
        o1 = mfma32(v0, pack8(X01, sx), o1);
        o1 = mfma32(v1, pack8(X11, sx), o1);
      }
      float ss0 = 0.f, ss1 = 0.f;
#pragma unroll
      for (int rg = 0; rg < 16; ++rg) { ss0 += o0[rg] * o0[rg]; ss1 += o1[rg] * o1[rg]; }
      ss0 = hsum(ss0); ss1 = hsum(ss1);
      float* red = (float*)(lds + GL_RED) + (cc & 1) * 512;
      if (h == 0) { red[w * 64 + r] = ss0; red[w * 64 + 32 + r] = ss1; }
    }
    { const unsigned char* ktL = buf + GL_KT + r * 144 + h * 16;
#pragma unroll
      for (int ks = 0; ks < 4; ++ks)
#pragma unroll
        for (int dkt = 0; dkt < 4; ++dkt) S[dkt] = mfma32(*(const bf16x8*)(ktL + dkt * 32 * 144 + ks * 32), vnat[ks], S[dkt]); }
    { const float* dcp = decay + (size_t)(b * 128 + ch) * 512 + hd * 128 + 4 * h;
#pragma unroll
      for (int dkt = 0; dkt < 4; ++dkt)
#pragma unroll
        for (int g = 0; g < 4; ++g) {
          const f32x4 d4 = *(const f32x4*)(dcp + 32 * dkt + 8 * g);
#pragma unroll
          for (int i = 0; i < 4; ++i) S[dkt][4 * g + i] *= d4[i];
        } }
    if (cc + 1 < 8) GL_LSTORE(lds + ((cc + 1) & 1) * GL_BUF);
    __syncthreads();
    if (PASS == 1) {
      const float* red = (const float*)(lds + GL_RED) + (cc & 1) * 512;
      float t0 = 0.f, t1 = 0.f;
#pragma unroll
      for (int ww = 0; ww < 8; ++ww) { t0 += red[ww * 64 + r]; t1 += red[ww * 64 + 32 + r]; }
      const float ri0 = rsqrtf(t0 * (1.f / 256.f) + 1e-5f), ri1 = rsqrtf(t1 * (1.f / 256.f) + 1e-5f);
      u32x2 r4s[2][4]; f32x4 gns[4];
#pragma unroll
      for (int g = 0; g < 4; ++g) {
        gns[g] = *(const f32x4*)(normg + 32 * w + 8 * g + 4 * h);
#pragma unroll
        for (int it = 0; it < 2; ++it) r4s[it][g] = *(const u32x2*)(Hg + (tokabs0 + 32 * it + r) * 2048 + 1024 + hd * 256 + 32 * w + 8 * g + 4 * h);
      }
#pragma unroll
      for (int it = 0; it < 2; ++it)
#pragma unroll
        for (int g = 0; g < 4; ++g) {
          const int dv0 = 32 * w + 8 * g + 4 * h;
          const size_t tok = tokabs0 + 32 * it + r;
          const u32x2 r4 = r4s[it][g];
          const f32x4 gn = gns[g];
          const float rv[4] = {bflo(r4[0]), bfhi(r4[0]), bflo(r4[1]), bfhi(r4[1])};
          float ov[4];
#pragma unroll
          for (int i = 0; i < 4; ++i) {
            const float oo = it ? o1[4 * g + i] : o0[4 * g + i];
            const float sg = rv[i] / (1.f + __expf(-rv[i]));
            ov[i] = oo * (it ? ri1 : ri0) * gn[i] * sg;
          }
          u32x2 pkd = {pk_bf16(ov[0], ov[1]), pk_bf16(ov[2], ov[3])};
          *(u32x2*)(AO + tok * 1024 + hd * 256 + dv0) = pkd;
        }
    }
  }
#undef GL_GLOAD
#undef GL_LSTORE
  if (PASS == 0) {
    float* up = Ubuf + ((size_t)(item * 8 + w) * 4) * 1024 + lane;
#pragma unroll
    for (int dkt = 0; dkt < 4; ++dkt)
#pragma unroll
      for (int rg = 0; rg < 16; ++rg) up[(dkt * 16 + rg) * 64] = S[dkt][rg];
    if (tid < 128) {
      float dv8[8];
#pragma unroll
      for (int cc = 0; cc < 8; ++cc) dv8[cc] = decay[(size_t)(b * 128 + seg * 8 + cc) * 512 + hd * 128 + tid];
      float d = 1.f;
#pragma unroll
      for (int cc = 0; cc < 8; ++cc) d *= dv8[cc];
      Dseg[item * 128 + tid] = d;
    }
  }
  __syncthreads();
}

#define XB_TMO      128
#define XB_XCNT(j)  (256  + 64 * (j))
#define XB_XSUB(j)  (1280 + 64 * (j))
#define XB_XGEN(j)  (2304 + 64 * (j))
#define XB_TOP      3328
#define XB_TOPGEN   3392
#define XCD_BAR_WORDS 3456
#define XB_SPIN_CAP (1u << 20)
DEVI unsigned xb_ld(unsigned* p)              { return __hip_atomic_load(p, __ATOMIC_RELAXED, __HIP_MEMORY_SCOPE_AGENT); }
DEVI unsigned xb_add(unsigned* p, unsigned v) { return __hip_atomic_fetch_add(p, v, __ATOMIC_RELAXED, __HIP_MEMORY_SCOPE_AGENT); }
DEVI unsigned xb_xcc_id() { return (unsigned)__builtin_amdgcn_s_getreg((3 << 11) | 20) & 0xFu; }
#define XB_SPIN(cond, bar) do { unsigned _sp = 0; while (cond) { __builtin_amdgcn_s_sleep(1); \
    if ((++_sp & 255u) == 0u) { if (xb_ld(&(bar)[XB_TMO])) break; if (_sp > XB_SPIN_CAP) { atomicAdd(&(bar)[XB_TMO], 1u); break; } } } } while (0)
struct XcdBarrier { unsigned* bar; unsigned x; volatile LAS unsigned* st; };
DEVI void xcd_barrier_complete(unsigned* bar, unsigned x, unsigned& nloc, unsigned& nx) {
  const unsigned G = gridDim.x * gridDim.y * gridDim.z;
  unsigned sum, cnt, mine, sp = 0u;
  for (;;) {
    sum = 0u; cnt = 0u; mine = 0u;
#pragma unroll
    for (unsigned j = 0; j < 16; ++j) { const unsigned c = xb_ld(&bar[XB_XCNT(j)]); sum += c; cnt += (c > 0u) ? 1u : 0u; mine = (j == x) ? c : mine; }
    if (sum == G) break;
    __builtin_amdgcn_s_sleep(1);
    if ((++sp & 255u) == 0u) { if (xb_ld(&bar[XB_TMO])) break; if (sp > XB_SPIN_CAP) { atomicAdd(&bar[XB_TMO], 1u); break; } }
  }
  nloc = mine > 0u ? mine : 1u; nx = cnt > 0u ? cnt : 1u;
}
DEVI void xcd_barrier(const XcdBarrier& b, bool leader) {
  asm volatile("s_waitcnt vmcnt(0)" ::: "memory");
  __syncthreads();
  if (leader) {
    unsigned* bar = b.bar;
    __builtin_amdgcn_s_waitcnt(0);
    unsigned bx = xb_xcc_id(); asm volatile("" : "+s"(bx));
    unsigned nloc = b.st[0], nx = b.st[1];
    if (nloc == 0u) { xcd_barrier_complete(bar, bx, nloc, nx); b.st[0] = nloc; b.st[1] = nx; }
    const unsigned old = xb_add(&bar[XB_XSUB(bx)], 1u);
    const unsigned gen = old / nloc;
    if (old + 1u == (gen + 1u) * nloc) {
      __builtin_amdgcn_fence(__ATOMIC_RELEASE, "agent");
      asm volatile("s_waitcnt vmcnt(0)" ::: "memory");
      const unsigned og = xb_add(&bar[XB_TOP], 1u);
      const unsigned tg = og / nx;
      if (og + 1u == (tg + 1u) * nx) xb_add(&bar[XB_TOPGEN], 1u);
      else XB_SPIN(xb_ld(&bar[XB_TOPGEN]) == tg, bar);
      __builtin_amdgcn_fence(__ATOMIC_ACQUIRE, "agent");
      xb_add(&bar[XB_XGEN(bx)], 1u);
      asm volatile("s_waitcnt vmcnt(0)" ::: "memory");
    } else {
      XB_SPIN(xb_ld(&bar[XB_XGEN(bx)]) == gen, bar);
      __builtin_amdgcn_fence(__ATOMIC_ACQUIRE, "agent");
      asm volatile("s_waitcnt vmcnt(0)" ::: "memory");
    }
  }
  __syncthreads();
}

#define GSYNC() xcd_barrier(xb, otid(wv) == 0)
__global__ void __launch_bounds__(512, 2) mega_fwd(Params p) {
  cg::grid_group grid = cg::this_grid();
  const int wv = __builtin_amdgcn_readfirstlane((int)threadIdx.x >> 6);
  unsigned char* ws = p.ws;
  XcdBarrier xb; xb.bar = (unsigned*)(ws + WS_BAR); xb.x = xb_xcc_id(); xb.st = (volatile LAS unsigned*)((LAS unsigned char*)g_lds + 131072);
  if (threadIdx.x == 0) { xb.st[0] = 0u; xb.st[1] = 0u; (void)xb_add(&xb.bar[XB_XCNT(xb.x)], 1u); }
  grid.sync();
  bf16_t* XB = (bf16_t*)(ws + WS_XB);
  bf16_t* AO = (bf16_t*)(ws + WS_AO);
  unsigned char* OV = ws + WS_OV;

#ifndef PM
#define PM 0xff
#endif
#ifndef DUP
#define DUP 0
#endif
  if (PM & 1) prologue(p, (char*)g_lds, wv);
  GSYNC();
#if (DUP & 32)
  prologue(p, (char*)g_lds, wv);
  GSYNC();
#endif

  { const int gtid = blockIdx.x * 512 + otid(wv);
    for (int i = gtid; i < 4 * 14336; i += gridDim.x * 512) {
      const int l = i / 14336, c = i % 14336;
      if (c < 6144 && !(l & 1)) continue;
      const float* pp = (const float*)(ws + WS_UVP) + (size_t)l * 16 * 16384 + c;
      float acc = 0.f;
#pragma unroll
      for (int kt = 0; kt < 16; ++kt) acc += pp[(size_t)kt * 16384];
      ((float*)(ws + WS_UV))[(size_t)l * 16384 + c] = acc;
    } }
#pragma unroll 1
  for (int l = 0; l < 4; ++l) {
    const bf16_t* wl = (const bf16_t*)(ws + WS_WT + (size_t)l * WT_LAYER);
    const int e = l >> 1;
    const bool odd = (l & 1) != 0;
    bf16_t* Hg = (bf16_t*)(OV + OV_HG); bf16_t* vT = (bf16_t*)(OV + OV_VT); bf16_t* kT = (bf16_t*)(OV + OV_KT);
    float* Ubuf = (float*)(OV + OV_U); float* decay = (float*)(ws + WS_DEC); float* Dseg = (float*)(ws + WS_DSEG);
#pragma unroll 1
    for (int st = 0; st < 9; ++st) {
      if (!odd && (st == 2 || st == 3)) continue;
      if (st == 5 || (st == 8 && l != 3)) {
        stat_finalize((const float*)(ws + WS_STATS) + (st == 8 ? 1048576 : 0), (float*)(ws + WS_MR) + (st == 8 ? 65536 : 0), wv);
        GSYNC();
        continue;
      }
      if (st == 0 || st == 4 || st == 6 || st == 7) {
        EpiArgs ea{};
        const bf16_t* A; const bf16_t* Bt; int N, K;
        const float* uv = (const float*)(ws + WS_UV) + (size_t)l * 16384;
        float* stats = (float*)(ws + WS_STATS);
        const float* mrb = (const float*)(ws + WS_MR);
        if (st == 0) {
          A = XB; Bt = wl; N = 3072; K = 1024;
          if (odd) { ea.stat_in = mrb + 65536; ea.u = uv + UV_U_IN; ea.v = uv + UV_V_IN; }
          else if (l > 0) { ln_bf16_phase(XB, AO, p.in[14] + (l - 1) * 1024, p.in[15] + (l - 1) * 1024, wv); GSYNC(); A = AO; }
          if (odd) { ea.kind = EPI_GLA; ea.H = Hg; ea.vt0 = vT; }
          else { ea.kind = EPI_EVEN; ea.H = (bf16_t*)(OV + OV_H); ea.vt0 = (bf16_t*)(OV + OV_DVT); ea.vt1 = (bf16_t*)(OV + OV_MVT); ea.kmsum = (float*)(ws + WS_KM) + (size_t)e * 65536; }
        } else if (st == 4) {
          A = AO; Bt = wl + 3 * 1024 * 1024; N = 1024; K = 1024; ea.kind = EPI_RES; ea.Y = XB; ea.X = p.X;
          if (l > 0) { ea.stat_prev = mrb + 65536; ea.gprev = p.in[14] + (l - 1) * 1024; ea.bprev = p.in[15] + (l - 1) * 1024; }
          ea.stat_new = stats;
        } else if (st == 6) {
          A = XB; Bt = wl + 4 * 1024 * 1024; N = 4096; K = 1024; ea.kind = EPI_FFN1; ea.Hff = (bf16_t*)OV;
          ea.stat_in = mrb; ea.u = uv + UV_U_F1; ea.v = uv + UV_V_F1;
        } else {
          A = (const bf16_t*)OV; Bt = wl + 8 * 1024 * 1024; N = 1024; K = 4096; ea.kind = EPI_RES; ea.Y = XB; ea.X = p.X;
          ea.stat_prev = mrb; ea.gprev = p.in[10] + l * 1024; ea.bprev = p.in[11] + l * 1024;
          ea.stat_new = stats + 1048576; ea.final_out = (l == 3);
        }
        if (PM & 2) gemm_phase(A, Bt, N, K, ea, wv);
#if (DUP & 2)
        if (st == 6) { GSYNC(); gemm_phase(A, Bt, N, K, ea, wv); }
#endif
      } else if (st == 1) {
        if (odd) {
#pragma unroll 1
          for (int it = blockIdx.x; it < 512; it += gridDim.x)
            if (PM & 8) gla_prep_item(it, XB, (const bf16_t*)(ws + WS_WGD) + (size_t)e * 16384, p.in[6] + e * 8192, p.in[7] + e * 512, Hg, kT, decay,
                                      (const float*)(ws + WS_MR) + 65536, (const float*)(ws + WS_UV) + (size_t)l * 16384 + UV_U_GD, (const float*)(ws + WS_UV) + (size_t)l * 16384 + UV_V_GD, wv);
        } else {
          if (PM & 4) attn_phase(p, e, wv);
#if (DUP & 1)
          GSYNC(); attn_phase(p, e, wv);
#endif
        }
      } else if (st == 2) {
#pragma unroll 1
        for (int it = blockIdx.x; it < 256; it += gridDim.x) if (PM & 16) gla_scan_item<0>(it, Hg, vT, kT, decay, Ubuf, Dseg, AO, p.in[8] + e * 256, wv);
#if (DUP & 4)
        GSYNC();
        for (int it = blockIdx.x; it < 256; it += gridDim.x) gla_scan_item<0>(it, Hg, vT, kT, decay, Ubuf, Dseg, AO, p.in[8] + e * 256, wv);
#endif
      } else if (st == 3) {
#pragma unroll 1
        for (int it = blockIdx.x; it < 256; it += gridDim.x) if (PM & 32) gla_scan_item<1>(it, Hg, vT, kT, decay, Ubuf, Dseg, AO, p.in[8] + e * 256, wv);
#if (DUP & 8)
        GSYNC();
        for (int it = blockIdx.x; it < 256; it += gridDim.x) gla_scan_item<1>(it, Hg, vT, kT, decay, Ubuf, Dseg, AO, p.in[8] + e * 256, wv);
#endif
      } else {
        if (PM & 64) ln_phase(p.X, XB, p.in[14] + l * 1024, p.in[15] + l * 1024, true, wv);
      }
      GSYNC();
#if (DUP & 16)
      GSYNC();
#endif
    }
  }
}

extern "C" void kernel_launch(void* const* d_in, const int* in_sizes, int n_in, void* d_out, int out_size, void* d_ws, size_t ws_size,
                              hipStream_t stream) {
  constexpr int LDS_BYTES = 131072 + 64;
  static int grid = 0;
  if (grid == 0) {
    if (n_in != 16 || out_size != NTOK * DM || ws_size < WS_END) {
      fprintf(stderr, "kernel_launch: unexpected shapes (n_in %d out %d ws %zu need %zu)\n", n_in, out_size, ws_size, (size_t)WS_END);
      grid = -1; return;
    }
    int dev = 0, cus = 0, per_cu = 0;
    hipGetDevice(&dev);
    hipDeviceGetAttribute(&cus, hipDeviceAttributeMultiprocessorCount, dev);
    hipFuncSetAttribute((const void*)mega_fwd, hipFuncAttributeMaxDynamicSharedMemorySize, LDS_BYTES);
    hipOccupancyMaxActiveBlocksPerMultiprocessor(&per_cu, (const void*)mega_fwd, 512, LDS_BYTES);
    if (per_cu < 1) per_cu = 1;
    grid = cus * per_cu;
    if (grid > 256) grid = 256;
    (void)hipGetLastError();
  }
  if (grid < 0) return;
  if (hipMemsetAsync((char*)d_ws + WS_BAR, 0, 16384, stream) != hipSuccess) { fprintf(stderr, "kernel_launch: memset of barrier words failed\n"); return; }
  Params p{};
  for (int i = 0; i < 16; ++i) p.in[i] = (const float*)d_in[i];
  p.X = (float*)d_out;
  p.ws = (unsigned char*)d_ws;
  void* args[] = {&p};
  hipError_t err = hipLaunchCooperativeKernel((const void*)mega_fwd, dim3(grid), dim3(512), args, LDS_BYTES, stream);
  if (err != hipSuccess) fprintf(stderr, "cooperative launch failed: %s (grid %d)\n", hipGetErrorString(err), grid);
}
```

```cpp
#include <hip/hip_runtime.h>
#include <hip/hip_cooperative_groups.h>
#include <cstdio>
#include <cstdint>
namespace cg = cooperative_groups;

typedef unsigned short bf16_t;
typedef short bf16x8 __attribute__((ext_vector_type(8)));
typedef float f32x4 __attribute__((ext_vector_type(4)));
typedef float f32x16 __attribute__((ext_vector_type(16)));
typedef unsigned u32x2 __attribute__((ext_vector_type(2)));
typedef unsigned u32x4 __attribute__((ext_vector_type(4)));

#define DEVI __device__ __forceinline__
#define NEG_INF (-__builtin_inff())

constexpr int SEQ = 8192, NTOK = 32768, DM = 1024;
constexpr float DN_ALPHA = 1.681792830507429f;

constexpr size_t MiB = 1024ull * 1024ull;
constexpr size_t WS_WT    = 4096;
constexpr size_t WT_LAYER = 24 * MiB;
constexpr size_t WS_WGD   = WS_WT + 4 * WT_LAYER;
constexpr size_t WS_XB    = WS_WGD + 65536;
constexpr size_t WS_AO    = WS_XB + 64 * MiB;
constexpr size_t WS_OV    = WS_AO + 64 * MiB;
constexpr size_t WS_KM    = WS_OV + 256 * MiB;
constexpr size_t WS_DEC   = WS_KM + 524288;
constexpr size_t WS_DSEG  = WS_DEC + 1 * MiB;
constexpr size_t WS_BAR   = WS_DSEG + 131072;
constexpr size_t WS_STATS = WS_BAR + 16384;
constexpr size_t WS_MR    = WS_STATS + 8 * MiB;
constexpr size_t WS_UV    = WS_MR + 524288;
constexpr size_t WS_UVP   = WS_UV + 262144;
constexpr size_t WS_END   = WS_UVP + 4 * MiB;
constexpr int UV_U_IN = 0, UV_V_IN = 3072, UV_U_F1 = 6144, UV_V_F1 = 10240, UV_U_GD = 14336, UV_V_GD = 14352;
constexpr size_t OV_H   = 0;
constexpr size_t OV_DVT = 192 * MiB;
constexpr size_t OV_MVT = 224 * MiB;
constexpr size_t OV_HG  = 0;
constexpr size_t OV_VT  = 128 * MiB;
constexpr size_t OV_KT  = 192 * MiB;
constexpr size_t OV_U   = 224 * MiB;

struct Params {
  const float* in[16];
  float* X;
  unsigned char* ws;
};

typedef __bf16 bf16x2_t __attribute__((ext_vector_type(2)));
DEVI unsigned pk_bf16(float lo, float hi) { bf16x2_t v = {(__bf16)lo, (__bf16)hi}; return __builtin_bit_cast(unsigned, v); }
DEVI bf16_t f2bf(float f) { return (bf16_t)(pk_bf16(f, 0.f) & 0xffffu); }
DEVI float bf2f(bf16_t v) { return __uint_as_float(((unsigned)v) << 16); }
DEVI float bflo(unsigned u) { return __uint_as_float(u << 16); }
DEVI float bfhi(unsigned u) { return __uint_as_float(u & 0xffff0000u); }
DEVI bf16x8 mk8(unsigned a, unsigned b, unsigned c, unsigned d) { u32x4 v = {a, b, c, d}; return __builtin_bit_cast(bf16x8, v); }
DEVI bf16x8 pack8(const f32x16& x, int s) {
  return s == 0 ? mk8(pk_bf16(x[0], x[1]), pk_bf16(x[2], x[3]), pk_bf16(x[4], x[5]), pk_bf16(x[6], x[7]))
                : mk8(pk_bf16(x[8], x[9]), pk_bf16(x[10], x[11]), pk_bf16(x[12], x[13]), pk_bf16(x[14], x[15]));
}
DEVI f32x16 mfma32(bf16x8 a, bf16x8 b, f32x16 c) { return __builtin_amdgcn_mfma_f32_32x32x16_bf16(a, b, c, 0, 0, 0); }
DEVI f32x4 mfma16(bf16x8 a, bf16x8 b, f32x4 c) { return __builtin_amdgcn_mfma_f32_16x16x32_bf16(a, b, c, 0, 0, 0); }
DEVI float ex2(float x) { return __builtin_amdgcn_exp2f(x); }

template <int X> DEVI float swz_xor(float v) { return __int_as_float(__builtin_amdgcn_ds_swizzle(__float_as_int(v), (X << 10) | 0x1f)); }
DEVI void halves(float v, float& lo, float& hi) {
  auto r = __builtin_amdgcn_permlane32_swap(__float_as_uint(v), __float_as_uint(v), false, false);
  lo = __uint_as_float(r[0]); hi = __uint_as_float(r[1]);
}
DEVI void halves_i(int v, int& lo, int& hi) {
  auto r = __builtin_amdgcn_permlane32_swap((unsigned)v, (unsigned)v, false, false);
  lo = (int)r[0]; hi = (int)r[1];
}
DEVI float hsum(float v) { float a, b; halves(v, a, b); return a + b; }
DEVI float hmax(float v) { float a, b; halves(v, a, b); return fmaxf(a, b); }
DEVI float sum16(float v) { v += swz_xor<1>(v); v += swz_xor<2>(v); v += swz_xor<4>(v); v += swz_xor<8>(v); return v; }
DEVI float sum64(float v) { v = sum16(v); v += swz_xor<16>(v); return hsum(v); }

DEVI u32x4 widen_pair(u32x2 a0, u32x2 a1, int h) {
  const unsigned sx = h ? a0[0] : a1[0], sy = h ? a0[1] : a1[1];
  const auto rx = __builtin_amdgcn_permlane32_swap(sx, sx, false, false);
  const auto ry = __builtin_amdgcn_permlane32_swap(sy, sy, false, false);
  const unsigned px = h ? rx[0] : rx[1], py = h ? ry[0] : ry[1];
  return h ? (u32x4){px, py, a1[0], a1[1]} : (u32x4){a0[0], a0[1], px, py};
}
DEVI int otid(int wv) { int t = wv * 64 + (int)__builtin_amdgcn_mbcnt_hi(~0u, __builtin_amdgcn_mbcnt_lo(~0u, 0u)); asm volatile("" : "+v"(t)); return t; }

constexpr double cexp_pos(double x) { double s = 1.0, t = 1.0; for (int i = 1; i < 100; ++i) { t *= x / i; s += t; } return s; }
constexpr float rope_inv(int p, int dim) { return (float)(1.0 / cexp_pos((2.0 * p / dim) * 9.210340371976184)); }
struct RopeTab { float d[32]; float m[64]; };
constexpr RopeTab make_rope_tab() { RopeTab t{}; for (int p = 0; p < 32; ++p) t.d[p] = rope_inv(p, 64); for (int p = 0; p < 64; ++p) t.m[p] = rope_inv(p, 128); return t; }
__device__ const RopeTab g_rope = make_rope_tab();

DEVI void sincos_f(float a, float& s, float& c) {
  float n = rintf(a * 0.636619772367581343f);
  float r = fmaf(-n, 1.5703125f, a);
  r = fmaf(-n, 4.837512969970703125e-4f, r);
  r = fmaf(-n, 7.54978995489188216e-8f, r);
  float r2 = r * r;
  float sp = r + r * r2 * (-1.66666667e-1f + r2 * (8.33333333e-3f + r2 * (-1.98412698e-4f + r2 * 2.75573192e-6f)));
  float cp = 1.f + r2 * (-0.5f + r2 * (4.16666667e-2f + r2 * (-1.38888889e-3f + r2 * (2.48015873e-5f + r2 * (-2.75573192e-7f)))));
  int q = ((int)n) & 3;
  float ss = (q & 1) ? cp : sp, cc = (q & 1) ? sp : cp;
  s = (q & 2) ? -ss : ss;
  c = ((q + 1) & 2) ? -cc : cc;
}

DEVI int perm_even(int c) {
  const int sec = c >> 9, cl = c & 511;
  if (sec == 0 || sec == 1) { const int mm = cl >> 6, j = cl & 63, second = j >> 5, p = j & 31; return sec * 512 + mm * 64 + (p >> 4) * 32 + second * 16 + (p & 15); }
  if (sec == 3 || sec == 4) { const int hh = cl >> 7, j = cl & 127, second = j >> 6, p = j & 63; return sec * 512 + hh * 128 + (p >> 4) * 32 + second * 16 + (p & 15); }
  return c;
}

DEVI int perm32_row(int c) {
  const int x = c & 31; return (c & ~31) + ((x >> 2) & 1) * 16 + (x >> 3) * 4 + (x & 3);
}
struct WJob { const float* W; int ldw; bf16_t* Wt; int K, k0, c0, perm; const float* gvec; const float* bvec; float* uvec; float* vvec; };
DEVI void wjob_load(const WJob& j, int t, f32x4& a, f32x4& b) {
  const float* src = j.W + (size_t)(j.k0 + (t >> 3)) * j.ldw + j.c0 + (t & 7) * 8;
  a = *(const f32x4*)src; b = *(const f32x4*)(src + 4);
}
DEVI void wtrans_tile(const WJob& jw, f32x4 a, f32x4 b, char* lds, int t) {
  bf16_t* Wt = jw.Wt; const int K = jw.K, k0 = jw.k0, c0 = jw.c0, perm = jw.perm;
  const float* gvec = jw.gvec; const float* bvec = jw.bvec; float* uvec = jw.uvec; float* vvec = jw.vvec;
  bf16_t* tl = (bf16_t*)lds;
  float* suw = (float*)(lds + 9216);
  const bool fold = gvec != nullptr;
  { const int kr = t >> 3, cc = (t & 7) * 8;
    if (fold) {
      const float gk = gvec[k0 + kr], bk = bvec[k0 + kr];
      float ua[8], va[8];
#pragma unroll
      for (int i = 0; i < 4; ++i) {
        const bf16_t ra = f2bf(a[i] * gk), rb = f2bf(b[i] * gk);
        tl[(cc + i) * 66 + kr] = ra; tl[(cc + 4 + i) * 66 + kr] = rb;
        ua[i] = bf2f(ra); ua[4 + i] = bf2f(rb); va[i] = a[i] * bk; va[4 + i] = b[i] * bk;
      }
#pragma unroll
      for (int i = 0; i < 8; ++i) {
        float x = ua[i], y = va[i];
        x += swz_xor<8>(x); y += swz_xor<8>(y);
        x += swz_xor<16>(x); y += swz_xor<16>(y);
        x = hsum(x); y = hsum(y);
        if ((t & 63) < 8) { suw[(t >> 6) * 128 + cc + i] = x; suw[(t >> 6) * 128 + 64 + cc + i] = y; }
      }
    } else {
#pragma unroll
      for (int i = 0; i < 4; ++i) { tl[(cc + i) * 66 + kr] = f2bf(a[i]); tl[(cc + 4 + i) * 66 + kr] = f2bf(b[i]); }
    } }
  __syncthreads();
  { const int c = t >> 3, kc = (t & 7) * 8;
    const unsigned* rp = (const unsigned*)(tl + c * 66 + kc);
    const u32x4 v = {rp[0], rp[1], rp[2], rp[3]};
    const int g = perm == 1 ? perm_even(c0 + c) : (perm == 2 || (perm == 3 && ((c0 + c) < 1024 || (c0 + c) >= 2048)) ? perm32_row(c0 + c) : (c0 + c));
    *(u32x4*)(Wt + (size_t)g * K + k0 + kc) = v; }
  if (fold && t < 128) {
    float acc = 0.f;
#pragma unroll
    for (int w8 = 0; w8 < 8; ++w8) acc += suw[w8 * 128 + t];
    const int c = t & 63;
    const int g = perm == 1 ? perm_even(c0 + c) : (perm == 2 || (perm == 3 && ((c0 + c) < 1024 || (c0 + c) >= 2048)) ? perm32_row(c0 + c) : (c0 + c));
    ((t < 64 ? uvec : vvec) + (size_t)(k0 >> 6) * 16384)[g] = acc;
  }
  __syncthreads();
}

DEVI void prologue(const Params& p, char* lds, int wv) {
  const int G = gridDim.x;
  unsigned char* ws = p.ws;
  auto decode = [&](int jb, WJob& j) {
    const int l = jb / 3072; int rem = jb % 3072;
    bf16_t* wl = (bf16_t*)(ws + WS_WT + (size_t)l * WT_LAYER);
    float* uv = (float*)(ws + WS_UVP) + (size_t)l * 16 * 16384;
    j.gvec = nullptr; j.bvec = nullptr; j.uvec = nullptr; j.vvec = nullptr;
    if (rem < 768) {
      const int kt = rem / 48, ct = rem % 48;
      j.K = 1024; j.k0 = kt * 64; j.c0 = ct * 64; j.Wt = wl;
      if (l & 1) { j.W = p.in[5] + (size_t)(l >> 1) * 1024 * 3088; j.ldw = 3088; j.perm = 3; j.gvec = p.in[14] + (l - 1) * 1024; j.bvec = p.in[15] + (l - 1) * 1024; j.uvec = uv + UV_U_IN; j.vvec = uv + UV_V_IN; }
      else       { j.W = p.in[1] + (size_t)(l >> 1) * 1024 * 3072; j.ldw = 3072; j.perm = 1; }
    } else if (rem < 1024) {
      rem -= 768; const int kt = rem / 16, ct = rem % 16;
      j.W = (l & 1) ? p.in[9] + (size_t)(l >> 1) * 1024 * 1024 : p.in[4] + (size_t)(l >> 1) * 1024 * 1024;
      j.ldw = 1024; j.Wt = wl + 3 * 1024 * 1024; j.K = 1024; j.k0 = kt * 64; j.c0 = ct * 64; j.perm = 2;
    } else if (rem < 2048) {
      rem -= 1024; const int kt = rem / 64, ct = rem % 64;
      j.W = p.in[12] + (size_t)l * 1024 * 4096; j.ldw = 4096; j.Wt = wl + 4 * 1024 * 1024; j.K = 1024; j.k0 = kt * 64; j.c0 = ct * 64; j.perm = 2;
      j.gvec = p.in[10] + l * 1024; j.bvec = p.in[11] + l * 1024; j.uvec = uv + UV_U_F1; j.vvec = uv + UV_V_F1;
    } else {
      rem -= 2048; const int kt = rem / 16, ct = rem % 16;
      j.W = p.in[13] + (size_t)l * 4096 * 1024; j.ldw = 1024; j.Wt = wl + 8 * 1024 * 1024; j.K = 4096; j.k0 = kt * 64; j.c0 = ct * 64; j.perm = 2;
    }
  };
  { const int tw = otid(wv);
    int jb = blockIdx.x;
    WJob cur{}, nxt{}; f32x4 ca = {}, cbv = {}, na = {}, nb = {};
    if (jb < 4 * 3072) { decode(jb, cur); wjob_load(cur, tw, ca, cbv); }
#pragma unroll 1
    while (jb < 4 * 3072) {
      const int jn = jb + G;
      if (jn < 4 * 3072) { decode(jn, nxt); wjob_load(nxt, tw, na, nb); }
      wtrans_tile(cur, ca, cbv, lds, tw);
      cur = nxt; ca = na; cbv = nb; jb = jn;
    } }
  const int gt = blockIdx.x * 512 + otid(wv), GT = G * 512;
  { const int t = otid(wv); const int gw = blockIdx.x * 8 + (t >> 6), lane = t & 63;
    if (gw < 32) {
      const int o = gw >> 4, rr = gw & 15, lsrc = 2 * o;
      const float* gv = p.in[14] + lsrc * 1024; const float* bv = p.in[15] + lsrc * 1024;
      float us = 0.f, vs = 0.f;
      for (int k = lane; k < 1024; k += 64) {
        const float wgt = p.in[5][(size_t)o * 1024 * 3088 + (size_t)k * 3088 + 3072 + rr];
        const bf16_t rb = f2bf(wgt * gv[k]);
        ((bf16_t*)(ws + WS_WGD))[(o * 16 + rr) * 1024 + k] = rb;
        us += bf2f(rb); vs += wgt * bv[k];
      }
      us = sum64(us); vs = sum64(vs);
      if (lane == 0) { float* uv = (float*)(ws + WS_UV) + (size_t)(2 * o + 1) * 16384; uv[UV_U_GD + rr] = us; uv[UV_V_GD + rr] = vs; }
    } }
  for (int i = gt; i < 131072; i += GT) ((float*)(ws + WS_KM))[i] = 0.f;
  for (int i = gt; i < NTOK * DM / 8; i += 4 * GT) {
    f32x4 a[4], b[4];
#pragma unroll
    for (int k = 0; k < 4; ++k) { if (i + k * GT < NTOK * DM / 8) { const size_t e8 = (size_t)(i + k * GT) * 8; a[k] = *(const f32x4*)(p.in[0] + e8); b[k] = *(const f32x4*)(p.in[0] + e8 + 4); } }
#pragma unroll
    for (int k = 0; k < 4; ++k) {
      if (i + k * GT < NTOK * DM / 8) {
        u32x4 v = {pk_bf16(a[k][0], a[k][1]), pk_bf16(a[k][2], a[k][3]), pk_bf16(b[k][0], b[k][1]), pk_bf16(b[k][2], b[k][3])};
        *(u32x4*)((bf16_t*)(ws + WS_XB) + (size_t)(i + k * GT) * 8) = v;
      }
    }
  }
}

#define LAS __attribute__((address_space(3)))
constexpr int BM = 256, BK = 64, HALF = 128, HTB = HALF * BK * 2, NXCD = 8, WGM = 4;
DEVI int lds_byte(int r, int c) { const int st = (r >> 4) * 2 + (c >> 5), rr = r & 15, cc = c & 31, ob = rr * 64 + cc * 2; return st * 1024 + (ob ^ (((ob >> 9) & 1) << 5)); }
DEVI void stage_rc(int b, int& R, int& C) { const int st = b / 1024, sb = b % 1024, swz = sb ^ (((sb >> 9) & 1) << 5); R = (st >> 1) * 16 + swz / 64; C = (st & 1) * 32 + (swz % 64) / 2; }

enum { EPI_EVEN = 0, EPI_GLA = 1, EPI_RES = 2, EPI_FFN1 = 3 };
struct EpiArgs {
  int kind;
  bf16_t* H; bf16_t* vt0; bf16_t* vt1; float* kmsum;
  bf16_t* Hff;
  const float* stat_in; const float* u; const float* v;
  bf16_t* Y; float* X;
  const float* stat_prev; const float* gprev; const float* bprev;
  float* stat_new; int final_out;
};
DEVI void row_sums(const float* raw, int row, float& s1, float& s2) {
  typedef float f32x2 __attribute__((ext_vector_type(2)));
  float a1 = 0.f, a2 = 0.f;
#pragma unroll
  for (int k = 0; k < 16; ++k) { const f32x2 p = *(const f32x2*)(raw + (size_t)k * 65536 + 2 * row); a1 += p[0]; a2 += p[1]; }
  s1 = a1; s2 = a2;
}
DEVI void stat_finalize(const float* raw, float* mr, int wv) {
  for (int row = blockIdx.x * 512 + otid(wv); row < NTOK; row += gridDim.x * 512) {
    float s1, s2; row_sums(raw, row, s1, s2);
    const float mu = s1 * (1.f / 1024.f);
    const float var = fmaxf(s2 * (1.f / 1024.f) - mu * mu, 0.f);
    mr[2 * row] = mu; mr[2 * row + 1] = rsqrtf(var + 1e-5f);
  }
}
DEVI void row_mu_rstd(const float* mr, int row, float& mu, float& rstd) { mu = mr[2 * row]; rstd = mr[2 * row + 1]; }
struct Unit { int brow, bcol, swap; };

DEVI bool unit_next(int i, int nN, int kind, Unit& u) {
  const int nM = NTOK / BM, nwg = nM * nN;
  const long L = (long)i * gridDim.x + blockIdx.x;
  if (L >= nwg) return false;
  int wgid = (int)L;
  { const int q = nwg / NXCD, r = nwg % NXCD, xcd = wgid % NXCD, off = wgid / NXCD; wgid = (xcd < r ? xcd * (q + 1) : r * (q + 1) + (xcd - r) * q) + off; }
  const int nig = WGM * nN, gid = wgid / nig, fm = gid * WGM, gsz = (nM - fm) < WGM ? (nM - fm) : WGM;
  const int pm = fm + ((wgid % nig) % gsz), pn = (wgid % nig) / gsz;
  u.brow = pm * BM; u.bcol = pn * BM;
  const int sec = u.bcol >> 9;
  u.swap = (kind == EPI_EVEN && (sec == 2 || sec == 5)) || (kind == EPI_GLA && (sec == 2 || sec == 3));
  return true;
}

DEVI void acc_init(f32x4 (&acc)[2][2][4][2], const Unit& un, int wr, int wc, int fr, int fq, const EpiArgs& e) {
  if (!e.stat_in) {
#pragma unroll
    for (int a = 0; a < 2; ++a)
#pragma unroll
      for (int b = 0; b < 2; ++b)
#pragma unroll
        for (int m = 0; m < 4; ++m)
#pragma unroll
          for (int n = 0; n < 2; ++n) acc[a][b][m][n] = (f32x4){0.f, 0.f, 0.f, 0.f};
  } else if (!un.swap) {
    float nmu[8];
#pragma unroll
    for (int q = 0; q < 8; ++q) nmu[q] = -e.stat_in[2 * (un.brow + (q >> 2) * 128 + wr * 64 + (q & 3) * 16 + fr)];
#pragma unroll
    for (int bj = 0; bj < 2; ++bj)
#pragma unroll
      for (int n = 0; n < 2; ++n) {
        const f32x4 u4 = *(const f32x4*)(e.u + un.bcol + bj * 128 + wc * 32 + n * 16 + 4 * fq);
#pragma unroll
        for (int q = 0; q < 8; ++q) acc[q >> 2][bj][q & 3][n] = u4 * nmu[q];
      }
  } else {
    float uc[8];
#pragma unroll
    for (int q = 0; q < 8; ++q) uc[q] = e.u[un.bcol + (q >> 2) * 128 + wr * 64 + (q & 3) * 16 + fr];
#pragma unroll
    for (int bj = 0; bj < 2; ++bj)
#pragma unroll
      for (int n = 0; n < 2; ++n) {
        const int tok = un.brow + bj * 128 + wc * 32 + n * 16 + 4 * fq;
        const f32x4 sa = *(const f32x4*)(e.stat_in + 2 * tok), sb = *(const f32x4*)(e.stat_in + 2 * tok + 4);
        const f32x4 nmu = {-sa[0], -sa[2], -sb[0], -sb[2]};
#pragma unroll
        for (int q = 0; q < 8; ++q) acc[q >> 2][bj][q & 3][n] = nmu * uc[q];
      }
  }
}
DEVI float row_rstd(const float* mr, int row) { return mr[2 * row + 1]; }
DEVI f32x4 rstd4(const float* mr, int tok) {
  const f32x4 sa = *(const f32x4*)(mr + 2 * tok), sb = *(const f32x4*)(mr + 2 * tok + 4);
  return (f32x4){sa[1], sa[3], sb[1], sb[3]};
}

template <bool FOLD>
DEVI void epi_vt(const f32x4 (&acc)[2][2][4][2], bf16_t* vt, int chan0, int tok0, int nchan, int wr, int wc, int fr, int fq, const EpiArgs& e, int gcol0) {
  const int b = tok0 >> 13, s0 = tok0 & 8191;
  f32x4 rs[2][2];
#pragma unroll
  for (int bj = 0; bj < 2; ++bj)
#pragma unroll
    for (int n = 0; n < 2; ++n) { if (FOLD) rs[bj][n] = rstd4(e.stat_in, tok0 + bj * 128 + wc * 32 + n * 16 + 4 * fq); else rs[bj][n] = (f32x4){1.f, 1.f, 1.f, 1.f}; }
  float vcs[8];
#pragma unroll
  for (int q = 0; q < 8; ++q) { if (FOLD) vcs[q] = e.v[gcol0 + (q >> 2) * 128 + wr * 64 + (q & 3) * 16 + fr]; else vcs[q] = 0.f; }
#pragma unroll
  for (int ai = 0; ai < 2; ++ai)
#pragma unroll
    for (int m = 0; m < 4; ++m) {
      bf16_t* rowp = (bf16_t*)((char*)vt + ((unsigned)(b * nchan + chan0 + ai * 128 + wr * 64 + m * 16 + fr) * 8192u + (unsigned)(s0 + wc * 32 + 4 * fq)) * 2u);
      const float vc = vcs[ai * 4 + m];
#pragma unroll
      for (int bj = 0; bj < 2; ++bj)
#pragma unroll
        for (int n = 0; n < 2; ++n) {
          const f32x4 v = acc[ai][bj][m][n] * rs[bj][n] + vc;
          u32x2 w2 = {pk_bf16(v[0], v[1]), pk_bf16(v[2], v[3])};
          *(u32x2*)(rowp + bj * 128 + n * 16) = w2;
        }
    }
}

DEVI void epi_even(const f32x4 (&acc)[2][2][4][2], const Unit& u, int wr, int wc, int fr, int fq, const EpiArgs& e) {
  const int sec = u.bcol >> 9;
  if (u.swap) { epi_vt<false>(acc, sec == 2 ? e.vt0 : e.vt1, u.bcol & 511, u.brow, 512, wr, wc, fr, fq, e, u.bcol); return; }
  const bool moba = sec >= 3;
  const int b = u.brow >> 13, sb = u.brow & 8191;
#pragma unroll
  for (int bj = 0; bj < 2; ++bj) {
    const int gl = (u.bcol & 511) + bj * 128 + wc * 32;
    int p0, c1, half;
    if (!moba) { const int mm = gl >> 6, grp = (gl >> 5) & 1; p0 = grp * 16 + 4 * fq; c1 = sec * 512 + mm * 64 + p0; half = 32; }
    else       { const int hh = gl >> 7, grp = (gl >> 5) & 3; p0 = grp * 16 + 4 * fq; c1 = sec * 512 + hh * 128 + p0; half = 64; }
    const f32x4 inv = moba ? *(const f32x4*)(g_rope.m + p0) : *(const f32x4*)(g_rope.d + p0);
    f32x4 ks1 = {0.f, 0.f, 0.f, 0.f}, ks2 = {0.f, 0.f, 0.f, 0.f};
#pragma unroll
    for (int ai = 0; ai < 2; ++ai)
#pragma unroll
      for (int m = 0; m < 4; ++m) {
        const int row = u.brow + ai * 128 + wr * 64 + m * 16 + fr;
        const float pos = (float)(row & 8191);
        const f32x4 x1 = acc[ai][bj][m][0], x2 = acc[ai][bj][m][1];
        f32x4 y1, y2;
#pragma unroll
        for (int j = 0; j < 4; ++j) {
          float sn, cs; sincos_f(pos * inv[j], sn, cs);
          y1[j] = x1[j] * cs - x2[j] * sn; y2[j] = x2[j] * cs + x1[j] * sn;
        }
        u32x2 w1 = {pk_bf16(y1[0], y1[1]), pk_bf16(y1[2], y1[3])}, w2 = {pk_bf16(y2[0], y2[1]), pk_bf16(y2[2], y2[3])};
        const unsigned hoff = (unsigned)row * 6144u + (unsigned)c1 * 2u;
        *(u32x2*)((char*)e.H + hoff) = w1;
        *(u32x2*)((char*)e.H + hoff + (unsigned)half * 2u) = w2;
        ks1 += y1; ks2 += y2;
        __builtin_amdgcn_sched_barrier(0);
      }
    if (sec == 4) {
#pragma unroll
      for (int j = 0; j < 4; ++j) {
        float a = ks1[j], c = ks2[j];
        a = sum16(a); c = sum16(c);
        if (fr == 0) {
          float* kp = e.kmsum + (size_t)(b * 32 + (sb >> 8)) * 512 + (c1 - 2048) + j;
          atomicAdd(kp, a); atomicAdd(kp + 64, c);
        }
      }
    }
  }
}

DEVI void epi_gla(const f32x4 (&acc)[2][2][4][2], const Unit& u, int wr, int wc, int fr, int fq, const EpiArgs& e) {
  if (u.swap) { epi_vt<true>(acc, e.vt0, u.bcol - 1024, u.brow, 1024, wr, wc, fr, fq, e, u.bcol); return; }
  const int cb = (u.bcol < 1024) ? u.bcol : u.bcol - 1024;
  f32x4 v4[2][2];
#pragma unroll
  for (int bj = 0; bj < 2; ++bj)
#pragma unroll
    for (int n = 0; n < 2; ++n) v4[bj][n] = *(const f32x4*)(e.v + u.bcol + bj * 128 + wc * 32 + n * 16 + 4 * fq);
  float rsq[8];
#pragma unroll
  for (int q = 0; q < 8; ++q) rsq[q] = row_rstd(e.stat_in, u.brow + (q >> 2) * 128 + wr * 64 + (q & 3) * 16 + fr);
#pragma unroll
  for (int ai = 0; ai < 2; ++ai)
#pragma unroll
    for (int m = 0; m < 4; ++m) {
      bf16_t* rowp = (bf16_t*)((char*)e.H + ((unsigned)(u.brow + ai * 128 + wr * 64 + m * 16 + fr) * 2048u + (unsigned)(cb + wc * 32 + 8 * fq)) * 2u);
      const float rsr = rsq[ai * 4 + m];
#pragma unroll
      for (int bj = 0; bj < 2; ++bj) {
        const f32x4 v0 = acc[ai][bj][m][0] * rsr + v4[bj][0], v1 = acc[ai][bj][m][1] * rsr + v4[bj][1];
        u32x4 w4 = {pk_bf16(v0[0], v0[1]), pk_bf16(v0[2], v0[3]), pk_bf16(v1[0], v1[1]), pk_bf16(v1[2], v1[3])};
        *(u32x4*)(rowp + bj * 128) = w4;
      }
    }
}

DEVI void epi_res(const f32x4 (&acc)[2][2][4][2], const Unit& u, int wr, int wc, int fr, int fq, const EpiArgs& e) {
  float mus[8], rsd[8]; f32x4 g4[2][2], b4[2][2];
  const bool ln = e.stat_prev != nullptr;
  if (ln) {
#pragma unroll
    for (int q = 0; q < 8; ++q) row_mu_rstd(e.stat_prev, u.brow + (q >> 2) * 128 + wr * 64 + (q & 3) * 16 + fr, mus[q], rsd[q]);
#pragma unroll
    for (int bj = 0; bj < 2; ++bj)
#pragma unroll
      for (int n = 0; n < 2; ++n) {
        const int c = u.bcol + bj * 128 + wc * 32 + 8 * fq + 4 * n;
        g4[bj][n] = *(const f32x4*)(e.gprev + c); b4[bj][n] = *(const f32x4*)(e.bprev + c);
      }
  } else {
#pragma unroll
    for (int q = 0; q < 8; ++q) { mus[q] = 0.f; rsd[q] = 1.f; }
#pragma unroll
    for (int bj = 0; bj < 2; ++bj)
#pragma unroll
      for (int n = 0; n < 2; ++n) { g4[bj][n] = (f32x4){1.f, 1.f, 1.f, 1.f}; b4[bj][n] = (f32x4){0.f, 0.f, 0.f, 0.f}; }
  }
#pragma unroll
  for (int ai = 0; ai < 2; ++ai)
#pragma unroll
    for (int m = 0; m < 4; ++m) {
      const int row = u.brow + ai * 128 + wr * 64 + m * 16 + fr;
      const unsigned o0 = (unsigned)row * 1024u + (unsigned)(u.bcol + wc * 32 + 8 * fq);
      const float mu = mus[ai * 4 + m], rstd = rsd[ai * 4 + m];
      u32x4 rb[2];
#pragma unroll
      for (int bj = 0; bj < 2; ++bj) rb[bj] = *(const u32x4*)((const char*)e.Y + (o0 + bj * 128) * 2u);
      float s1 = 0.f, s2 = 0.f;
#pragma unroll
      for (int bj = 0; bj < 2; ++bj) {
        const unsigned o = o0 + bj * 128;
        f32x4 r0 = {bflo(rb[bj][0]), bfhi(rb[bj][0]), bflo(rb[bj][1]), bfhi(rb[bj][1])};
        f32x4 r1 = {bflo(rb[bj][2]), bfhi(rb[bj][2]), bflo(rb[bj][3]), bfhi(rb[bj][3])};
        r0 = (r0 - mu) * rstd * g4[bj][0] + b4[bj][0];
        r1 = (r1 - mu) * rstd * g4[bj][1] + b4[bj][1];
        const f32x4 y0 = r0 * DN_ALPHA + acc[ai][bj][m][0], y1 = r1 * DN_ALPHA + acc[ai][bj][m][1];
        u32x4 w4 = {pk_bf16(y0[0], y0[1]), pk_bf16(y0[2], y0[3]), pk_bf16(y1[0], y1[1]), pk_bf16(y1[2], y1[3])};
        *(u32x4*)((char*)e.Y + o * 2u) = w4;
        if (e.final_out) { *(f32x4*)((char*)e.X + o * 4u) = y0; *(f32x4*)((char*)e.X + o * 4u + 16) = y1; }
        s1 += ((y0[0] + y0[1]) + (y0[2] + y0[3])) + ((y1[0] + y1[1]) + (y1[2] + y1[3]));
        s2 += ((y0[0] * y0[0] + y0[1] * y0[1]) + (y0[2] * y0[2] + y0[3] * y0[3])) + ((y1[0] * y1[0] + y1[1] * y1[1]) + (y1[2] * y1[2] + y1[3] * y1[3]));
      }
      s1 += swz_xor<16>(s1); s2 += swz_xor<16>(s2);
      s1 = hsum(s1); s2 = hsum(s2);
      if (fq == 0) { float* sp = e.stat_new + (size_t)((u.bcol >> 8) * 4 + wc) * 65536 + 2 * row; sp[0] = s1; sp[1] = s2; }
    }
}

DEVI void epi_ffn1(const f32x4 (&acc)[2][2][4][2], const Unit& u, int wr, int wc, int fr, int fq, const EpiArgs& e) {
  float rs[8]; f32x4 v4[2][2];
#pragma unroll
  for (int q = 0; q < 8; ++q) rs[q] = row_rstd(e.stat_in, u.brow + (q >> 2) * 128 + wr * 64 + (q & 3) * 16 + fr);
#pragma unroll
  for (int bj = 0; bj < 2; ++bj)
#pragma unroll
    for (int n = 0; n < 2; ++n) v4[bj][n] = *(const f32x4*)(e.v + u.bcol + bj * 128 + wc * 32 + n * 16 + 4 * fq);
#pragma unroll
  for (int ai = 0; ai < 2; ++ai)
#pragma unroll
    for (int m = 0; m < 4; ++m) {
      bf16_t* rowp = (bf16_t*)((char*)e.Hff + ((unsigned)(u.brow + ai * 128 + wr * 64 + m * 16 + fr) * 4096u + (unsigned)(u.bcol + wc * 32 + 8 * fq)) * 2u);
      const float rsr = rs[ai * 4 + m];
#pragma unroll
      for (int bj = 0; bj < 2; ++bj) {
        f32x4 v0 = acc[ai][bj][m][0] * rsr + v4[bj][0], v1 = acc[ai][bj][m][1] * rsr + v4[bj][1];
#pragma unroll
        for (int j = 0; j < 4; ++j) { const float t0 = fmaxf(v0[j], 0.f), t1 = fmaxf(v1[j], 0.f); v0[j] = t0 * t0; v1[j] = t1 * t1; }
        u32x4 w4 = {pk_bf16(v0[0], v0[1]), pk_bf16(v0[2], v0[3]), pk_bf16(v1[0], v1[1]), pk_bf16(v1[2], v1[3])};
        *(u32x4*)(rowp + bj * 128) = w4;
      }
    }
}

extern __shared__ __attribute__((aligned(16))) unsigned char g_lds[];

DEVI void gemm_phase(const bf16_t* A, const bf16_t* Bt, int N, int K, const EpiArgs& e, int wv) {
  LAS unsigned char* lds = (LAS unsigned char*)g_lds;
  const int tid = otid(wv), wid = __builtin_amdgcn_readfirstlane(tid >> 6), lane = tid & 63, wr = wid >> 2, wc = wid & 3, fr = lane & 15, fq = lane >> 4;
  const int nt = K / BK, nN = N / BM;
  unsigned voff[2];
#pragma unroll
  for (int i = 0; i < 2; ++i) { int R, C; stage_rc(tid * 16 + i * 8192, R, C); voff[i] = (unsigned)(R * K + C) * 2u; }
  const size_t kstep = (size_t)(BK * 2);
  const size_t hstep = (size_t)HALF * K * 2;
  const size_t tstep = 2 * hstep;
  const unsigned ldsw = (unsigned)wid * 1024u;
  const int aoff = lds_byte(wr * 64 + fr, fq * 8), boff = lds_byte(wc * 32 + fr, fq * 8);
#define PG8_SA(b, h) (((b) * 2 + (h)) * HTB)
#define PG8_SB(b, h) ((4 + (b) * 2 + (h)) * HTB)
#define PG8_STAGE(bufoff, gbase) do { _Pragma("unroll") for (int _i = 0; _i < 2; ++_i) \
    __builtin_amdgcn_global_load_lds((const unsigned*)((const char*)(gbase) + voff[_i]), (LAS unsigned*)(lds + (bufoff) + ldsw + _i * 8192), 16, 0, 0); } while (0)
#define PG8_LDA(dst, b, h) do { _Pragma("unroll") for (int m = 0; m < 4; ++m) _Pragma("unroll") for (int k = 0; k < 2; ++k) dst[m][k] = *(const LAS bf16x8*)(lds + PG8_SA(b, h) + aoff + m * 2048 + k * 1024); } while (0)
#define PG8_LDB(dst, b, h) do { _Pragma("unroll") for (int n = 0; n < 2; ++n) _Pragma("unroll") for (int k = 0; k < 2; ++k) dst[n][k] = *(const LAS bf16x8*)(lds + PG8_SB(b, h) + boff + n * 2048 + k * 1024); } while (0)
#define PG8_MMA(ai, bj, At, Bt_) do { __builtin_amdgcn_s_setprio(1); _Pragma("unroll") for (int m = 0; m < 4; ++m) _Pragma("unroll") for (int n = 0; n < 2; ++n) _Pragma("unroll") for (int k = 0; k < 2; ++k) \
    acc[ai][bj][m][n] = __builtin_amdgcn_mfma_f32_16x16x32_bf16(Bt_[n][k], At[m][k], acc[ai][bj][m][n], 0, 0, 0); __builtin_amdgcn_s_setprio(0); } while (0)
#define PG8_WAIT_V(n) asm volatile("s_waitcnt vmcnt(" #n ")" ::: "memory")
#define PG8_WAIT_L(n) asm volatile("s_waitcnt lgkmcnt(" #n ")" ::: "memory")
#define PG8_BAR __builtin_amdgcn_s_barrier()
#define PG8_SCHED __builtin_amdgcn_sched_barrier(0)
#define UNIT_P(u) ((const char*)((u).swap ? Bt : A) + (size_t)(((u).swap ? (u).bcol : (u).brow) >> 8) * tstep)
#define UNIT_Q(u) ((const char*)((u).swap ? A : Bt) + (size_t)(((u).swap ? (u).brow : (u).bcol) >> 8) * tstep)
  Unit cur, nxt; int ui = 0;
  if (!unit_next(0, nN, e.kind, cur)) return;
  f32x4 acc[2][2][4][2];
  acc_init(acc, cur, wr, wc, fr, fq, e);
  bf16x8 At[4][2], B0[2][2], B1[2][2];
  const char* cA = UNIT_P(cur); const char* cB = UNIT_Q(cur);
  PG8_STAGE(PG8_SB(0, 0), cB); PG8_STAGE(PG8_SB(0, 1), cB + hstep); PG8_STAGE(PG8_SA(0, 0), cA); PG8_STAGE(PG8_SA(0, 1), cA + hstep);
  if (wr == 1) PG8_BAR;
  PG8_WAIT_V(2); PG8_BAR;
  PG8_STAGE(PG8_SB(1, 0), cB + kstep); PG8_STAGE(PG8_SA(1, 0), cA + kstep); PG8_STAGE(PG8_SB(1, 1), cB + hstep + kstep);
  PG8_WAIT_V(6); PG8_BAR;
  for (;;) {
    const bool has_next = unit_next(ui + 1, nN, e.kind, nxt);
    const char* nA = has_next ? UNIT_P(nxt) : cA; const char* nB = has_next ? UNIT_Q(nxt) : cB;
#pragma unroll 1
    for (int t = 0; t < nt; t += 2) {
      const bool last = (t == nt - 2);
      const char* a1 = cA + (size_t)(t + 1) * kstep;
      const char* a2 = last ? nA : cA + (size_t)(t + 2) * kstep; const char* b2 = last ? nB : cB + (size_t)(t + 2) * kstep;
      const char* a3 = a2 + kstep; const char* b3 = b2 + kstep;
      PG8_LDB(B0, 0, 0); PG8_LDB(B1, 0, 1); PG8_SCHED; PG8_LDA(At, 0, 0); PG8_STAGE(PG8_SA(1, 1), a1 + hstep);
      PG8_WAIT_V(8); PG8_WAIT_L(0); PG8_BAR; PG8_MMA(0, 0, At, B0); PG8_MMA(0, 1, At, B1); PG8_BAR; PG8_SCHED;
      PG8_LDA(At, 0, 1); PG8_STAGE(PG8_SB(0, 0), b2); PG8_STAGE(PG8_SB(0, 1), b2 + hstep); PG8_STAGE(PG8_SA(0, 0), a2);
      PG8_WAIT_V(8); PG8_WAIT_L(0); PG8_BAR; PG8_MMA(1, 0, At, B0); PG8_MMA(1, 1, At, B1); PG8_BAR; PG8_SCHED;
      PG8_LDB(B0, 1, 0); PG8_LDB(B1, 1, 1); PG8_SCHED; PG8_LDA(At, 1, 0); PG8_STAGE(PG8_SA(0, 1), a2 + hstep);
      PG8_WAIT_V(8); PG8_WAIT_L(0); PG8_BAR; PG8_MMA(0, 0, At, B0); PG8_MMA(0, 1, At, B1); PG8_BAR; PG8_SCHED;
      PG8_LDA(At, 1, 1); PG8_STAGE(PG8_SB(1, 0), b3); PG8_STAGE(PG8_SB(1, 1), b3 + hstep); PG8_STAGE(PG8_SA(1, 0), a3);
      PG8_WAIT_V(8); PG8_WAIT_L(0); PG8_BAR; PG8_MMA(1, 0, At, B0); PG8_MMA(1, 1, At, B1); PG8_BAR; PG8_SCHED;
    }
    if (wr == 0) PG8_BAR;
    {
      const int tid_e = otid(wv);
      const int wid_e = __builtin_amdgcn_readfirstlane(tid_e >> 6), lane_e = tid_e & 63;
      const int wr_e = wid_e >> 2, wc_e = wid_e & 3, fr_e = lane_e & 15, fq_e = lane_e >> 4;
      if (e.kind == EPI_EVEN) epi_even(acc, cur, wr_e, wc_e, fr_e, fq_e, e);
      else if (e.kind == EPI_GLA) epi_gla(acc, cur, wr_e, wc_e, fr_e, fq_e, e);
      else if (e.kind == EPI_RES) epi_res(acc, cur, wr_e, wc_e, fr_e, fq_e, e);
      else epi_ffn1(acc, cur, wr_e, wc_e, fr_e, fq_e, e);
    }
    if (!has_next) break;
    cur = nxt; cA = nA; cB = nB; ++ui;
    { const int tid_i = otid(wv); const int wid_i = __builtin_amdgcn_readfirstlane(tid_i >> 6), lane_i = tid_i & 63;
      acc_init(acc, cur, wid_i >> 2, wid_i & 3, lane_i & 15, lane_i >> 4, e); }
    if (wr == 1) PG8_BAR;
  }
  PG8_WAIT_V(0);
  PG8_BAR;
#undef PG8_SA
#undef PG8_SB
#undef PG8_STAGE
#undef PG8_LDA
#undef PG8_LDB
#undef PG8_MMA
}

DEVI void ln_phase(float* X, bf16_t* XB, const float* g, const float* bt, bool final_out, int wv) {
  const int tidl = otid(wv); const int w = tidl >> 6, lane = tidl & 63;
  const int stride = gridDim.x * 8;
  int row = blockIdx.x * 8 + w;
  f32x4 v[4], vn[4];
  if (row < NTOK) {
#pragma unroll
    for (int i = 0; i < 4; ++i) v[i] = *(const f32x4*)(X + (size_t)row * 1024 + i * 256 + lane * 4);
  }
  for (; row < NTOK; row += stride) {
    float* xr = X + (size_t)row * 1024;
    if (row + stride < NTOK) {
#pragma unroll
      for (int i = 0; i < 4; ++i) vn[i] = *(const f32x4*)(X + (size_t)(row + stride) * 1024 + i * 256 + lane * 4);
    }
    float s = 0.f;
#pragma unroll
    for (int i = 0; i < 4; ++i) s += (v[i][0] + v[i][1]) + (v[i][2] + v[i][3]);
    s = sum64(s);
    const float mu = s * (1.f / 1024.f);
    float q = 0.f;
#pragma unroll
    for (int i = 0; i < 4; ++i) { const f32x4 d = v[i] - mu; q += (d[0] * d[0] + d[1] * d[1]) + (d[2] * d[2] + d[3] * d[3]); }
    q = sum64(q);
    const float rstd = rsqrtf(q * (1.f / 1024.f) + 1e-5f);
#pragma unroll
    for (int i = 0; i < 4; ++i) {
      const int c = i * 256 + lane * 4;
      const f32x4 gg = *(const f32x4*)(g + c), bb = *(const f32x4*)(bt + c);
      const f32x4 y = (v[i] - mu) * rstd * gg + bb;
      if (final_out) *(f32x4*)(xr + c) = y;
      else { u32x2 pkd = {pk_bf16(y[0], y[1]), pk_bf16(y[2], y[3])}; *(u32x2*)(XB + (size_t)row * 1024 + c) = pkd; }
    }
#pragma unroll
    for (int i = 0; i < 4; ++i) v[i] = vn[i];
  }
}

DEVI void ln_bf16_phase(const bf16_t* Y, bf16_t* XN, const float* g, const float* bt, int wv) {
  const int tidl = otid(wv); const int w = tidl >> 6, lane = tidl & 63;
  const int stride = gridDim.x * 8;
  int row = blockIdx.x * 8 + w;
  u32x4 ra = {}, rb = {}, na = {}, nb = {};
  if (row < NTOK) { ra = *(const u32x4*)(Y + (size_t)row * 1024 + lane * 8); rb = *(const u32x4*)(Y + (size_t)row * 1024 + 512 + lane * 8); }
  for (; row < NTOK; row += stride, ra = na, rb = nb) {
    if (row + stride < NTOK) { na = *(const u32x4*)(Y + (size_t)(row + stride) * 1024 + lane * 8); nb = *(const u32x4*)(Y + (size_t)(row + stride) * 1024 + 512 + lane * 8); }
    float v[16];
#pragma unroll
    for (int i = 0; i < 4; ++i) { v[2 * i] = bflo(ra[i]); v[2 * i + 1] = bfhi(ra[i]); v[8 + 2 * i] = bflo(rb[i]); v[8 + 2 * i + 1] = bfhi(rb[i]); }
    float sacc = 0.f;
#pragma unroll
    for (int i = 0; i < 16; ++i) sacc += v[i];
    sacc = sum64(sacc);
    const float mu = sacc * (1.f / 1024.f);
    float q = 0.f;
#pragma unroll
    for (int i = 0; i < 16; ++i) { const float d = v[i] - mu; q += d * d; }
    q = sum64(q);
    const float rstd = rsqrtf(q * (1.f / 1024.f) + 1e-5f);
#pragma unroll
    for (int hf = 0; hf < 2; ++hf) {
      const int c = hf * 512 + lane * 8;
      const f32x4 g0 = *(const f32x4*)(g + c), g1 = *(const f32x4*)(g + c + 4), b0 = *(const f32x4*)(bt + c), b1 = *(const f32x4*)(bt + c + 4);
      float y[8];
#pragma unroll
      for (int i = 0; i < 4; ++i) { y[i] = (v[hf * 8 + i] - mu) * rstd * g0[i] + b0[i]; y[4 + i] = (v[hf * 8 + 4 + i] - mu) * rstd * g1[i] + b1[i]; }
      u32x4 o = {pk_bf16(y[0], y[1]), pk_bf16(y[2], y[3]), pk_bf16(y[4], y[5]), pk_bf16(y[6], y[7])};
      *(u32x4*)(XN + (size_t)row * 1024 + c) = o;
    }
  }
}

constexpr int AT_BUF = 34816;
struct TileRegs { u32x4 k0, k1, v0, v1; };
DEVI void at_gload(TileRegs& r, const bf16_t* Kbase, const bf16_t* VTbase, int key0, int t) {
  r.k0 = *(const u32x4*)(Kbase + (size_t)(key0 + (t >> 4)) * 3072 + (t & 15) * 8);
  r.k1 = *(const u32x4*)(Kbase + (size_t)(key0 + 32 + (t >> 4)) * 3072 + (t & 15) * 8);
  r.v0 = *(const u32x4*)(VTbase + (size_t)(t >> 3) * 8192 + key0 + (t & 7) * 8);
  r.v1 = *(const u32x4*)(VTbase + (size_t)(64 + (t >> 3)) * 8192 + key0 + (t & 7) * 8);
}
DEVI void at_lstore(const TileRegs& r, unsigned char* buf, int t) {
  *(u32x4*)(buf + (t >> 4) * 272 + (t & 15) * 16) = r.k0;
  *(u32x4*)(buf + (32 + (t >> 4)) * 272 + (t & 15) * 16) = r.k1;
  unsigned char* vb = buf + 17408;
  u32x2* p0 = (u32x2*)(vb + (t >> 3) * 136 + (t & 7) * 16);
  u32x2 a = {r.v0[0], r.v0[1]}, b = {r.v0[2], r.v0[3]}; p0[0] = a; p0[1] = b;
  u32x2* p1 = (u32x2*)(vb + (64 + (t >> 3)) * 136 + (t & 7) * 16);
  u32x2 c = {r.v1[0], r.v1[1]}, d = {r.v1[2], r.v1[3]}; p1[0] = c; p1[1] = d;
}

template <int MODE>
DEVI void attn_item(const bf16_t* H, const bf16_t* vT, const float* kmsum, bf16_t* AO, int b, int hh, int qi,
                    float lam_full, float one_m_linit, const float* subln, int wv) {
  constexpr int NKS = MODE ? 8 : 4;
  unsigned char* lds = g_lds;
  const int tid = otid(wv), w = tid >> 6, lane = tid & 63, r = lane & 31, h = lane >> 5;
  const int map = MODE ? 0 : (w & 1);
  const int q0 = MODE ? qi * 256 + w * 32 : qi * 128 + (w >> 1) * 32;
  const int ntiles = MODE ? 4 * (qi + 1) : 2 * qi + 2;
  const size_t tokbase = (size_t)b * 8192;
#ifdef MOBA_ON_DIFF
  const int qcol = MODE ? hh * 128 : hh * 128 + map * 64;
  const int kcol = 512 + hh * 128;
#else
  const int qcol = MODE ? 1536 + hh * 128 : hh * 128 + map * 64;
  const int kcol = MODE ? 2048 + hh * 128 : 512 + hh * 128;
#endif
  const bf16_t* Kbase = H + tokbase * 3072 + kcol;
  const bf16_t* VTbase = vT + (size_t)(b * 512 + hh * 128) * 8192;
  const float cs = (MODE ? 0.08838834764831845f : 0.125f) * 1.4426950408889634f;
  const int kboff = MODE ? 0 : map * 128;

  bf16x8 qf[NKS];
  { const bf16_t* qp = H + (tokbase + q0 + r) * 3072 + qcol + 8 * h;
#pragma unroll
    for (int ks = 0; ks < NKS; ++ks) qf[ks] = *(const bf16x8*)(qp + 16 * ks); }

  unsigned sel = 0;
  if (MODE) {
    f32x16 gt = {};
    const float* kmp = kmsum + (size_t)(b * 32 + r) * 512 + hh * 128 + 8 * h;
    f32x4 kma[8], kmc[8];
#pragma unroll
    for (int ks = 0; ks < 8; ++ks) { kma[ks] = *(const f32x4*)(kmp + 16 * ks); kmc[ks] = *(const f32x4*)(kmp + 16 * ks + 4); }
#pragma unroll
    for (int ks = 0; ks < 8; ++ks) {
      const f32x4 a = kma[ks] * (1.f / 256.f), c = kmc[ks] * (1.f / 256.f);
      gt = mfma32(mk8(pk_bf16(a[0], a[1]), pk_bf16(a[2], a[3]), pk_bf16(c[0], c[1]), pk_bf16(c[2], c[3])), qf[ks < NKS ? ks : 0], gt);
    }
    float gv[16];
#pragma unroll
    for (int rg = 0; rg < 16; ++rg) { const int blk = (rg & 3) + 8 * (rg >> 2) + 4 * h; gv[rg] = (blk < qi) ? gt[rg] : NEG_INF; }
#pragma unroll
    for (int round = 0; round < 3; ++round) {
      float best = NEG_INF; int bi = 99;
#pragma unroll
      for (int rg = 0; rg < 16; ++rg) { const int blk = (rg & 3) + 8 * (rg >> 2) + 4 * h; if (gv[rg] > best) { best = gv[rg]; bi = blk; } }
      float b_lo, b_hi; int i_lo, i_hi; halves(best, b_lo, b_hi); halves_i(bi, i_lo, i_hi);
      const bool lowin = (b_lo > b_hi) || (b_lo == b_hi && i_lo < i_hi);
      const float wval = lowin ? b_lo : b_hi; const int wi = lowin ? i_lo : i_hi;
      if (wval > NEG_INF) sel |= 1u << wi;
#pragma unroll
      for (int rg = 0; rg < 16; ++rg) { const int blk = (rg & 3) + 8 * (rg >> 2) + 4 * h; if (blk == wi) gv[rg] = NEG_INF; }
    }
  }

#ifdef SELFIX
  if (MODE) sel = (qi >= 3) ? 7u : ((1u << qi) - 1u);
#endif
  f32x16 o[4] = {};
  float m = NEG_INF, l = 0.f;
  TileRegs tr;
  at_gload(tr, Kbase, VTbase, 0, tid); at_lstore(tr, lds, tid); __syncthreads();
#pragma unroll 1
  for (int tt = 0; tt < ntiles; ++tt) {
    const unsigned char* buf = lds + (tt & 1) * AT_BUF;
    const int key0 = tt * 64;
    if (tt + 1 < ntiles) at_gload(tr, Kbase, VTbase, key0 + 64, tid);
    bool active, needmask, lanesel = true;
    if (MODE && (tt >> 2) < qi) { lanesel = (sel >> (tt >> 2)) & 1u; active = __any(lanesel ? 1 : 0) != 0; needmask = false; }
    else { active = key0 <= q0 + 31; needmask = key0 + 63 > q0; }
    if (active) {
      f32x16 st[2];
      {
        bf16x8 kfa[NKS], kfb[NKS];
        const unsigned char* kp0 = buf + r * 272 + kboff + h * 16;
#pragma unroll
        for (int ks = 0; ks < NKS; ++ks) kfa[ks] = *(const bf16x8*)(kp0 + ks * 32);
#pragma unroll
        for (int ks = 0; ks < NKS; ++ks) kfb[ks] = *(const bf16x8*)(kp0 + 32 * 272 + ks * 32);
        __builtin_amdgcn_sched_barrier(0);
        f32x16 a0 = {}, a1 = {};
#pragma unroll
        for (int ks = 0; ks < NKS; ++ks) a0 = mfma32(kfa[ks], qf[ks], a0);
#pragma unroll
        for (int ks = 0; ks < NKS; ++ks) a1 = mfma32(kfb[ks], qf[ks], a1);
        st[0] = a0; st[1] = a1;
      }
      if (needmask) {
#pragma unroll
        for (int T = 0; T < 2; ++T)
#pragma unroll
          for (int rg = 0; rg < 16; ++rg) { const int key = key0 + 32 * T + 8 * (rg >> 2) + 4 * h + (rg & 3); if (key > q0 + r) st[T][rg] = NEG_INF; }
      }
      float mxr = NEG_INF;
#pragma unroll
      for (int T = 0; T < 2; ++T)
#pragma unroll
        for (int rg = 0; rg < 16; ++rg) mxr = fmaxf(mxr, st[T][rg]);
      mxr = hmax(mxr);
      const float mxs = lanesel ? mxr * cs : NEG_INF;
      if (__any((mxs > m + 8.0f) ? 1 : 0)) {
        const float mn = fmaxf(m, mxs);
        const float mu2 = (mn == NEG_INF) ? 0.f : mn;
        const float alpha = ex2(m - mu2);
        m = mn;
        l *= alpha;
#pragma unroll
        for (int dt = 0; dt < 4; ++dt) o[dt] = o[dt] * alpha;
      }
      const float nb = lanesel ? ((m == NEG_INF) ? 0.f : -m) : NEG_INF;
      float ps = 0.f;
#pragma unroll
      for (int T = 0; T < 2; ++T)
#pragma unroll
        for (int rg = 0; rg < 16; ++rg) { const float pv = ex2(fmaf(st[T][rg], cs, nb)); st[T][rg] = pv; ps += pv; }
      l += ps;
      {
        const unsigned char* vb0 = buf + 17408 + r * 136 + 8 * h;
        u32x2 vlo[2][4], vhi[2][4];
#pragma unroll
        for (int dt = 0; dt < 4; ++dt) { const unsigned char* vp = vb0 + dt * 32 * 136; vlo[0][dt] = *(const u32x2*)vp; vhi[0][dt] = *(const u32x2*)(vp + 16); }
#pragma unroll
        for (int step = 0; step < 4; ++step) {
          const int T = step >> 1, sx = step & 1;
          if (step < 3) {
#pragma unroll
            for (int dt = 0; dt < 4; ++dt) { const unsigned char* vp = vb0 + dt * 32 * 136 + (step + 1) * 32; vlo[(step + 1) & 1][dt] = *(const u32x2*)vp; vhi[(step + 1) & 1][dt] = *(const u32x2*)(vp + 16); }
          }
          const bf16x8 pb = pack8(st[T], sx);
#pragma unroll
          for (int dt = 0; dt < 4; ++dt) o[dt] = mfma32(mk8(vlo[step & 1][dt][0], vlo[step & 1][dt][1], vhi[step & 1][dt][0], vhi[step & 1][dt][1]), pb, o[dt]);
          __builtin_amdgcn_sched_barrier(0);
        }
      }
    }
    if (tt + 1 < ntiles) at_lstore(tr, lds + ((tt + 1) & 1) * AT_BUF, tid);
    __syncthreads();
  }
  const float lt = hsum(l);
  const float il = 1.f / lt;
  const size_t token = tokbase + q0 + r;
  if (MODE) {
#pragma unroll
    for (int dt = 0; dt < 4; ++dt)
#pragma unroll
      for (int gp = 0; gp < 2; ++gp) {
        const int g0 = 2 * gp, g1 = g0 + 1;
        const u32x2 a0 = {pk_bf16(o[dt][4 * g0] * il, o[dt][4 * g0 + 1] * il), pk_bf16(o[dt][4 * g0 + 2] * il, o[dt][4 * g0 + 3] * il)};
        const u32x2 a1 = {pk_bf16(o[dt][4 * g1] * il, o[dt][4 * g1 + 1] * il), pk_bf16(o[dt][4 * g1 + 2] * il, o[dt][4 * g1 + 3] * il)};
        *(u32x4*)(AO + token * 1024 + 512 + hh * 128 + 32 * dt + 8 * (g0 + h)) = widen_pair(a0, a1, h);
      }
  } else {
    float* ex = (float*)lds;
    const int rgp = w >> 1;
    if (map == 1) {
      const float f = il * lam_full;
#pragma unroll
      for (int dt = 0; dt < 4; ++dt)
#pragma unroll
        for (int rg = 0; rg < 16; ++rg) ex[((rgp * 4 + dt) * 16 + rg) * 64 + lane] = o[dt][rg] * f;
    }
    __syncthreads();
    if (map == 0) {
      float ss = 0.f;
#pragma unroll
      for (int dt = 0; dt < 4; ++dt)
#pragma unroll
        for (int rg = 0; rg < 16; ++rg) { const float d = o[dt][rg] * il - ex[((rgp * 4 + dt) * 16 + rg) * 64 + lane]; o[dt][rg] = d; ss += d * d; }
      ss = hsum(ss);
      const float rinv = rsqrtf(ss * (1.f / 128.f) + 1e-5f) * one_m_linit;
#pragma unroll
      for (int dt = 0; dt < 4; ++dt)
#pragma unroll
        for (int gp = 0; gp < 2; ++gp) {
          u32x2 a[2];
#pragma unroll
          for (int k = 0; k < 2; ++k) {
            const int g = 2 * gp + k, dv = 32 * dt + 8 * g + 4 * h;
            const f32x4 sl = *(const f32x4*)(lds + 130048 + dv * 4);
            a[k] = (u32x2){pk_bf16(o[dt][4 * g] * rinv * sl[0], o[dt][4 * g + 1] * rinv * sl[1]), pk_bf16(o[dt][4 * g + 2] * rinv * sl[2], o[dt][4 * g + 3] * rinv * sl[3])};
          }
          *(u32x4*)(AO + token * 1024 + hh * 128 + 32 * dt + 8 * (2 * gp + h)) = widen_pair(a[0], a[1], h);
        }
    }
    __syncthreads();
  }
}

#ifndef AM
#define AM 3
#endif
DEVI void attn_phase(const Params& p, int e, int wv) {
  asm volatile("" : "+s"(e));
  unsigned char* ws = p.ws;
  const bf16_t* H = (const bf16_t*)(ws + WS_OV + OV_H);
  const bf16_t* dvT = (const bf16_t*)(ws + WS_OV + OV_DVT);
  const bf16_t* mvT = (const bf16_t*)(ws + WS_OV + OV_MVT);
  const float* kmsum = (const float*)(ws + WS_KM) + (size_t)e * 65536;
  bf16_t* AO = (bf16_t*)(ws + WS_AO);
  const float* lam = p.in[2] + e * 256;
  float s1 = 0.f, s2 = 0.f;
  for (int i = 0; i < 64; ++i) { s1 += lam[i] * lam[64 + i]; s2 += lam[128 + i] * lam[192 + i]; }
  const float linit = (e == 0) ? 0.2f : 0.47071301834358413f;
  const float lam_full = __expf(s1) - __expf(s2) + linit;
  const float* subln = p.in[3] + e * 128;
  { const int t0 = otid(wv); if (t0 < 128) ((float*)(g_lds + 130048))[t0] = subln[t0]; __syncthreads(); }
  const int vb = (gridDim.x == 256) ? (int)((blockIdx.x & 7) * 32 + (blockIdx.x >> 3)) : (int)blockIdx.x;
#pragma unroll 1
  for (int u = vb; u < 768; u += gridDim.x) {
    if (u < 512) {
      if (!(AM & 1)) continue;
      const int pidx = (u & 255) * 2 + (u >> 8); const int bh = pidx >> 5, ip = pidx & 31;
      attn_item<0>(H, dvT, kmsum, AO, bh >> 2, bh & 3, 63 - ip, lam_full, 1.f - linit, subln, wv);
      attn_item<0>(H, dvT, kmsum, AO, bh >> 2, bh & 3, ip, lam_full, 1.f - linit, subln, wv);
    } else {
      if (!(AM & 2)) continue;
      const int pp = u - 512, bh = pp >> 4, jp = pp & 15;
#ifdef MOBA_ON_DIFF
#define MVT_SRC dvT
#else
#define MVT_SRC mvT
#endif
      attn_item<1>(H, MVT_SRC, kmsum, AO, bh >> 2, bh & 3, 31 - jp, lam_full, 1.f - linit, subln, wv);
      attn_item<1>(H, MVT_SRC, kmsum, AO, bh >> 2, bh & 3, jp, lam_full, 1.f - linit, subln, wv);
    }
  }
}

DEVI void gla_prep_item(int item, const bf16_t* XB, const bf16_t* WgdT, const float* Wup, const float* bgate,
                        bf16_t* Hg, bf16_t* kT, float* decay, const float* stat_in, const float* ugd, const float* vgd, int wv) {
  const int tid = otid(wv), w = tid >> 6, lane = tid & 63;
  const int b = item >> 7, ch = item & 127;
  const size_t tok0 = (size_t)b * 8192 + ch * 64;
  float* gd = (float*)g_lds;
  if (w < 4) {
    const int fr = lane & 15, fq = lane >> 4;
    f32x4 acc = {};
    const bf16_t* ap = XB + (tok0 + 16 * w + fr) * 1024 + 8 * fq;
    const bf16_t* bp = WgdT + fr * 1024 + 8 * fq;
#pragma unroll 1
    for (int k0 = 0; k0 < 32; k0 += 8) {
      bf16x8 af[8], bfr[8];
#pragma unroll
      for (int i = 0; i < 8; ++i) { af[i] = *(const bf16x8*)(ap + 32 * (k0 + i)); bfr[i] = *(const bf16x8*)(bp + 32 * (k0 + i)); }
#pragma unroll
      for (int i = 0; i < 8; ++i) acc = mfma16(af[i], bfr[i], acc);
    }
    const float ug = ugd[fr], vg = vgd[fr];
#pragma unroll
    for (int j = 0; j < 4; ++j) {
      float mu, rstd; row_mu_rstd(stat_in, (int)tok0 + 16 * w + 4 * fq + j, mu, rstd);
      gd[(16 * w + 4 * fq + j) * 16 + fr] = rstd * (acc[j] - mu * ug) + vg;
    }
  }
  __syncthreads();
  const int c = tid;
  float wup[16];
#pragma unroll
  for (int rr = 0; rr < 16; ++rr) wup[rr] = Wup[rr * 512 + c];
  const float bias = bgate[c];
  float bsum = 0.f;
  bf16_t* qp = Hg + tok0 * 2048 + c;
  bf16_t* kp = qp + 512;
  bf16_t* ktp = kT + (size_t)(b * 512 + c) * 8192 + ch * 64;
  bf16_t qv[8], kv[8], qn[8], kn[8];
#pragma unroll
  for (int tt = 0; tt < 8; ++tt) { qv[tt] = qp[(size_t)tt * 2048]; kv[tt] = kp[(size_t)tt * 2048]; }
#pragma unroll 1
  for (int t8 = 0; t8 < 8; ++t8) {
    if (t8 < 7) {
#pragma unroll
      for (int tt = 0; tt < 8; ++tt) { qn[tt] = qp[(size_t)((t8 + 1) * 8 + tt) * 2048]; kn[tt] = kp[(size_t)((t8 + 1) * 8 + tt) * 2048]; }
    }
    unsigned short kb[8];
#pragma unroll
    for (int tt = 0; tt < 8; ++tt) {
      const int t = t8 * 8 + tt;
      const f32x4* g4 = (const f32x4*)(gd + t * 16);
      float z = bias;
#pragma unroll
      for (int i = 0; i < 4; ++i) { const f32x4 gg = g4[i]; z += gg[0] * wup[4 * i] + gg[1] * wup[4 * i + 1] + gg[2] * wup[4 * i + 2] + gg[3] * wup[4 * i + 3]; }
      const float ls = fminf(z, 0.f) - __logf(1.f + __expf(-fabsf(z)));
      bsum += ls * 0.0625f;
      const float eb = __expf(bsum), en = __expf(-bsum);
      const float q = bf2f(qv[tt]), k = bf2f(kv[tt]);
      qp[(size_t)t * 2048] = f2bf(q * eb * 0.08838834764831845f);
      const bf16_t kk = f2bf(k * en);
      kp[(size_t)t * 2048] = kk;
      kb[tt] = kk;
    }
    u32x4 pk = {(unsigned)kb[0] | ((unsigned)kb[1] << 16), (unsigned)kb[2] | ((unsigned)kb[3] << 16),
                (unsigned)kb[4] | ((unsigned)kb[5] << 16), (unsigned)kb[6] | ((unsigned)kb[7] << 16)};
    *(u32x4*)(ktp + t8 * 8) = pk;
#pragma unroll
    for (int tt = 0; tt < 8; ++tt) { qv[tt] = qn[tt]; kv[tt] = kn[tt]; }
  }
  decay[(size_t)(b * 128 + ch) * 512 + c] = __expf(bsum);
  __syncthreads();
}

constexpr int GL_Q = 0, GL_K = 17408, GL_KT = 34816, GL_BUF = 53248, GL_RED = 2 * GL_BUF;

template <int PASS>
DEVI void gla_scan_item(int item, const bf16_t* Hg, const bf16_t* vT, const bf16_t* kT, const float* decay,
                        float* Ubuf, float* Dseg, bf16_t* AO, const float* normg, int wv) {
  const int tid = otid(wv), w = tid >> 6, lane = tid & 63, r = lane & 31, h = lane >> 5;
  const int bh = item >> 4, seg = item & 15, b = bh >> 2, hd = bh & 3;
  unsigned char* lds = g_lds;
  const bf16_t* hq = Hg + ((size_t)b * 8192 + seg * 512 + (tid >> 4)) * 2048 + hd * 128 + (tid & 15) * 8;
  const bf16_t* kts = kT + (size_t)(b * 512 + hd * 128 + (tid >> 3)) * 8192 + seg * 512 + (tid & 7) * 8;
  u32x4 rq0, rq1, rk0, rk1, rt0, rt1;
#define GL_GLOAD(cc) do { \
    if (PASS == 1) { const bf16_t* _p = hq + (size_t)(cc) * 64 * 2048; rq0 = *(const u32x4*)_p; rq1 = *(const u32x4*)(_p + 32 * 2048); \
                     rk0 = *(const u32x4*)(_p + 512); rk1 = *(const u32x4*)(_p + 32 * 2048 + 512); } \
    rt0 = *(const u32x4*)(kts + (cc) * 64); rt1 = *(const u32x4*)(kts + (size_t)64 * 8192 + (cc) * 64); } while (0)
#define GL_LSTORE(bufp) do { \
    if (PASS == 1) { unsigned char* _q = (bufp) + GL_Q + (tid >> 4) * 272 + (tid & 15) * 16; *(u32x4*)_q = rq0; *(u32x4*)(_q + 32 * 272) = rq1; \
                     *(u32x4*)(_q + GL_K) = rk0; *(u32x4*)(_q + GL_K + 32 * 272) = rk1; } \
    unsigned char* _t = (bufp) + GL_KT + (tid >> 3) * 144 + (tid & 7) * 16; *(u32x4*)_t = rt0; *(u32x4*)(_t + 64 * 144) = rt1; } while (0)
  GL_GLOAD(0);
  f32x16 S[4] = {};
  if (PASS == 1) {
#pragma unroll 1
    for (int js = 0; js < seg; ++js) {
      const int it2 = bh * 16 + js;
      const float* up = Ubuf + ((size_t)(it2 * 8 + w) * 4) * 1024 + lane;
      const float* dp = Dseg + it2 * 128 + 4 * h;
#pragma unroll
      for (int dkt = 0; dkt < 4; ++dkt)
#pragma unroll
        for (int g = 0; g < 4; ++g) {
          const f32x4 d4 = *(const f32x4*)(dp + 32 * dkt + 8 * g);
#pragma unroll
          for (int i = 0; i < 4; ++i) S[dkt][4 * g + i] = S[dkt][4 * g + i] * d4[i] + up[(dkt * 16 + 4 * g + i) * 64];
        }
    }
  }
  GL_LSTORE(lds);
  __syncthreads();
  const bf16_t* vrow = vT + (size_t)(b * 1024 + hd * 256 + 32 * w + r) * 8192;
#pragma unroll 1
  for (int cc = 0; cc < 8; ++cc) {
    const int ch = seg * 8 + cc, tc0 = ch * 64;
    const size_t tokabs0 = (size_t)b * 8192 + tc0;
    const unsigned char* buf = lds + (cc & 1) * GL_BUF;
    if (cc + 1 < 8) GL_GLOAD(cc + 1);
    bf16x8 vnat[4];
#pragma unroll
    for (int ks = 0; ks < 4; ++ks) vnat[ks] = *(const bf16x8*)(vrow + tc0 + 16 * ks + 8 * h);
    f32x16 o0 = {}, o1 = {};
    if (PASS == 1) {
      f32x16 X00 = {}, X01 = {}, X11 = {};
      { const unsigned char* qL = buf + GL_Q + r * 272 + h * 16; const unsigned char* kL = buf + GL_K + r * 272 + h * 16;
#pragma unroll
        for (int ks = 0; ks < 8; ++ks) {
          const bf16x8 k0 = *(const bf16x8*)(kL + ks * 32), k1 = *(const bf16x8*)(kL + 32 * 272 + ks * 32);
          const bf16x8 q0 = *(const bf16x8*)(qL + ks * 32), q1 = *(const bf16x8*)(qL + 32 * 272 + ks * 32);
          X00 = mfma32(k0, q0, X00); X01 = mfma32(k0, q1, X01); X11 = mfma32(k1, q1, X11);
        } }
      u32x2 vpa[4], vpb[4];
      { const bf16_t* vp = vrow + tc0 + 4 * h;
#pragma unroll
        for (int q = 0; q < 4; ++q) { vpa[q] = *(const u32x2*)(vp + 16 * q); vpb[q] = *(const u32x2*)(vp + 16 * q + 8); } }
#pragma unroll
      for (int rg = 0; rg < 16; ++rg) { const int j = (rg & 3) + 8 * (rg >> 2) + 4 * h; if (r < j) { X00[rg] = 0.f; X11[rg] = 0.f; } }
      { const unsigned char* qP = buf + GL_Q + r * 272 + 8 * h;
#pragma unroll
        for (int dkt = 0; dkt < 4; ++dkt)
#pragma unroll
          for (int sx = 0; sx < 2; ++sx) {
            const bf16x8 sa = pack8(S[dkt], sx);
            const unsigned char* qq = qP + (32 * dkt + 16 * sx) * 2;
            const u32x2 a0 = *(const u32x2*)qq, a1 = *(const u32x2*)(qq + 16);
            const u32x2 c0 = *(const u32x2*)(qq + 32 * 272), c1 = *(const u32x2*)(qq + 32 * 272 + 16);
            o0 = mfma32(sa, mk8(a0[0], a0[1], a1[0], a1[1]), o0);
            o1 = mfma32(sa, mk8(c0[0], c0[1], c1[0], c1[1]), o1);
          } }
#pragma unroll
      for (int sx = 0; sx < 2; ++sx) {
        const bf16x8 v0 = mk8(vpa[sx][0], vpa[sx][1], vpb[sx][0], vpb[sx][1]), v1 = mk8(vpa[2 + sx][0], vpa[2 + sx][1], vpb[2 + sx][0], vpb[2 + sx][1]);
        o0 = mfma32(v0, pack8(X00, sx), o0);
        o1 = mfma32(v0, pack8(X01, sx), o1);
        o1 = mfma32(v1, pack8(X11, sx), o1);
      }
      float ss0 = 0.f, ss1 = 0.f;
#pragma unroll
      for (int rg = 0; rg < 16; ++rg) { ss0 += o0[rg] * o0[rg]; ss1 += o1[rg] * o1[rg]; }
      ss0 = hsum(ss0); ss1 = hsum(ss1);
      float* red = (float*)(lds + GL_RED) + (cc & 1) * 512;
      if (h == 0) { red[w * 64 + r] = ss0; red[w * 64 + 32 + r] = ss1; }
    }
    { const unsigned char* ktL = buf + GL_KT + r * 144 + h * 16;
#pragma unroll
      for (int ks = 0; ks < 4; ++ks)
#pragma unroll
        for (int dkt = 0; dkt < 4; ++dkt) S[dkt] = mfma32(*(const bf16x8*)(ktL + dkt * 32 * 144 + ks * 32), vnat[ks], S[dkt]); }
    { const float* dcp = decay + (size_t)(b * 128 + ch) * 512 + hd * 128 + 4 * h;
#pragma unroll
      for (int dkt = 0; dkt < 4; ++dkt)
#pragma unroll
        for (int g = 0; g < 4; ++g) {
          const f32x4 d4 = *(const f32x4*)(dcp + 32 * dkt + 8 * g);
#pragma unroll
          for (int i = 0; i < 4; ++i) S[dkt][4 * g + i] *= d4[i];
        } }
    if (cc + 1 < 8) GL_LSTORE(lds + ((cc + 1) & 1) * GL_BUF);
    __syncthreads();
    if (PASS == 1) {
      const float* red = (const float*)(lds + GL_RED) + (cc & 1) * 512;
      float t0 = 0.f, t1 = 0.f;
#pragma unroll
      for (int ww = 0; ww < 8; ++ww) { t0 += red[ww * 64 + r]; t1 += red[ww * 64 + 32 + r]; }
      const float ri0 = rsqrtf(t0 * (1.f / 256.f) + 1e-5f), ri1 = rsqrtf(t1 * (1.f / 256.f) + 1e-5f);
      u32x2 r4s[2][4]; f32x4 gns[4];
#pragma unroll
      for (int g = 0; g < 4; ++g) {
        gns[g] = *(const f32x4*)(normg + 32 * w + 8 * g + 4 * h);
#pragma unroll
        for (int it = 0; it < 2; ++it) r4s[it][g] = *(const u32x2*)(Hg + (tokabs0 + 32 * it + r) * 2048 + 1024 + hd * 256 + 32 * w + 8 * g + 4 * h);
      }
#pragma unroll
      for (int it = 0; it < 2; ++it) {
        const size_t tok = tokabs0 + 32 * it + r;
        u32x2 pk4[4];
#pragma unroll
        for (int g = 0; g < 4; ++g) {
          const u32x2 r4 = r4s[it][g];
          const f32x4 gn = gns[g];
          const float rv[4] = {bflo(r4[0]), bfhi(r4[0]), bflo(r4[1]), bfhi(r4[1])};
          float ov[4];
#pragma unroll
          for (int i = 0; i < 4; ++i) {
            const float oo = it ? o1[4 * g + i] : o0[4 * g + i];
            const float sg = rv[i] / (1.f + __expf(-rv[i]));
            ov[i] = oo * (it ? ri1 : ri0) * gn[i] * sg;
          }
          pk4[g] = (u32x2){pk_bf16(ov[0], ov[1]), pk_bf16(ov[2], ov[3])};
        }
#pragma unroll
        for (int gp = 0; gp < 2; ++gp)
          *(u32x4*)(AO + tok * 1024 + hd * 256 + 32 * w + 8 * (2 * gp + h)) = widen_pair(pk4[2 * gp], pk4[2 * gp + 1], h);
      }
    }
  }
#undef GL_GLOAD
#undef GL_LSTORE
  if (PASS == 0) {
    float* up = Ubuf + ((size_t)(item * 8 + w) * 4) * 1024 + lane;
#pragma unroll
    for (int dkt = 0; dkt < 4; ++dkt)
#pragma unroll
      for (int rg = 0; rg < 16; ++rg) up[(dkt * 16 + rg) * 64] = S[dkt][rg];
    if (tid < 128) {
      float dv8[8];
#pragma unroll
      for (int cc = 0; cc < 8; ++cc) dv8[cc] = decay[(size_t)(b * 128 + seg * 8 + cc) * 512 + hd * 128 + tid];
      float d = 1.f;
#pragma unroll
      for (int cc = 0; cc < 8; ++cc) d *= dv8[cc];
      Dseg[item * 128 + tid] = d;
    }
  }
  __syncthreads();
}

#define XB_TMO      128
#define XB_XCNT(j)  (256  + 64 * (j))
#define XB_XSUB(j)  (1280 + 64 * (j))
#define XB_XGEN(j)  (2304 + 64 * (j))
#define XB_TOP      3328
#define XB_TOPGEN   3392
#define XCD_BAR_WORDS 3456
#define XB_SPIN_CAP (1u << 20)
DEVI unsigned xb_ld(unsigned* p)              { return __hip_atomic_load(p, __ATOMIC_RELAXED, __HIP_MEMORY_SCOPE_AGENT); }
DEVI unsigned xb_add(unsigned* p, unsigned v) { return __hip_atomic_fetch_add(p, v, __ATOMIC_RELAXED, __HIP_MEMORY_SCOPE_AGENT); }
DEVI unsigned xb_xcc_id() { return (unsigned)__builtin_amdgcn_s_getreg((3 << 11) | 20) & 0xFu; }
#define XB_SPIN(cond, bar) do { unsigned _sp = 0; while (cond) { __builtin_amdgcn_s_sleep(1); \
    if ((++_sp & 255u) == 0u) { if (xb_ld(&(bar)[XB_TMO])) break; if (_sp > XB_SPIN_CAP) { atomicAdd(&(bar)[XB_TMO], 1u); break; } } } } while (0)
struct XcdBarrier { unsigned* bar; unsigned x; volatile LAS unsigned* st; };
DEVI void xcd_barrier_complete(unsigned* bar, unsigned x, unsigned& nloc, unsigned& nx) {
  const unsigned G = gridDim.x * gridDim.y * gridDim.z;
  unsigned sum, cnt, mine, sp = 0u;
  for (;;) {
    sum = 0u; cnt = 0u; mine = 0u;
#pragma unroll
    for (unsigned j = 0; j < 16; ++j) { const unsigned c = xb_ld(&bar[XB_XCNT(j)]); sum += c; cnt += (c > 0u) ? 1u : 0u; mine = (j == x) ? c : mine; }
    if (sum == G) break;
    __builtin_amdgcn_s_sleep(1);
    if ((++sp & 255u) == 0u) { if (xb_ld(&bar[XB_TMO])) break; if (sp > XB_SPIN_CAP) { atomicAdd(&bar[XB_TMO], 1u); break; } }
  }
  nloc = mine > 0u ? mine : 1u; nx = cnt > 0u ? cnt : 1u;
}
DEVI void xcd_barrier(const XcdBarrier& b, bool leader) {
  asm volatile("s_waitcnt vmcnt(0)" ::: "memory");
  __syncthreads();
  if (leader) {
    unsigned* bar = b.bar;
    __builtin_amdgcn_s_waitcnt(0);
    unsigned bx = xb_xcc_id(); asm volatile("" : "+s"(bx));
    unsigned nloc = b.st[0], nx = b.st[1];
    if (nloc == 0u) { xcd_barrier_complete(bar, bx, nloc, nx); b.st[0] = nloc; b.st[1] = nx; }
    const unsigned old = xb_add(&bar[XB_XSUB(bx)], 1u);
    const unsigned gen = old / nloc;
    if (old + 1u == (gen + 1u) * nloc) {
      __builtin_amdgcn_fence(__ATOMIC_RELEASE, "agent");
      asm volatile("s_waitcnt vmcnt(0)" ::: "memory");
      const unsigned og = xb_add(&bar[XB_TOP], 1u);
      const unsigned tg = og / nx;
      if (og + 1u == (tg + 1u) * nx) xb_add(&bar[XB_TOPGEN], 1u);
      else XB_SPIN(xb_ld(&bar[XB_TOPGEN]) == tg, bar);
      __builtin_amdgcn_fence(__ATOMIC_ACQUIRE, "agent");
      xb_add(&bar[XB_XGEN(bx)], 1u);
      asm volatile("s_waitcnt vmcnt(0)" ::: "memory");
    } else {
      XB_SPIN(xb_ld(&bar[XB_XGEN(bx)]) == gen, bar);
      __builtin_amdgcn_fence(__ATOMIC_ACQUIRE, "agent");
      asm volatile("s_waitcnt vmcnt(0)" ::: "memory");
    }
  }
  __syncthreads();
}

#define GSYNC() xcd_barrier(xb, otid(wv) == 0)
__global__ void __launch_bounds__(512, 2) mega_fwd(Params p) {
  cg::grid_group grid = cg::this_grid();
  const int wv = __builtin_amdgcn_readfirstlane((int)threadIdx.x >> 6);
  unsigned char* ws = p.ws;
  XcdBarrier xb; xb.bar = (unsigned*)(ws + WS_BAR); xb.x = xb_xcc_id(); xb.st = (volatile LAS unsigned*)((LAS unsigned char*)g_lds + 131072);
  if (threadIdx.x == 0) { xb.st[0] = 0u; xb.st[1] = 0u; (void)xb_add(&xb.bar[XB_XCNT(xb.x)], 1u); }
  grid.sync();
  bf16_t* XB = (bf16_t*)(ws + WS_XB);
  bf16_t* AO = (bf16_t*)(ws + WS_AO);
  unsigned char* OV = ws + WS_OV;

#ifndef PM
#define PM 0xff
#endif
#ifndef DUP
#define DUP 0
#endif
  if (PM & 1) prologue(p, (char*)g_lds, wv);
  GSYNC();
#if (DUP & 32)
  prologue(p, (char*)g_lds, wv);
  GSYNC();
#endif

  { const int gtid = blockIdx.x * 512 + otid(wv);
    for (int i = gtid; i < 4 * 14336; i += gridDim.x * 512) {
      const int l = i / 14336, c = i % 14336;
      if (c < 6144 && !(l & 1)) continue;
      const float* pp = (const float*)(ws + WS_UVP) + (size_t)l * 16 * 16384 + c;
      float acc = 0.f;
#pragma unroll
      for (int kt = 0; kt < 16; ++kt) acc += pp[(size_t)kt * 16384];
      ((float*)(ws + WS_UV))[(size_t)l * 16384 + c] = acc;
    } }
#pragma unroll 1
  for (int l = 0; l < 4; ++l) {
    const bf16_t* wl = (const bf16_t*)(ws + WS_WT + (size_t)l * WT_LAYER);
    const int e = l >> 1;
    const bool odd = (l & 1) != 0;
    bf16_t* Hg = (bf16_t*)(OV + OV_HG); bf16_t* vT = (bf16_t*)(OV + OV_VT); bf16_t* kT = (bf16_t*)(OV + OV_KT);
    float* Ubuf = (float*)(OV + OV_U); float* decay = (float*)(ws + WS_DEC); float* Dseg = (float*)(ws + WS_DSEG);
#pragma unroll 1
    for (int st = 0; st < 9; ++st) {
      if (!odd && (st == 2 || st == 3)) continue;
      if (st == 5 || (st == 8 && l != 3)) {
        stat_finalize((const float*)(ws + WS_STATS) + (st == 8 ? 1048576 : 0), (float*)(ws + WS_MR) + (st == 8 ? 65536 : 0), wv);
        GSYNC();
        continue;
      }
      if (st == 0 || st == 4 || st == 6 || st == 7) {
        EpiArgs ea{};
        const bf16_t* A; const bf16_t* Bt; int N, K;
        const float* uv = (const float*)(ws + WS_UV) + (size_t)l * 16384;
        float* stats = (float*)(ws + WS_STATS);
        const float* mrb = (const float*)(ws + WS_MR);
        if (st == 0) {
          A = XB; Bt = wl; N = 3072; K = 1024;
          if (odd) { ea.stat_in = mrb + 65536; ea.u = uv + UV_U_IN; ea.v = uv + UV_V_IN; }
          else if (l > 0) { ln_bf16_phase(XB, AO, p.in[14] + (l - 1) * 1024, p.in[15] + (l - 1) * 1024, wv); GSYNC(); A = AO; }
          if (odd) { ea.kind = EPI_GLA; ea.H = Hg; ea.vt0 = vT; }
          else { ea.kind = EPI_EVEN; ea.H = (bf16_t*)(OV + OV_H); ea.vt0 = (bf16_t*)(OV + OV_DVT); ea.vt1 = (bf16_t*)(OV + OV_MVT); ea.kmsum = (float*)(ws + WS_KM) + (size_t)e * 65536; }
        } else if (st == 4) {
          A = AO; Bt = wl + 3 * 1024 * 1024; N = 1024; K = 1024; ea.kind = EPI_RES; ea.Y = XB; ea.X = p.X;
          if (l > 0) { ea.stat_prev = mrb + 65536; ea.gprev = p.in[14] + (l - 1) * 1024; ea.bprev = p.in[15] + (l - 1) * 1024; }
          ea.stat_new = stats;
        } else if (st == 6) {
          A = XB; Bt = wl + 4 * 1024 * 1024; N = 4096; K = 1024; ea.kind = EPI_FFN1; ea.Hff = (bf16_t*)OV;
          ea.stat_in = mrb; ea.u = uv + UV_U_F1; ea.v = uv + UV_V_F1;
        } else {
          A = (const bf16_t*)OV; Bt = wl + 8 * 1024 * 1024; N = 1024; K = 4096; ea.kind = EPI_RES; ea.Y = XB; ea.X = p.X;
          ea.stat_prev = mrb; ea.gprev = p.in[10] + l * 1024; ea.bprev = p.in[11] + l * 1024;
          ea.stat_new = stats + 1048576; ea.final_out = (l == 3);
        }
        if (PM & 2) gemm_phase(A, Bt, N, K, ea, wv);
#if (DUP & 2)
        if (st == 6) { GSYNC(); gemm_phase(A, Bt, N, K, ea, wv); }
#endif
      } else if (st == 1) {
        if (odd) {
#pragma unroll 1
          for (int it = blockIdx.x; it < 512; it += gridDim.x)
            if (PM & 8) gla_prep_item(it, XB, (const bf16_t*)(ws + WS_WGD) + (size_t)e * 16384, p.in[6] + e * 8192, p.in[7] + e * 512, Hg, kT, decay,
                                      (const float*)(ws + WS_MR) + 65536, (const float*)(ws + WS_UV) + (size_t)l * 16384 + UV_U_GD, (const float*)(ws + WS_UV) + (size_t)l * 16384 + UV_V_GD, wv);
        } else {
          if (PM & 4) attn_phase(p, e, wv);
#if (DUP & 1)
          GSYNC(); attn_phase(p, e, wv);
#endif
        }
      } else if (st == 2) {
#pragma unroll 1
        for (int it = blockIdx.x; it < 256; it += gridDim.x) if (PM & 16) gla_scan_item<0>(it, Hg, vT, kT, decay, Ubuf, Dseg, AO, p.in[8] + e * 256, wv);
#if (DUP & 4)
        GSYNC();
        for (int it = blockIdx.x; it < 256; it += gridDim.x) gla_scan_item<0>(it, Hg, vT, kT, decay, Ubuf, Dseg, AO, p.in[8] + e * 256, wv);
#endif
      } else if (st == 3) {
#pragma unroll 1
        for (int it = blockIdx.x; it < 256; it += gridDim.x) if (PM & 32) gla_scan_item<1>(it, Hg, vT, kT, decay, Ubuf, Dseg, AO, p.in[8] + e * 256, wv);
#if (DUP & 8)
        GSYNC();
        for (int it = blockIdx.x; it < 256; it += gridDim.x) gla_scan_item<1>(it, Hg, vT, kT, decay, Ubuf, Dseg, AO, p.in[8] + e * 256, wv);
#endif
      } else {
        if (PM & 64) ln_phase(p.X, XB, p.in[14] + l * 1024, p.in[15] + l * 1024, true, wv);
      }
      GSYNC();
#if (DUP & 16)
      GSYNC();
#endif
    }
  }
}

extern "C" void kernel_launch(void* const* d_in, const int* in_sizes, int n_in, void* d_out, int out_size, void* d_ws, size_t ws_size,
                              hipStream_t stream) {
  constexpr int LDS_BYTES = 131072 + 64;
  static int grid = 0;
  if (grid == 0) {
    if (n_in != 16 || out_size != NTOK * DM || ws_size < WS_END) {
      fprintf(stderr, "kernel_launch: unexpected shapes (n_in %d out %d ws %zu need %zu)\n", n_in, out_size, ws_size, (size_t)WS_END);
      grid = -1; return;
    }
    int dev = 0, cus = 0, per_cu = 0;
    hipGetDevice(&dev);
    hipDeviceGetAttribute(&cus, hipDeviceAttributeMultiprocessorCount, dev);
    hipFuncSetAttribute((const void*)mega_fwd, hipFuncAttributeMaxDynamicSharedMemorySize, LDS_BYTES);
    hipOccupancyMaxActiveBlocksPerMultiprocessor(&per_cu, (const void*)mega_fwd, 512, LDS_BYTES);
    if (per_cu < 1) per_cu = 1;
    grid = cus * per_cu;
    if (grid > 256) grid = 256;
    (void)hipGetLastError();
  }
  if (grid < 0) return;
  if (hipMemsetAsync((char*)d_ws + WS_BAR, 0, 16384, stream) != hipSuccess) { fprintf(stderr, "kernel_launch: memset of barrier words failed\n"); return; }
  Params p{};
  for (int i = 0; i < 16; ++i) p.in[i] = (const float*)d_in[i];
  p.X = (float*)d_out;
  p.ws = (unsigned char*)d_ws;
  void* args[] = {&p};
  hipError_t err = hipLaunchCooperativeKernel((const void*)mega_fwd, dim3(grid), dim3(512), args, LDS_BYTES, stream);
  if (err != hipSuccess) fprintf(stderr, "cooperative launch failed: %s (grid %d)\n", hipGetErrorString(err), grid);
}
```

```cpp
#include <hip/hip_runtime.h>
#include <hip/hip_cooperative_groups.h>
#include <cstdio>
#include <cstdint>
namespace cg = cooperative_groups;

typedef unsigned short bf16_t;
typedef short bf16x8 __attribute__((ext_vector_type(8)));
typedef float f32x4 __attribute__((ext_vector_type(4)));
typedef float f32x16 __attribute__((ext_vector_type(16)));
typedef unsigned u32x2 __attribute__((ext_vector_type(2)));
typedef unsigned u32x4 __attribute__((ext_vector_type(4)));

#define DEVI __device__ __forceinline__
#define NEG_INF (-__builtin_inff())

constexpr int SEQ = 8192, NTOK = 32768, DM = 1024;
constexpr float DN_ALPHA = 1.681792830507429f;

constexpr size_t MiB = 1024ull * 1024ull;
constexpr size_t WS_WT    = 4096;
constexpr size_t WT_LAYER = 24 * MiB;
constexpr size_t WS_WGD   = WS_WT + 4 * WT_LAYER;
constexpr size_t WS_XB    = WS_WGD + 65536;
constexpr size_t WS_AO    = WS_XB + 64 * MiB;
constexpr size_t WS_OV    = WS_AO + 64 * MiB;
constexpr size_t WS_KM    = WS_OV + 256 * MiB;
constexpr size_t WS_DEC   = WS_KM + 524288;
constexpr size_t WS_DSEG  = WS_DEC + 1 * MiB;
constexpr size_t WS_BAR   = WS_DSEG + 131072;
constexpr size_t WS_STATS = WS_BAR + 16384;
constexpr size_t WS_MR    = WS_STATS + 8 * MiB;
constexpr size_t WS_UV    = WS_MR + 524288;
constexpr size_t WS_UVP   = WS_UV + 262144;
constexpr size_t WS_END   = WS_UVP + 4 * MiB;
constexpr int UV_U_IN = 0, UV_V_IN = 3072, UV_U_F1 = 6144, UV_V_F1 = 10240, UV_U_GD = 14336, UV_V_GD = 14352;
constexpr size_t OV_H   = 0;
constexpr size_t OV_DVT = 192 * MiB;
constexpr size_t OV_MVT = 224 * MiB;
constexpr size_t OV_HG  = 0;
constexpr size_t OV_VT  = 128 * MiB;
constexpr size_t OV_KT  = 192 * MiB;
constexpr size_t OV_U   = 224 * MiB;

struct Params {
  const float* in[16];
  float* X;
  unsigned char* ws;
};

typedef __bf16 bf16x2_t __attribute__((ext_vector_type(2)));
DEVI unsigned pk_bf16(float lo, float hi) { bf16x2_t v = {(__bf16)lo, (__bf16)hi}; return __builtin_bit_cast(unsigned, v); }
DEVI bf16_t f2bf(float f) { return (bf16_t)(pk_bf16(f, 0.f) & 0xffffu); }
DEVI float bf2f(bf16_t v) { return __uint_as_float(((unsigned)v) << 16); }
DEVI float bflo(unsigned u) { return __uint_as_float(u << 16); }
DEVI float bfhi(unsigned u) { return __uint_as_float(u & 0xffff0000u); }
DEVI bf16x8 mk8(unsigned a, unsigned b, unsigned c, unsigned d) { u32x4 v = {a, b, c, d}; return __builtin_bit_cast(bf16x8, v); }
DEVI bf16x8 pack8(const f32x16& x, int s) {
  return s == 0 ? mk8(pk_bf16(x[0], x[1]), pk_bf16(x[2], x[3]), pk_bf16(x[4], x[5]), pk_bf16(x[6], x[7]))
                : mk8(pk_bf16(x[8], x[9]), pk_bf16(x[10], x[11]), pk_bf16(x[12], x[13]), pk_bf16(x[14], x[15]));
}
DEVI f32x16 mfma32(bf16x8 a, bf16x8 b, f32x16 c) { return __builtin_amdgcn_mfma_f32_32x32x16_bf16(a, b, c, 0, 0, 0); }
DEVI f32x4 mfma16(bf16x8 a, bf16x8 b, f32x4 c) { return __builtin_amdgcn_mfma_f32_16x16x32_bf16(a, b, c, 0, 0, 0); }
DEVI float ex2(float x) { return __builtin_amdgcn_exp2f(x); }

template <int X> DEVI float swz_xor(float v) { return __int_as_float(__builtin_amdgcn_ds_swizzle(__float_as_int(v), (X << 10) | 0x1f)); }
DEVI void halves(float v, float& lo, float& hi) {
  auto r = __builtin_amdgcn_permlane32_swap(__float_as_uint(v), __float_as_uint(v), false, false);
  lo = __uint_as_float(r[0]); hi = __uint_as_float(r[1]);
}
DEVI void halves_i(int v, int& lo, int& hi) {
  auto r = __builtin_amdgcn_permlane32_swap((unsigned)v, (unsigned)v, false, false);
  lo = (int)r[0]; hi = (int)r[1];
}
DEVI float hsum(float v) { float a, b; halves(v, a, b); return a + b; }
DEVI float hmax(float v) { float a, b; halves(v, a, b); return fmaxf(a, b); }
DEVI float sum16(float v) { v += swz_xor<1>(v); v += swz_xor<2>(v); v += swz_xor<4>(v); v += swz_xor<8>(v); return v; }
DEVI float sum64(float v) { v = sum16(v); v += swz_xor<16>(v); return hsum(v); }

DEVI u32x4 widen_pair(u32x2 a0, u32x2 a1, int h) {
  const unsigned sx = h ? a0[0] : a1[0], sy = h ? a0[1] : a1[1];
  const auto rx = __builtin_amdgcn_permlane32_swap(sx, sx, false, false);
  const auto ry = __builtin_amdgcn_permlane32_swap(sy, sy, false, false);
  const unsigned px = h ? rx[0] : rx[1], py = h ? ry[0] : ry[1];
  return h ? (u32x4){px, py, a1[0], a1[1]} : (u32x4){a0[0], a0[1], px, py};
}

DEVI u32x4 widen_pair16(u32x2 a0, u32x2 a1, int e) {
  const int sx = (int)(e ? a0[0] : a1[0]), sy = (int)(e ? a0[1] : a1[1]);
  const unsigned px = (unsigned)__builtin_amdgcn_ds_swizzle(sx, (16 << 10) | 0x1f), py = (unsigned)__builtin_amdgcn_ds_swizzle(sy, (16 << 10) | 0x1f);
  return e ? (u32x4){px, py, a1[0], a1[1]} : (u32x4){a0[0], a0[1], px, py};
}
DEVI int otid(int wv) { int t = wv * 64 + (int)__builtin_amdgcn_mbcnt_hi(~0u, __builtin_amdgcn_mbcnt_lo(~0u, 0u)); asm volatile("" : "+v"(t)); return t; }

constexpr double cexp_pos(double x) { double s = 1.0, t = 1.0; for (int i = 1; i < 100; ++i) { t *= x / i; s += t; } return s; }
constexpr float rope_inv(int p, int dim) { return (float)(1.0 / cexp_pos((2.0 * p / dim) * 9.210340371976184)); }
struct RopeTab { float d[32]; float m[64]; };
constexpr RopeTab make_rope_tab() { RopeTab t{}; for (int p = 0; p < 32; ++p) t.d[p] = rope_inv(p, 64); for (int p = 0; p < 64; ++p) t.m[p] = rope_inv(p, 128); return t; }
__device__ const RopeTab g_rope = make_rope_tab();

DEVI void sincos_f(float a, float& s, float& c) {
  float n = rintf(a * 0.636619772367581343f);
  float r = fmaf(-n, 1.5703125f, a);
  r = fmaf(-n, 4.837512969970703125e-4f, r);
  r = fmaf(-n, 7.54978995489188216e-8f, r);
  float r2 = r * r;
  float sp = r + r * r2 * (-1.66666667e-1f + r2 * (8.33333333e-3f + r2 * (-1.98412698e-4f + r2 * 2.75573192e-6f)));
  float cp = 1.f + r2 * (-0.5f + r2 * (4.16666667e-2f + r2 * (-1.38888889e-3f + r2 * (2.48015873e-5f + r2 * (-2.75573192e-7f)))));
  int q = ((int)n) & 3;
  float ss = (q & 1) ? cp : sp, cc = (q & 1) ? sp : cp;
  s = (q & 2) ? -ss : ss;
  c = ((q + 1) & 2) ? -cc : cc;
}

DEVI int perm_even(int c) {
  const int sec = c >> 9, cl = c & 511;
  if (sec == 0 || sec == 1) { const int mm = cl >> 6, j = cl & 63, second = j >> 5, p = j & 31; return sec * 512 + mm * 64 + (p >> 4) * 32 + second * 16 + (p & 15); }
  if (sec == 3 || sec == 4) { const int hh = cl >> 7, j = cl & 127, second = j >> 6, p = j & 63; return sec * 512 + hh * 128 + (p >> 4) * 32 + second * 16 + (p & 15); }
  return c;
}

DEVI int perm32_row(int c) {
  const int x = c & 31; return (c & ~31) + ((x >> 2) & 1) * 16 + (x >> 3) * 4 + (x & 3);
}
struct WJob { const float* W; int ldw; bf16_t* Wt; int K, k0, c0, perm; const float* gvec; const float* bvec; float* uvec; float* vvec; };
DEVI void wjob_load(const WJob& j, int t, f32x4& a, f32x4& b) {
  const float* src = j.W + (size_t)(j.k0 + (t >> 3)) * j.ldw + j.c0 + (t & 7) * 8;
  a = *(const f32x4*)src; b = *(const f32x4*)(src + 4);
}
DEVI void wtrans_tile(const WJob& jw, f32x4 a, f32x4 b, char* lds, int t) {
  bf16_t* Wt = jw.Wt; const int K = jw.K, k0 = jw.k0, c0 = jw.c0, perm = jw.perm;
  const float* gvec = jw.gvec; const float* bvec = jw.bvec; float* uvec = jw.uvec; float* vvec = jw.vvec;
  bf16_t* tl = (bf16_t*)lds;
  float* suw = (float*)(lds + 9216);
  const bool fold = gvec != nullptr;
  { const int kr = t >> 3, cc = (t & 7) * 8;
    if (fold) {
      const float gk = gvec[k0 + kr], bk = bvec[k0 + kr];
      float ua[8], va[8];
#pragma unroll
      for (int i = 0; i < 4; ++i) {
        const bf16_t ra = f2bf(a[i] * gk), rb = f2bf(b[i] * gk);
        tl[(cc + i) * 66 + kr] = ra; tl[(cc + 4 + i) * 66 + kr] = rb;
        ua[i] = bf2f(ra); ua[4 + i] = bf2f(rb); va[i] = a[i] * bk; va[4 + i] = b[i] * bk;
      }
#pragma unroll
      for (int i = 0; i < 8; ++i) {
        float x = ua[i], y = va[i];
        x += swz_xor<8>(x); y += swz_xor<8>(y);
        x += swz_xor<16>(x); y += swz_xor<16>(y);
        x = hsum(x); y = hsum(y);
        if ((t & 63) < 8) { suw[(t >> 6) * 128 + cc + i] = x; suw[(t >> 6) * 128 + 64 + cc + i] = y; }
      }
    } else {
#pragma unroll
      for (int i = 0; i < 4; ++i) { tl[(cc + i) * 66 + kr] = f2bf(a[i]); tl[(cc + 4 + i) * 66 + kr] = f2bf(b[i]); }
    } }
  __syncthreads();
  { const int c = t >> 3, kc = (t & 7) * 8;
    const unsigned* rp = (const unsigned*)(tl + c * 66 + kc);
    const u32x4 v = {rp[0], rp[1], rp[2], rp[3]};
    const int g = perm == 1 ? perm_even(c0 + c) : (perm == 2 || (perm == 3 && ((c0 + c) < 1024 || (c0 + c) >= 2048)) ? perm32_row(c0 + c) : (c0 + c));
    *(u32x4*)(Wt + (size_t)g * K + k0 + kc) = v; }
  if (fold && t < 128) {
    float acc = 0.f;
#pragma unroll
    for (int w8 = 0; w8 < 8; ++w8) acc += suw[w8 * 128 + t];
    const int c = t & 63;
    const int g = perm == 1 ? perm_even(c0 + c) : (perm == 2 || (perm == 3 && ((c0 + c) < 1024 || (c0 + c) >= 2048)) ? perm32_row(c0 + c) : (c0 + c));
    ((t < 64 ? uvec : vvec) + (size_t)(k0 >> 6) * 16384)[g] = acc;
  }
  __syncthreads();
}

DEVI void prologue(const Params& p, char* lds, int wv) {
  const int G = gridDim.x;
  unsigned char* ws = p.ws;
  auto decode = [&](int jb, WJob& j) {
    const int l = jb / 3072; int rem = jb % 3072;
    bf16_t* wl = (bf16_t*)(ws + WS_WT + (size_t)l * WT_LAYER);
    float* uv = (float*)(ws + WS_UVP) + (size_t)l * 16 * 16384;
    j.gvec = nullptr; j.bvec = nullptr; j.uvec = nullptr; j.vvec = nullptr;
    if (rem < 768) {
      const int kt = rem / 48, ct = rem % 48;
      j.K = 1024; j.k0 = kt * 64; j.c0 = ct * 64; j.Wt = wl;
      if (l & 1) { j.W = p.in[5] + (size_t)(l >> 1) * 1024 * 3088; j.ldw = 3088; j.perm = 3; j.gvec = p.in[14] + (l - 1) * 1024; j.bvec = p.in[15] + (l - 1) * 1024; j.uvec = uv + UV_U_IN; j.vvec = uv + UV_V_IN; }
      else       { j.W = p.in[1] + (size_t)(l >> 1) * 1024 * 3072; j.ldw = 3072; j.perm = 1; }
    } else if (rem < 1024) {
      rem -= 768; const int kt = rem / 16, ct = rem % 16;
      j.W = (l & 1) ? p.in[9] + (size_t)(l >> 1) * 1024 * 1024 : p.in[4] + (size_t)(l >> 1) * 1024 * 1024;
      j.ldw = 1024; j.Wt = wl + 3 * 1024 * 1024; j.K = 1024; j.k0 = kt * 64; j.c0 = ct * 64; j.perm = 2;
    } else if (rem < 2048) {
      rem -= 1024; const int kt = rem / 64, ct = rem % 64;
      j.W = p.in[12] + (size_t)l * 1024 * 4096; j.ldw = 4096; j.Wt = wl + 4 * 1024 * 1024; j.K = 1024; j.k0 = kt * 64; j.c0 = ct * 64; j.perm = 2;
      j.gvec = p.in[10] + l * 1024; j.bvec = p.in[11] + l * 1024; j.uvec = uv + UV_U_F1; j.vvec = uv + UV_V_F1;
    } else {
      rem -= 2048; const int kt = rem / 16, ct = rem % 16;
      j.W = p.in[13] + (size_t)l * 4096 * 1024; j.ldw = 1024; j.Wt = wl + 8 * 1024 * 1024; j.K = 4096; j.k0 = kt * 64; j.c0 = ct * 64; j.perm = 2;
    }
  };
  { const int tw = otid(wv);
    int jb = blockIdx.x;
    WJob cur{}, nxt{}; f32x4 ca = {}, cbv = {}, na = {}, nb = {};
    if (jb < 4 * 3072) { decode(jb, cur); wjob_load(cur, tw, ca, cbv); }
#pragma unroll 1
    while (jb < 4 * 3072) {
      const int jn = jb + G;
      if (jn < 4 * 3072) { decode(jn, nxt); wjob_load(nxt, tw, na, nb); }
      wtrans_tile(cur, ca, cbv, lds, tw);
      cur = nxt; ca = na; cbv = nb; jb = jn;
    } }
  const int gt = blockIdx.x * 512 + otid(wv), GT = G * 512;
  { const int t = otid(wv); const int gw = blockIdx.x * 8 + (t >> 6), lane = t & 63;
    if (gw < 32) {
      const int o = gw >> 4, rr = gw & 15, lsrc = 2 * o;
      const float* gv = p.in[14] + lsrc * 1024; const float* bv = p.in[15] + lsrc * 1024;
      float us = 0.f, vs = 0.f;
      for (int k = lane; k < 1024; k += 64) {
        const float wgt = p.in[5][(size_t)o * 1024 * 3088 + (size_t)k * 3088 + 3072 + rr];
        const bf16_t rb = f2bf(wgt * gv[k]);
        ((bf16_t*)(ws + WS_WGD))[(o * 16 + rr) * 1024 + k] = rb;
        us += bf2f(rb); vs += wgt * bv[k];
      }
      us = sum64(us); vs = sum64(vs);
      if (lane == 0) { float* uv = (float*)(ws + WS_UV) + (size_t)(2 * o + 1) * 16384; uv[UV_U_GD + rr] = us; uv[UV_V_GD + rr] = vs; }
    } }
  for (int i = gt; i < 131072; i += GT) ((float*)(ws + WS_KM))[i] = 0.f;
  for (int i = gt; i < NTOK * DM / 8; i += 4 * GT) {
    f32x4 a[4], b[4];
#pragma unroll
    for (int k = 0; k < 4; ++k) { if (i + k * GT < NTOK * DM / 8) { const size_t e8 = (size_t)(i + k * GT) * 8; a[k] = *(const f32x4*)(p.in[0] + e8); b[k] = *(const f32x4*)(p.in[0] + e8 + 4); } }
#pragma unroll
    for (int k = 0; k < 4; ++k) {
      if (i + k * GT < NTOK * DM / 8) {
        u32x4 v = {pk_bf16(a[k][0], a[k][1]), pk_bf16(a[k][2], a[k][3]), pk_bf16(b[k][0], b[k][1]), pk_bf16(b[k][2], b[k][3])};
        *(u32x4*)((bf16_t*)(ws + WS_XB) + (size_t)(i + k * GT) * 8) = v;
      }
    }
  }
}

#define LAS __attribute__((address_space(3)))
constexpr int BM = 256, BK = 64, HALF = 128, HTB = HALF * BK * 2, NXCD = 8, WGM = 4;
DEVI int lds_byte(int r, int c) { const int st = (r >> 4) * 2 + (c >> 5), rr = r & 15, cc = c & 31, ob = rr * 64 + cc * 2; return st * 1024 + (ob ^ (((ob >> 9) & 1) << 5)); }
DEVI void stage_rc(int b, int& R, int& C) { const int st = b / 1024, sb = b % 1024, swz = sb ^ (((sb >> 9) & 1) << 5); R = (st >> 1) * 16 + swz / 64; C = (st & 1) * 32 + (swz % 64) / 2; }

enum { EPI_EVEN = 0, EPI_GLA = 1, EPI_RES = 2, EPI_FFN1 = 3 };
struct EpiArgs {
  int kind;
  bf16_t* H; bf16_t* vt0; bf16_t* vt1; float* kmsum;
  bf16_t* Hff;
  const float* stat_in; const float* u; const float* v;
  bf16_t* Y; float* X;
  const float* stat_prev; const float* gprev; const float* bprev;
  float* stat_new; int final_out;
};
DEVI void row_sums(const float* raw, int row, float& s1, float& s2) {
  typedef float f32x2 __attribute__((ext_vector_type(2)));
  float a1 = 0.f, a2 = 0.f;
#pragma unroll
  for (int k = 0; k < 16; ++k) { const f32x2 p = *(const f32x2*)(raw + (size_t)k * 65536 + 2 * row); a1 += p[0]; a2 += p[1]; }
  s1 = a1; s2 = a2;
}
DEVI void stat_finalize(const float* raw, float* mr, int wv) {
  for (int row = blockIdx.x * 512 + otid(wv); row < NTOK; row += gridDim.x * 512) {
    float s1, s2; row_sums(raw, row, s1, s2);
    const float mu = s1 * (1.f / 1024.f);
    const float var = fmaxf(s2 * (1.f / 1024.f) - mu * mu, 0.f);
    mr[2 * row] = mu; mr[2 * row + 1] = rsqrtf(var + 1e-5f);
  }
}
DEVI void row_mu_rstd(const float* mr, int row, float& mu, float& rstd) { mu = mr[2 * row]; rstd = mr[2 * row + 1]; }
struct Unit { int brow, bcol, swap; };

DEVI bool unit_next(int i, int nN, int kind, Unit& u) {
  const int nM = NTOK / BM, nwg = nM * nN;
  const long L = (long)i * gridDim.x + blockIdx.x;
  if (L >= nwg) return false;
  int wgid = (int)L;
  { const int q = nwg / NXCD, r = nwg % NXCD, xcd = wgid % NXCD, off = wgid / NXCD; wgid = (xcd < r ? xcd * (q + 1) : r * (q + 1) + (xcd - r) * q) + off; }
  const int nig = WGM * nN, gid = wgid / nig, fm = gid * WGM, gsz = (nM - fm) < WGM ? (nM - fm) : WGM;
  const int pm = fm + ((wgid % nig) % gsz), pn = (wgid % nig) / gsz;
  u.brow = pm * BM; u.bcol = pn * BM;
  const int sec = u.bcol >> 9;
  u.swap = (kind == EPI_EVEN && (sec == 2 || sec == 5)) || (kind == EPI_GLA && (sec == 2 || sec == 3));
  return true;
}

DEVI void acc_init(f32x4 (&acc)[2][2][4][2], const Unit& un, int wr, int wc, int fr, int fq, const EpiArgs& e) {
  if (!e.stat_in) {
#pragma unroll
    for (int a = 0; a < 2; ++a)
#pragma unroll
      for (int b = 0; b < 2; ++b)
#pragma unroll
        for (int m = 0; m < 4; ++m)
#pragma unroll
          for (int n = 0; n < 2; ++n) acc[a][b][m][n] = (f32x4){0.f, 0.f, 0.f, 0.f};
  } else if (!un.swap) {
    float nmu[8];
#pragma unroll
    for (int q = 0; q < 8; ++q) nmu[q] = -e.stat_in[2 * (un.brow + (q >> 2) * 128 + wr * 64 + (q & 3) * 16 + fr)];
#pragma unroll
    for (int bj = 0; bj < 2; ++bj)
#pragma unroll
      for (int n = 0; n < 2; ++n) {
        const f32x4 u4 = *(const f32x4*)(e.u + un.bcol + bj * 128 + wc * 32 + n * 16 + 4 * fq);
#pragma unroll
        for (int q = 0; q < 8; ++q) acc[q >> 2][bj][q & 3][n] = u4 * nmu[q];
      }
  } else {
    float uc[8];
#pragma unroll
    for (int q = 0; q < 8; ++q) uc[q] = e.u[un.bcol + (q >> 2) * 128 + wr * 64 + (q & 3) * 16 + fr];
#pragma unroll
    for (int bj = 0; bj < 2; ++bj)
#pragma unroll
      for (int n = 0; n < 2; ++n) {
        const int tok = un.brow + bj * 128 + wc * 32 + n * 16 + 4 * fq;
        const f32x4 sa = *(const f32x4*)(e.stat_in + 2 * tok), sb = *(const f32x4*)(e.stat_in + 2 * tok + 4);
        const f32x4 nmu = {-sa[0], -sa[2], -sb[0], -sb[2]};
#pragma unroll
        for (int q = 0; q < 8; ++q) acc[q >> 2][bj][q & 3][n] = nmu * uc[q];
      }
  }
}
DEVI float row_rstd(const float* mr, int row) { return mr[2 * row + 1]; }
DEVI f32x4 rstd4(const float* mr, int tok) {
  const f32x4 sa = *(const f32x4*)(mr + 2 * tok), sb = *(const f32x4*)(mr + 2 * tok + 4);
  return (f32x4){sa[1], sa[3], sb[1], sb[3]};
}

template <bool FOLD>
DEVI void epi_vt(const f32x4 (&acc)[2][2][4][2], bf16_t* vt, int chan0, int tok0, int nchan, int wr, int wc, int fr, int fq, const EpiArgs& e, int gcol0) {
  const int b = tok0 >> 13, s0 = tok0 & 8191;
  f32x4 rs[2][2];
#pragma unroll
  for (int bj = 0; bj < 2; ++bj)
#pragma unroll
    for (int n = 0; n < 2; ++n) { if (FOLD) rs[bj][n] = rstd4(e.stat_in, tok0 + bj * 128 + wc * 32 + n * 16 + 4 * fq); else rs[bj][n] = (f32x4){1.f, 1.f, 1.f, 1.f}; }
  float vcs[8];
#pragma unroll
  for (int q = 0; q < 8; ++q) { if (FOLD) vcs[q] = e.v[gcol0 + (q >> 2) * 128 + wr * 64 + (q & 3) * 16 + fr]; else vcs[q] = 0.f; }
#pragma unroll
  for (int ai = 0; ai < 2; ++ai)
#pragma unroll
    for (int m = 0; m < 4; ++m) {
      bf16_t* rowp = (bf16_t*)((char*)vt + ((unsigned)(b * nchan + chan0 + ai * 128 + wr * 64 + m * 16 + fr) * 8192u + (unsigned)(s0 + wc * 32 + 4 * fq)) * 2u);
      const float vc = vcs[ai * 4 + m];
      const int e1 = fq & 1;
#pragma unroll
      for (int bj = 0; bj < 2; ++bj) {
        const f32x4 v0 = acc[ai][bj][m][0] * rs[bj][0] + vc, v1 = acc[ai][bj][m][1] * rs[bj][1] + vc;
        const u32x2 a0 = {pk_bf16(v0[0], v0[1]), pk_bf16(v0[2], v0[3])}, a1 = {pk_bf16(v1[0], v1[1]), pk_bf16(v1[2], v1[3])};
        *(u32x4*)(rowp + bj * 128 + (e1 ? 12 : 0)) = widen_pair16(a0, a1, e1);
      }
    }
}

DEVI void epi_even(const f32x4 (&acc)[2][2][4][2], const Unit& u, int wr, int wc, int fr, int fq, const EpiArgs& e) {
  const int sec = u.bcol >> 9;
  if (u.swap) { epi_vt<false>(acc, sec == 2 ? e.vt0 : e.vt1, u.bcol & 511, u.brow, 512, wr, wc, fr, fq, e, u.bcol); return; }
  const bool moba = sec >= 3;
  const int b = u.brow >> 13, sb = u.brow & 8191;
#pragma unroll
  for (int bj = 0; bj < 2; ++bj) {
    const int gl = (u.bcol & 511) + bj * 128 + wc * 32;
    int p0, c1, half;
    if (!moba) { const int mm = gl >> 6, grp = (gl >> 5) & 1; p0 = grp * 16 + 4 * fq; c1 = sec * 512 + mm * 64 + p0; half = 32; }
    else       { const int hh = gl >> 7, grp = (gl >> 5) & 3; p0 = grp * 16 + 4 * fq; c1 = sec * 512 + hh * 128 + p0; half = 64; }
    const f32x4 inv = moba ? *(const f32x4*)(g_rope.m + p0) : *(const f32x4*)(g_rope.d + p0);
    f32x4 ks1 = {0.f, 0.f, 0.f, 0.f}, ks2 = {0.f, 0.f, 0.f, 0.f};
#pragma unroll
    for (int ai = 0; ai < 2; ++ai)
#pragma unroll
      for (int m = 0; m < 4; ++m) {
        const int row = u.brow + ai * 128 + wr * 64 + m * 16 + fr;
        const float pos = (float)(row & 8191);
        const f32x4 x1 = acc[ai][bj][m][0], x2 = acc[ai][bj][m][1];
        f32x4 y1, y2;
#pragma unroll
        for (int j = 0; j < 4; ++j) {
          float sn, cs; sincos_f(pos * inv[j], sn, cs);
          y1[j] = x1[j] * cs - x2[j] * sn; y2[j] = x2[j] * cs + x1[j] * sn;
        }
        u32x2 w1 = {pk_bf16(y1[0], y1[1]), pk_bf16(y1[2], y1[3])}, w2 = {pk_bf16(y2[0], y2[1]), pk_bf16(y2[2], y2[3])};
        const unsigned hoff = (unsigned)row * 6144u + (unsigned)c1 * 2u;
        *(u32x2*)((char*)e.H + hoff) = w1;
        *(u32x2*)((char*)e.H + hoff + (unsigned)half * 2u) = w2;
        ks1 += y1; ks2 += y2;
        __builtin_amdgcn_sched_barrier(0);
      }
    if (sec == 4) {
#pragma unroll
      for (int j = 0; j < 4; ++j) {
        float a = ks1[j], c = ks2[j];
        a = sum16(a); c = sum16(c);
        if (fr == 0) {
          float* kp = e.kmsum + (size_t)(b * 32 + (sb >> 8)) * 512 + (c1 - 2048) + j;
          atomicAdd(kp, a); atomicAdd(kp + 64, c);
        }
      }
    }
  }
}

DEVI void epi_gla(const f32x4 (&acc)[2][2][4][2], const Unit& u, int wr, int wc, int fr, int fq, const EpiArgs& e) {
  if (u.swap) { epi_vt<true>(acc, e.vt0, u.bcol - 1024, u.brow, 1024, wr, wc, fr, fq, e, u.bcol); return; }
  const int cb = (u.bcol < 1024) ? u.bcol : u.bcol - 1024;
  f32x4 v4[2][2];
#pragma unroll
  for (int bj = 0; bj < 2; ++bj)
#pragma unroll
    for (int n = 0; n < 2; ++n) v4[bj][n] = *(const f32x4*)(e.v + u.bcol + bj * 128 + wc * 32 + n * 16 + 4 * fq);
  float rsq[8];
#pragma unroll
  for (int q = 0; q < 8; ++q) rsq[q] = row_rstd(e.stat_in, u.brow + (q >> 2) * 128 + wr * 64 + (q & 3) * 16 + fr);
#pragma unroll
  for (int ai = 0; ai < 2; ++ai)
#pragma unroll
    for (int m = 0; m < 4; ++m) {
      bf16_t* rowp = (bf16_t*)((char*)e.H + ((unsigned)(u.brow + ai * 128 + wr * 64 + m * 16 + fr) * 2048u + (unsigned)(cb + wc * 32 + 8 * fq)) * 2u);
      const float rsr = rsq[ai * 4 + m];
#pragma unroll
      for (int bj = 0; bj < 2; ++bj) {
        const f32x4 v0 = acc[ai][bj][m][0] * rsr + v4[bj][0], v1 = acc[ai][bj][m][1] * rsr + v4[bj][1];
        u32x4 w4 = {pk_bf16(v0[0], v0[1]), pk_bf16(v0[2], v0[3]), pk_bf16(v1[0], v1[1]), pk_bf16(v1[2], v1[3])};
        *(u32x4*)(rowp + bj * 128) = w4;
      }
    }
}

DEVI void epi_res(const f32x4 (&acc)[2][2][4][2], const Unit& u, int wr, int wc, int fr, int fq, const EpiArgs& e) {
  float mus[8], rsd[8]; f32x4 g4[2][2], b4[2][2];
  const bool ln = e.stat_prev != nullptr;
  if (ln) {
#pragma unroll
    for (int q = 0; q < 8; ++q) row_mu_rstd(e.stat_prev, u.brow + (q >> 2) * 128 + wr * 64 + (q & 3) * 16 + fr, mus[q], rsd[q]);
#pragma unroll
    for (int bj = 0; bj < 2; ++bj)
#pragma unroll
      for (int n = 0; n < 2; ++n) {
        const int c = u.bcol + bj * 128 + wc * 32 + 8 * fq + 4 * n;
        g4[bj][n] = *(const f32x4*)(e.gprev + c); b4[bj][n] = *(const f32x4*)(e.bprev + c);
      }
  } else {
#pragma unroll
    for (int q = 0; q < 8; ++q) { mus[q] = 0.f; rsd[q] = 1.f; }
#pragma unroll
    for (int bj = 0; bj < 2; ++bj)
#pragma unroll
      for (int n = 0; n < 2; ++n) { g4[bj][n] = (f32x4){1.f, 1.f, 1.f, 1.f}; b4[bj][n] = (f32x4){0.f, 0.f, 0.f, 0.f}; }
  }
#pragma unroll
  for (int ai = 0; ai < 2; ++ai)
#pragma unroll
    for (int m = 0; m < 4; ++m) {
      const int row = u.brow + ai * 128 + wr * 64 + m * 16 + fr;
      const unsigned o0 = (unsigned)row * 1024u + (unsigned)(u.bcol + wc * 32 + 8 * fq);
      const float mu = mus[ai * 4 + m], rstd = rsd[ai * 4 + m];
      u32x4 rb[2];
#pragma unroll
      for (int bj = 0; bj < 2; ++bj) rb[bj] = *(const u32x4*)((const char*)e.Y + (o0 + bj * 128) * 2u);
      float s1 = 0.f, s2 = 0.f;
#pragma unroll
      for (int bj = 0; bj < 2; ++bj) {
        const unsigned o = o0 + bj * 128;
        f32x4 r0 = {bflo(rb[bj][0]), bfhi(rb[bj][0]), bflo(rb[bj][1]), bfhi(rb[bj][1])};
        f32x4 r1 = {bflo(rb[bj][2]), bfhi(rb[bj][2]), bflo(rb[bj][3]), bfhi(rb[bj][3])};
        r0 = (r0 - mu) * rstd * g4[bj][0] + b4[bj][0];
        r1 = (r1 - mu) * rstd * g4[bj][1] + b4[bj][1];
        const f32x4 y0 = r0 * DN_ALPHA + acc[ai][bj][m][0], y1 = r1 * DN_ALPHA + acc[ai][bj][m][1];
        u32x4 w4 = {pk_bf16(y0[0], y0[1]), pk_bf16(y0[2], y0[3]), pk_bf16(y1[0], y1[1]), pk_bf16(y1[2], y1[3])};
        *(u32x4*)((char*)e.Y + o * 2u) = w4;
        if (e.final_out) { *(f32x4*)((char*)e.X + o * 4u) = y0; *(f32x4*)((char*)e.X + o * 4u + 16) = y1; }
        s1 += ((y0[0] + y0[1]) + (y0[2] + y0[3])) + ((y1[0] + y1[1]) + (y1[2] + y1[3]));
        s2 += ((y0[0] * y0[0] + y0[1] * y0[1]) + (y0[2] * y0[2] + y0[3] * y0[3])) + ((y1[0] * y1[0] + y1[1] * y1[1]) + (y1[2] * y1[2] + y1[3] * y1[3]));
      }
      s1 += swz_xor<16>(s1); s2 += swz_xor<16>(s2);
      s1 = hsum(s1); s2 = hsum(s2);
      if (fq == 0) { float* sp = e.stat_new + (size_t)((u.bcol >> 8) * 4 + wc) * 65536 + 2 * row; sp[0] = s1; sp[1] = s2; }
    }
}

DEVI void epi_ffn1(const f32x4 (&acc)[2][2][4][2], const Unit& u, int wr, int wc, int fr, int fq, const EpiArgs& e) {
  float rs[8]; f32x4 v4[2][2];
#pragma unroll
  for (int q = 0; q < 8; ++q) rs[q] = row_rstd(e.stat_in, u.brow + (q >> 2) * 128 + wr * 64 + (q & 3) * 16 + fr);
#pragma unroll
  for (int bj = 0; bj < 2; ++bj)
#pragma unroll
    for (int n = 0; n < 2; ++n) v4[bj][n] = *(const f32x4*)(e.v + u.bcol + bj * 128 + wc * 32 + n * 16 + 4 * fq);
#pragma unroll
  for (int ai = 0; ai < 2; ++ai)
#pragma unroll
    for (int m = 0; m < 4; ++m) {
      bf16_t* rowp = (bf16_t*)((char*)e.Hff + ((unsigned)(u.brow + ai * 128 + wr * 64 + m * 16 + fr) * 4096u + (unsigned)(u.bcol + wc * 32 + 8 * fq)) * 2u);
      const float rsr = rs[ai * 4 + m];
#pragma unroll
      for (int bj = 0; bj < 2; ++bj) {
        f32x4 v0 = acc[ai][bj][m][0] * rsr + v4[bj][0], v1 = acc[ai][bj][m][1] * rsr + v4[bj][1];
#pragma unroll
        for (int j = 0; j < 4; ++j) { const float t0 = fmaxf(v0[j], 0.f), t1 = fmaxf(v1[j], 0.f); v0[j] = t0 * t0; v1[j] = t1 * t1; }
        u32x4 w4 = {pk_bf16(v0[0], v0[1]), pk_bf16(v0[2], v0[3]), pk_bf16(v1[0], v1[1]), pk_bf16(v1[2], v1[3])};
        *(u32x4*)(rowp + bj * 128) = w4;
      }
    }
}

extern __shared__ __attribute__((aligned(16))) unsigned char g_lds[];

DEVI void gemm_phase(const bf16_t* A, const bf16_t* Bt, int N, int K, const EpiArgs& e, int wv) {
  LAS unsigned char* lds = (LAS unsigned char*)g_lds;
  const int tid = otid(wv), wid = __builtin_amdgcn_readfirstlane(tid >> 6), lane = tid & 63, wr = wid >> 2, wc = wid & 3, fr = lane & 15, fq = lane >> 4;
  const int nt = K / BK, nN = N / BM;
  unsigned voff[2];
#pragma unroll
  for (int i = 0; i < 2; ++i) { int R, C; stage_rc(tid * 16 + i * 8192, R, C); voff[i] = (unsigned)(R * K + C) * 2u; }
  const size_t kstep = (size_t)(BK * 2);
  const size_t hstep = (size_t)HALF * K * 2;
  const size_t tstep = 2 * hstep;
  const unsigned ldsw = (unsigned)wid * 1024u;
  const int aoff = lds_byte(wr * 64 + fr, fq * 8), boff = lds_byte(wc * 32 + fr, fq * 8);
#define PG8_SA(b, h) (((b) * 2 + (h)) * HTB)
#define PG8_SB(b, h) ((4 + (b) * 2 + (h)) * HTB)
#define PG8_STAGE(bufoff, gbase) do { _Pragma("unroll") for (int _i = 0; _i < 2; ++_i) \
    __builtin_amdgcn_global_load_lds((const unsigned*)((const char*)(gbase) + voff[_i]), (LAS unsigned*)(lds + (bufoff) + ldsw + _i * 8192), 16, 0, 0); } while (0)
#define PG8_LDA(dst, b, h) do { _Pragma("unroll") for (int m = 0; m < 4; ++m) _Pragma("unroll") for (int k = 0; k < 2; ++k) dst[m][k] = *(const LAS bf16x8*)(lds + PG8_SA(b, h) + aoff + m * 2048 + k * 1024); } while (0)
#define PG8_LDB(dst, b, h) do { _Pragma("unroll") for (int n = 0; n < 2; ++n) _Pragma("unroll") for (int k = 0; k < 2; ++k) dst[n][k] = *(const LAS bf16x8*)(lds + PG8_SB(b, h) + boff + n * 2048 + k * 1024); } while (0)
#define PG8_MMA(ai, bj, At, Bt_) do { __builtin_amdgcn_s_setprio(1); _Pragma("unroll") for (int m = 0; m < 4; ++m) _Pragma("unroll") for (int n = 0; n < 2; ++n) _Pragma("unroll") for (int k = 0; k < 2; ++k) \
    acc[ai][bj][m][n] = __builtin_amdgcn_mfma_f32_16x16x32_bf16(Bt_[n][k], At[m][k], acc[ai][bj][m][n], 0, 0, 0); __builtin_amdgcn_s_setprio(0); } while (0)
#define PG8_WAIT_V(n) asm volatile("s_waitcnt vmcnt(" #n ")" ::: "memory")
#define PG8_WAIT_L(n) asm volatile("s_waitcnt lgkmcnt(" #n ")" ::: "memory")
#define PG8_BAR __builtin_amdgcn_s_barrier()
#define PG8_SCHED __builtin_amdgcn_sched_barrier(0)
#define UNIT_P(u) ((const char*)((u).swap ? Bt : A) + (size_t)(((u).swap ? (u).bcol : (u).brow) >> 8) * tstep)
#define UNIT_Q(u) ((const char*)((u).swap ? A : Bt) + (size_t)(((u).swap ? (u).brow : (u).bcol) >> 8) * tstep)
  Unit cur, nxt; int ui = 0;
  if (!unit_next(0, nN, e.kind, cur)) return;
  f32x4 acc[2][2][4][2];
  acc_init(acc, cur, wr, wc, fr, fq, e);
  bf16x8 At[4][2], B0[2][2], B1[2][2];
  const char* cA = UNIT_P(cur); const char* cB = UNIT_Q(cur);
  PG8_STAGE(PG8_SB(0, 0), cB); PG8_STAGE(PG8_SB(0, 1), cB + hstep); PG8_STAGE(PG8_SA(0, 0), cA); PG8_STAGE(PG8_SA(0, 1), cA + hstep);
  if (wr == 1) PG8_BAR;
  PG8_WAIT_V(2); PG8_BAR;
  PG8_STAGE(PG8_SB(1, 0), cB + kstep); PG8_STAGE(PG8_SA(1, 0), cA + kstep); PG8_STAGE(PG8_SB(1, 1), cB + hstep + kstep);
  PG8_WAIT_V(6); PG8_BAR;
  for (;;) {
    const bool has_next = unit_next(ui + 1, nN, e.kind, nxt);
    const char* nA = has_next ? UNIT_P(nxt) : cA; const char* nB = has_next ? UNIT_Q(nxt) : cB;
#pragma unroll 1
    for (int t = 0; t < nt; t += 2) {
      const bool last = (t == nt - 2);
      const char* a1 = cA + (size_t)(t + 1) * kstep;
      const char* a2 = last ? nA : cA + (size_t)(t + 2) * kstep; const char* b2 = last ? nB : cB + (size_t)(t + 2) * kstep;
      const char* a3 = a2 + kstep; const char* b3 = b2 + kstep;
      PG8_LDB(B0, 0, 0); PG8_LDB(B1, 0, 1); PG8_SCHED; PG8_LDA(At, 0, 0); PG8_STAGE(PG8_SA(1, 1), a1 + hstep);
      PG8_WAIT_V(8); PG8_WAIT_L(0); PG8_BAR; PG8_MMA(0, 0, At, B0); PG8_MMA(0, 1, At, B1); PG8_BAR; PG8_SCHED;
      PG8_LDA(At, 0, 1); PG8_STAGE(PG8_SB(0, 0), b2); PG8_STAGE(PG8_SB(0, 1), b2 + hstep); PG8_STAGE(PG8_SA(0, 0), a2);
      PG8_WAIT_V(8); PG8_WAIT_L(0); PG8_BAR; PG8_MMA(1, 0, At, B0); PG8_MMA(1, 1, At, B1); PG8_BAR; PG8_SCHED;
      PG8_LDB(B0, 1, 0); PG8_LDB(B1, 1, 1); PG8_SCHED; PG8_LDA(At, 1, 0); PG8_STAGE(PG8_SA(0, 1), a2 + hstep);
      PG8_WAIT_V(8); PG8_WAIT_L(0); PG8_BAR; PG8_MMA(0, 0, At, B0); PG8_MMA(0, 1, At, B1); PG8_BAR; PG8_SCHED;
      PG8_LDA(At, 1, 1); PG8_STAGE(PG8_SB(1, 0), b3); PG8_STAGE(PG8_SB(1, 1), b3 + hstep); PG8_STAGE(PG8_SA(1, 0), a3);
      PG8_WAIT_V(8); PG8_WAIT_L(0); PG8_BAR; PG8_MMA(1, 0, At, B0); PG8_MMA(1, 1, At, B1); PG8_BAR; PG8_SCHED;
    }
    if (wr == 0) PG8_BAR;
    {
      const int tid_e = otid(wv);
      const int wid_e = __builtin_amdgcn_readfirstlane(tid_e >> 6), lane_e = tid_e & 63;
      const int wr_e = wid_e >> 2, wc_e = wid_e & 3, fr_e = lane_e & 15, fq_e = lane_e >> 4;
      if (e.kind == EPI_EVEN) epi_even(acc, cur, wr_e, wc_e, fr_e, fq_e, e);
      else if (e.kind == EPI_GLA) epi_gla(acc, cur, wr_e, wc_e, fr_e, fq_e, e);
      else if (e.kind == EPI_RES) epi_res(acc, cur, wr_e, wc_e, fr_e, fq_e, e);
      else epi_ffn1(acc, cur, wr_e, wc_e, fr_e, fq_e, e);
    }
    if (!has_next) break;
    cur = nxt; cA = nA; cB = nB; ++ui;
    { const int tid_i = otid(wv); const int wid_i = __builtin_amdgcn_readfirstlane(tid_i >> 6), lane_i = tid_i & 63;
      acc_init(acc, cur, wid_i >> 2, wid_i & 3, lane_i & 15, lane_i >> 4, e); }
    if (wr == 1) PG8_BAR;
  }
  PG8_WAIT_V(0);
  PG8_BAR;
#undef PG8_SA
#undef PG8_SB
#undef PG8_STAGE
#undef PG8_LDA
#undef PG8_LDB
#undef PG8_MMA
}

DEVI void ln_phase(float* X, bf16_t* XB, const float* g, const float* bt, bool final_out, int wv) {
  const int tidl = otid(wv); const int w = tidl >> 6, lane = tidl & 63;
  const int stride = gridDim.x * 8;
  int row = blockIdx.x * 8 + w;
  f32x4 v[4], vn[4];
  if (row < NTOK) {
#pragma unroll
    for (int i = 0; i < 4; ++i) v[i] = *(const f32x4*)(X + (size_t)row * 1024 + i * 256 + lane * 4);
  }
  for (; row < NTOK; row += stride) {
    float* xr = X + (size_t)row * 1024;
    if (row + stride < NTOK) {
#pragma unroll
      for (int i = 0; i < 4; ++i) vn[i] = *(const f32x4*)(X + (size_t)(row + stride) * 1024 + i * 256 + lane * 4);
    }
    float s = 0.f;
#pragma unroll
    for (int i = 0; i < 4; ++i) s += (v[i][0] + v[i][1]) + (v[i][2] + v[i][3]);
    s = sum64(s);
    const float mu = s * (1.f / 1024.f);
    float q = 0.f;
#pragma unroll
    for (int i = 0; i < 4; ++i) { const f32x4 d = v[i] - mu; q += (d[0] * d[0] + d[1] * d[1]) + (d[2] * d[2] + d[3] * d[3]); }
    q = sum64(q);
    const float rstd = rsqrtf(q * (1.f / 1024.f) + 1e-5f);
#pragma unroll
    for (int i = 0; i < 4; ++i) {
      const int c = i * 256 + lane * 4;
      const f32x4 gg = *(const f32x4*)(g + c), bb = *(const f32x4*)(bt + c);
      const f32x4 y = (v[i] - mu) * rstd * gg + bb;
      if (final_out) *(f32x4*)(xr + c) = y;
      else { u32x2 pkd = {pk_bf16(y[0], y[1]), pk_bf16(y[2], y[3])}; *(u32x2*)(XB + (size_t)row * 1024 + c) = pkd; }
    }
#pragma unroll
    for (int i = 0; i < 4; ++i) v[i] = vn[i];
  }
}

DEVI void ln_bf16_phase(const bf16_t* Y, bf16_t* XN, const float* g, const float* bt, int wv) {
  const int tidl = otid(wv); const int w = tidl >> 6, lane = tidl & 63;
  const int stride = gridDim.x * 8;
  int row = blockIdx.x * 8 + w;
  u32x4 ra = {}, rb = {}, na = {}, nb = {};
  if (row < NTOK) { ra = *(const u32x4*)(Y + (size_t)row * 1024 + lane * 8); rb = *(const u32x4*)(Y + (size_t)row * 1024 + 512 + lane * 8); }
  for (; row < NTOK; row += stride, ra = na, rb = nb) {
    if (row + stride < NTOK) { na = *(const u32x4*)(Y + (size_t)(row + stride) * 1024 + lane * 8); nb = *(const u32x4*)(Y + (size_t)(row + stride) * 1024 + 512 + lane * 8); }
    float v[16];
#pragma unroll
    for (int i = 0; i < 4; ++i) { v[2 * i] = bflo(ra[i]); v[2 * i + 1] = bfhi(ra[i]); v[8 + 2 * i] = bflo(rb[i]); v[8 + 2 * i + 1] = bfhi(rb[i]); }
    float sacc = 0.f;
#pragma unroll
    for (int i = 0; i < 16; ++i) sacc += v[i];
    sacc = sum64(sacc);
    const float mu = sacc * (1.f / 1024.f);
    float q = 0.f;
#pragma unroll
    for (int i = 0; i < 16; ++i) { const float d = v[i] - mu; q += d * d; }
    q = sum64(q);
    const float rstd = rsqrtf(q * (1.f / 1024.f) + 1e-5f);
#pragma unroll
    for (int hf = 0; hf < 2; ++hf) {
      const int c = hf * 512 + lane * 8;
      const f32x4 g0 = *(const f32x4*)(g + c), g1 = *(const f32x4*)(g + c + 4), b0 = *(const f32x4*)(bt + c), b1 = *(const f32x4*)(bt + c + 4);
      float y[8];
#pragma unroll
      for (int i = 0; i < 4; ++i) { y[i] = (v[hf * 8 + i] - mu) * rstd * g0[i] + b0[i]; y[4 + i] = (v[hf * 8 + 4 + i] - mu) * rstd * g1[i] + b1[i]; }
      u32x4 o = {pk_bf16(y[0], y[1]), pk_bf16(y[2], y[3]), pk_bf16(y[4], y[5]), pk_bf16(y[6], y[7])};
      *(u32x4*)(XN + (size_t)row * 1024 + c) = o;
    }
  }
}

constexpr int AT_BUF = 34816;
struct TileRegs { u32x4 k0, k1, v0, v1; };
DEVI void at_gload(TileRegs& r, const bf16_t* Kbase, const bf16_t* VTbase, int key0, int t) {
  r.k0 = *(const u32x4*)(Kbase + (size_t)(key0 + (t >> 4)) * 3072 + (t & 15) * 8);
  r.k1 = *(const u32x4*)(Kbase + (size_t)(key0 + 32 + (t >> 4)) * 3072 + (t & 15) * 8);
  r.v0 = *(const u32x4*)(VTbase + (size_t)(t >> 3) * 8192 + key0 + (t & 7) * 8);
  r.v1 = *(const u32x4*)(VTbase + (size_t)(64 + (t >> 3)) * 8192 + key0 + (t & 7) * 8);
}
DEVI void at_lstore(const TileRegs& r, unsigned char* buf, int t) {
  *(u32x4*)(buf + (t >> 4) * 272 + (t & 15) * 16) = r.k0;
  *(u32x4*)(buf + (32 + (t >> 4)) * 272 + (t & 15) * 16) = r.k1;
  unsigned char* vb = buf + 17408;
  u32x2* p0 = (u32x2*)(vb + (t >> 3) * 136 + (t & 7) * 16);
  u32x2 a = {r.v0[0], r.v0[1]}, b = {r.v0[2], r.v0[3]}; p0[0] = a; p0[1] = b;
  u32x2* p1 = (u32x2*)(vb + (64 + (t >> 3)) * 136 + (t & 7) * 16);
  u32x2 c = {r.v1[0], r.v1[1]}, d = {r.v1[2], r.v1[3]}; p1[0] = c; p1[1] = d;
}

template <int MODE>
DEVI void attn_item(const bf16_t* H, const bf16_t* vT, const float* kmsum, bf16_t* AO, int b, int hh, int qi,
                    float lam_full, float one_m_linit, const float* subln, int wv) {
  constexpr int NKS = MODE ? 8 : 4;
  unsigned char* lds = g_lds;
  const int tid = otid(wv), w = tid >> 6, lane = tid & 63, r = lane & 31, h = lane >> 5;
  const int map = MODE ? 0 : (w & 1);
  const int q0 = MODE ? qi * 256 + w * 32 : qi * 128 + (w >> 1) * 32;
  const int ntiles = MODE ? 4 * (qi + 1) : 2 * qi + 2;
  const size_t tokbase = (size_t)b * 8192;
#ifdef MOBA_ON_DIFF
  const int qcol = MODE ? hh * 128 : hh * 128 + map * 64;
  const int kcol = 512 + hh * 128;
#else
  const int qcol = MODE ? 1536 + hh * 128 : hh * 128 + map * 64;
  const int kcol = MODE ? 2048 + hh * 128 : 512 + hh * 128;
#endif
  const bf16_t* Kbase = H + tokbase * 3072 + kcol;
  const bf16_t* VTbase = vT + (size_t)(b * 512 + hh * 128) * 8192;
  const float cs = (MODE ? 0.08838834764831845f : 0.125f) * 1.4426950408889634f;
  const int kboff = MODE ? 0 : map * 128;

  bf16x8 qf[NKS];
  { const bf16_t* qp = H + (tokbase + q0 + r) * 3072 + qcol + 8 * h;
#pragma unroll
    for (int ks = 0; ks < NKS; ++ks) qf[ks] = *(const bf16x8*)(qp + 16 * ks); }

  unsigned sel = 0;
  if (MODE) {
    f32x16 gt = {};
    const float* kmp = kmsum + (size_t)(b * 32 + r) * 512 + hh * 128 + 8 * h;
    f32x4 kma[8], kmc[8];
#pragma unroll
    for (int ks = 0; ks < 8; ++ks) { kma[ks] = *(const f32x4*)(kmp + 16 * ks); kmc[ks] = *(const f32x4*)(kmp + 16 * ks + 4); }
#pragma unroll
    for (int ks = 0; ks < 8; ++ks) {
      const f32x4 a = kma[ks] * (1.f / 256.f), c = kmc[ks] * (1.f / 256.f);
      gt = mfma32(mk8(pk_bf16(a[0], a[1]), pk_bf16(a[2], a[3]), pk_bf16(c[0], c[1]), pk_bf16(c[2], c[3])), qf[ks < NKS ? ks : 0], gt);
    }
    float gv[16];
#pragma unroll
    for (int rg = 0; rg < 16; ++rg) { const int blk = (rg & 3) + 8 * (rg >> 2) + 4 * h; gv[rg] = (blk < qi) ? gt[rg] : NEG_INF; }
#pragma unroll
    for (int round = 0; round < 3; ++round) {
      float best = NEG_INF; int bi = 99;
#pragma unroll
      for (int rg = 0; rg < 16; ++rg) { const int blk = (rg & 3) + 8 * (rg >> 2) + 4 * h; if (gv[rg] > best) { best = gv[rg]; bi = blk; } }
      float b_lo, b_hi; int i_lo, i_hi; halves(best, b_lo, b_hi); halves_i(bi, i_lo, i_hi);
      const bool lowin = (b_lo > b_hi) || (b_lo == b_hi && i_lo < i_hi);
      const float wval = lowin ? b_lo : b_hi; const int wi = lowin ? i_lo : i_hi;
      if (wval > NEG_INF) sel |= 1u << wi;
#pragma unroll
      for (int rg = 0; rg < 16; ++rg) { const int blk = (rg & 3) + 8 * (rg >> 2) + 4 * h; if (blk == wi) gv[rg] = NEG_INF; }
    }
  }

#ifdef SELFIX
  if (MODE) sel = (qi >= 3) ? 7u : ((1u << qi) - 1u);
#endif
  f32x16 o[4] = {};
  float m = NEG_INF, l = 0.f;
  TileRegs tr;
  at_gload(tr, Kbase, VTbase, 0, tid); at_lstore(tr, lds, tid); __syncthreads();
#pragma unroll 1
  for (int tt = 0; tt < ntiles; ++tt) {
    const unsigned char* buf = lds + (tt & 1) * AT_BUF;
    const int key0 = tt * 64;
    if (tt + 1 < ntiles) at_gload(tr, Kbase, VTbase, key0 + 64, tid);
    bool active, needmask, lanesel = true;
    if (MODE && (tt >> 2) < qi) { lanesel = (sel >> (tt >> 2)) & 1u; active = __any(lanesel ? 1 : 0) != 0; needmask = false; }
    else { active = key0 <= q0 + 31; needmask = key0 + 63 > q0; }
    if (active) {
      f32x16 st[2];
      {
        bf16x8 kfa[NKS], kfb[NKS];
        const unsigned char* kp0 = buf + r * 272 + kboff + h * 16;
#pragma unroll
        for (int ks = 0; ks < NKS; ++ks) kfa[ks] = *(const bf16x8*)(kp0 + ks * 32);
#pragma unroll
        for (int ks = 0; ks < NKS; ++ks) kfb[ks] = *(const bf16x8*)(kp0 + 32 * 272 + ks * 32);
        __builtin_amdgcn_sched_barrier(0);
        f32x16 a0 = {}, a1 = {};
#pragma unroll
        for (int ks = 0; ks < NKS; ++ks) a0 = mfma32(kfa[ks], qf[ks], a0);
#pragma unroll
        for (int ks = 0; ks < NKS; ++ks) a1 = mfma32(kfb[ks], qf[ks], a1);
        st[0] = a0; st[1] = a1;
      }
      if (needmask) {
#pragma unroll
        for (int T = 0; T < 2; ++T)
#pragma unroll
          for (int rg = 0; rg < 16; ++rg) { const int key = key0 + 32 * T + 8 * (rg >> 2) + 4 * h + (rg & 3); if (key > q0 + r) st[T][rg] = NEG_INF; }
      }
      float mxr = NEG_INF;
#pragma unroll
      for (int T = 0; T < 2; ++T)
#pragma unroll
        for (int rg = 0; rg < 16; ++rg) mxr = fmaxf(mxr, st[T][rg]);
      mxr = hmax(mxr);
      const float mxs = lanesel ? mxr * cs : NEG_INF;
      if (__any((mxs > m + 8.0f) ? 1 : 0)) {
        const float mn = fmaxf(m, mxs);
        const float mu2 = (mn == NEG_INF) ? 0.f : mn;
        const float alpha = ex2(m - mu2);
        m = mn;
        l *= alpha;
#pragma unroll
        for (int dt = 0; dt < 4; ++dt) o[dt] = o[dt] * alpha;
      }
      const float nb = lanesel ? ((m == NEG_INF) ? 0.f : -m) : NEG_INF;
      float ps = 0.f;
#pragma unroll
      for (int T = 0; T < 2; ++T)
#pragma unroll
        for (int rg = 0; rg < 16; ++rg) { const float pv = ex2(fmaf(st[T][rg], cs, nb)); st[T][rg] = pv; ps += pv; }
      l += ps;
      {
        const unsigned char* vb0 = buf + 17408 + r * 136 + 8 * h;
        u32x2 vlo[2][4], vhi[2][4];
#pragma unroll
        for (int dt = 0; dt < 4; ++dt) { const unsigned char* vp = vb0 + dt * 32 * 136; vlo[0][dt] = *(const u32x2*)vp; vhi[0][dt] = *(const u32x2*)(vp + 16); }
#pragma unroll
        for (int step = 0; step < 4; ++step) {
          const int T = step >> 1, sx = step & 1;
          if (step < 3) {
#pragma unroll
            for (int dt = 0; dt < 4; ++dt) { const unsigned char* vp = vb0 + dt * 32 * 136 + (step + 1) * 32; vlo[(step + 1) & 1][dt] = *(const u32x2*)vp; vhi[(step + 1) & 1][dt] = *(const u32x2*)(vp + 16); }
          }
          const bf16x8 pb = pack8(st[T], sx);
#pragma unroll
          for (int dt = 0; dt < 4; ++dt) o[dt] = mfma32(mk8(vlo[step & 1][dt][0], vlo[step & 1][dt][1], vhi[step & 1][dt][0], vhi[step & 1][dt][1]), pb, o[dt]);
          __builtin_amdgcn_sched_barrier(0);
        }
      }
    }
    if (tt + 1 < ntiles) at_lstore(tr, lds + ((tt + 1) & 1) * AT_BUF, tid);
    __syncthreads();
  }
  const float lt = hsum(l);
  const float il = 1.f / lt;
  const size_t token = tokbase + q0 + r;
  if (MODE) {
#pragma unroll
    for (int dt = 0; dt < 4; ++dt)
#pragma unroll
      for (int gp = 0; gp < 2; ++gp) {
        const int g0 = 2 * gp, g1 = g0 + 1;
        const u32x2 a0 = {pk_bf16(o[dt][4 * g0] * il, o[dt][4 * g0 + 1] * il), pk_bf16(o[dt][4 * g0 + 2] * il, o[dt][4 * g0 + 3] * il)};
        const u32x2 a1 = {pk_bf16(o[dt][4 * g1] * il, o[dt][4 * g1 + 1] * il), pk_bf16(o[dt][4 * g1 + 2] * il, o[dt][4 * g1 + 3] * il)};
        *(u32x4*)(AO + token * 1024 + 512 + hh * 128 + 32 * dt + 8 * (g0 + h)) = widen_pair(a0, a1, h);
      }
  } else {
    float* ex = (float*)lds;
    const int rgp = w >> 1;
    if (map == 1) {
      const float f = il * lam_full;
#pragma unroll
      for (int dt = 0; dt < 4; ++dt)
#pragma unroll
        for (int rg = 0; rg < 16; ++rg) ex[((rgp * 4 + dt) * 16 + rg) * 64 + lane] = o[dt][rg] * f;
    }
    __syncthreads();
    if (map == 0) {
      float ss = 0.f;
#pragma unroll
      for (int dt = 0; dt < 4; ++dt)
#pragma unroll
        for (int rg = 0; rg < 16; ++rg) { const float d = o[dt][rg] * il - ex[((rgp * 4 + dt) * 16 + rg) * 64 + lane]; o[dt][rg] = d; ss += d * d; }
      ss = hsum(ss);
      const float rinv = rsqrtf(ss * (1.f / 128.f) + 1e-5f) * one_m_linit;
#pragma unroll
      for (int dt = 0; dt < 4; ++dt)
#pragma unroll
        for (int gp = 0; gp < 2; ++gp) {
          u32x2 a[2];
#pragma unroll
          for (int k = 0; k < 2; ++k) {
            const int g = 2 * gp + k, dv = 32 * dt + 8 * g + 4 * h;
            const f32x4 sl = *(const f32x4*)(lds + 130048 + dv * 4);
            a[k] = (u32x2){pk_bf16(o[dt][4 * g] * rinv * sl[0], o[dt][4 * g + 1] * rinv * sl[1]), pk_bf16(o[dt][4 * g + 2] * rinv * sl[2], o[dt][4 * g + 3] * rinv * sl[3])};
          }
          *(u32x4*)(AO + token * 1024 + hh * 128 + 32 * dt + 8 * (2 * gp + h)) = widen_pair(a[0], a[1], h);
        }
    }
    __syncthreads();
  }
}

#ifndef AM
#define AM 3
#endif
DEVI void attn_phase(const Params& p, int e, int wv) {
  asm volatile("" : "+s"(e));
  unsigned char* ws = p.ws;
  const bf16_t* H = (const bf16_t*)(ws + WS_OV + OV_H);
  const bf16_t* dvT = (const bf16_t*)(ws + WS_OV + OV_DVT);
  const bf16_t* mvT = (const bf16_t*)(ws + WS_OV + OV_MVT);
  const float* kmsum = (const float*)(ws + WS_KM) + (size_t)e * 65536;
  bf16_t* AO = (bf16_t*)(ws + WS_AO);
  const float* lam = p.in[2] + e * 256;
  float s1 = 0.f, s2 = 0.f;
  for (int i = 0; i < 64; ++i) { s1 += lam[i] * lam[64 + i]; s2 += lam[128 + i] * lam[192 + i]; }
  const float linit = (e == 0) ? 0.2f : 0.47071301834358413f;
  const float lam_full = __expf(s1) - __expf(s2) + linit;
  const float* subln = p.in[3] + e * 128;
  { const int t0 = otid(wv); if (t0 < 128) ((float*)(g_lds + 130048))[t0] = subln[t0]; __syncthreads(); }
  const int vb = (gridDim.x == 256) ? (int)((blockIdx.x & 7) * 32 + (blockIdx.x >> 3)) : (int)blockIdx.x;
#pragma unroll 1
  for (int u = vb; u < 768; u += gridDim.x) {
    if (u < 512) {
      if (!(AM & 1)) continue;
      const int pidx = (u & 255) * 2 + (u >> 8); const int bh = pidx >> 5, ip = pidx & 31;
      attn_item<0>(H, dvT, kmsum, AO, bh >> 2, bh & 3, 63 - ip, lam_full, 1.f - linit, subln, wv);
      attn_item<0>(H, dvT, kmsum, AO, bh >> 2, bh & 3, ip, lam_full, 1.f - linit, subln, wv);
    } else {
      if (!(AM & 2)) continue;
      const int pp = u - 512, bh = pp >> 4, jp = pp & 15;
#ifdef MOBA_ON_DIFF
#define MVT_SRC dvT
#else
#define MVT_SRC mvT
#endif
      attn_item<1>(H, MVT_SRC, kmsum, AO, bh >> 2, bh & 3, 31 - jp, lam_full, 1.f - linit, subln, wv);
      attn_item<1>(H, MVT_SRC, kmsum, AO, bh >> 2, bh & 3, jp, lam_full, 1.f - linit, subln, wv);
    }
  }
}

DEVI void gla_prep_item(int item, const bf16_t* XB, const bf16_t* WgdT, const float* Wup, const float* bgate,
                        bf16_t* Hg, bf16_t* kT, float* decay, const float* stat_in, const float* ugd, const float* vgd, int wv) {
  const int tid = otid(wv), w = tid >> 6, lane = tid & 63;
  const int b = item >> 7, ch = item & 127;
  const size_t tok0 = (size_t)b * 8192 + ch * 64;
  float* gd = (float*)g_lds;
  if (w < 4) {
    const int fr = lane & 15, fq = lane >> 4;
    f32x4 acc = {};
    const bf16_t* ap = XB + (tok0 + 16 * w + fr) * 1024 + 8 * fq;
    const bf16_t* bp = WgdT + fr * 1024 + 8 * fq;
#pragma unroll 1
    for (int k0 = 0; k0 < 32; k0 += 8) {
      bf16x8 af[8], bfr[8];
#pragma unroll
      for (int i = 0; i < 8; ++i) { af[i] = *(const bf16x8*)(ap + 32 * (k0 + i)); bfr[i] = *(const bf16x8*)(bp + 32 * (k0 + i)); }
#pragma unroll
      for (int i = 0; i < 8; ++i) acc = mfma16(af[i], bfr[i], acc);
    }
    const float ug = ugd[fr], vg = vgd[fr];
#pragma unroll
    for (int j = 0; j < 4; ++j) {
      float mu, rstd; row_mu_rstd(stat_in, (int)tok0 + 16 * w + 4 * fq + j, mu, rstd);
      gd[(16 * w + 4 * fq + j) * 16 + fr] = rstd * (acc[j] - mu * ug) + vg;
    }
  }
  __syncthreads();
  const int c = tid;
  float wup[16];
#pragma unroll
  for (int rr = 0; rr < 16; ++rr) wup[rr] = Wup[rr * 512 + c];
  const float bias = bgate[c];
  float bsum = 0.f;
  bf16_t* qp = Hg + tok0 * 2048 + c;
  bf16_t* kp = qp + 512;
  bf16_t* ktp = kT + (size_t)(b * 512 + c) * 8192 + ch * 64;
  bf16_t qv[8], kv[8], qn[8], kn[8];
#pragma unroll
  for (int tt = 0; tt < 8; ++tt) { qv[tt] = qp[(size_t)tt * 2048]; kv[tt] = kp[(size_t)tt * 2048]; }
#pragma unroll 1
  for (int t8 = 0; t8 < 8; ++t8) {
    if (t8 < 7) {
#pragma unroll
      for (int tt = 0; tt < 8; ++tt) { qn[tt] = qp[(size_t)((t8 + 1) * 8 + tt) * 2048]; kn[tt] = kp[(size_t)((t8 + 1) * 8 + tt) * 2048]; }
    }
    unsigned short kb[8];
#pragma unroll
    for (int tt = 0; tt < 8; ++tt) {
      const int t = t8 * 8 + tt;
      const f32x4* g4 = (const f32x4*)(gd + t * 16);
      float z = bias;
#pragma unroll
      for (int i = 0; i < 4; ++i) { const f32x4 gg = g4[i]; z += gg[0] * wup[4 * i] + gg[1] * wup[4 * i + 1] + gg[2] * wup[4 * i + 2] + gg[3] * wup[4 * i + 3]; }
      const float ls = fminf(z, 0.f) - __logf(1.f + __expf(-fabsf(z)));
      bsum += ls * 0.0625f;
      const float eb = __expf(bsum), en = __expf(-bsum);
      const float q = bf2f(qv[tt]), k = bf2f(kv[tt]);
      qp[(size_t)t * 2048] = f2bf(q * eb * 0.08838834764831845f);
      const bf16_t kk = f2bf(k * en);
      kp[(size_t)t * 2048] = kk;
      kb[tt] = kk;
    }
    u32x4 pk = {(unsigned)kb[0] | ((unsigned)kb[1] << 16), (unsigned)kb[2] | ((unsigned)kb[3] << 16),
                (unsigned)kb[4] | ((unsigned)kb[5] << 16), (unsigned)kb[6] | ((unsigned)kb[7] << 16)};
    *(u32x4*)(ktp + t8 * 8) = pk;
#pragma unroll
    for (int tt = 0; tt < 8; ++tt) { qv[tt] = qn[tt]; kv[tt] = kn[tt]; }
  }
  decay[(size_t)(b * 128 + ch) * 512 + c] = __expf(bsum);
  __syncthreads();
}

constexpr int GL_Q = 0, GL_K = 17408, GL_KT = 34816, GL_BUF = 53248, GL_RED = 2 * GL_BUF;

template <int PASS>
DEVI void gla_scan_item(int item, const bf16_t* Hg, const bf16_t* vT, const bf16_t* kT, const float* decay,
                        float* Ubuf, float* Dseg, bf16_t* AO, const float* normg, int wv) {
  const int tid = otid(wv), w = tid >> 6, lane = tid & 63, r = lane & 31, h = lane >> 5;
  const int bh = item >> 4, seg = item & 15, b = bh >> 2, hd = bh & 3;
  unsigned char* lds = g_lds;
  const bf16_t* hq = Hg + ((size_t)b * 8192 + seg * 512 + (tid >> 4)) * 2048 + hd * 128 + (tid & 15) * 8;
  const bf16_t* kts = kT + (size_t)(b * 512 + hd * 128 + (tid >> 3)) * 8192 + seg * 512 + (tid & 7) * 8;
  u32x4 rq0, rq1, rk0, rk1, rt0, rt1;
#define GL_GLOAD(cc) do { \
    if (PASS == 1) { const bf16_t* _p = hq + (size_t)(cc) * 64 * 2048; rq0 = *(const u32x4*)_p; rq1 = *(const u32x4*)(_p + 32 * 2048); \
                     rk0 = *(const u32x4*)(_p + 512); rk1 = *(const u32x4*)(_p + 32 * 2048 + 512); } \
    rt0 = *(const u32x4*)(kts + (cc) * 64); rt1 = *(const u32x4*)(kts + (size_t)64 * 8192 + (cc) * 64); } while (0)
#define GL_LSTORE(bufp) do { \
    if (PASS == 1) { unsigned char* _q = (bufp) + GL_Q + (tid >> 4) * 272 + (tid & 15) * 16; *(u32x4*)_q = rq0; *(u32x4*)(_q + 32 * 272) = rq1; \
                     *(u32x4*)(_q + GL_K) = rk0; *(u32x4*)(_q + GL_K + 32 * 272) = rk1; } \
    unsigned char* _t = (bufp) + GL_KT + (tid >> 3) * 144 + (tid & 7) * 16; *(u32x4*)_t = rt0; *(u32x4*)(_t + 64 * 144) = rt1; } while (0)
  GL_GLOAD(0);
  f32x16 S[4] = {};
  if (PASS == 1) {
#pragma unroll 1
    for (int js = 0; js < seg; ++js) {
      const int it2 = bh * 16 + js;
      const float* up = Ubuf + ((size_t)(it2 * 8 + w) * 4) * 1024 + lane;
      const float* dp = Dseg + it2 * 128 + 4 * h;
#pragma unroll
      for (int dkt = 0; dkt < 4; ++dkt)
#pragma unroll
        for (int g = 0; g < 4; ++g) {
          const f32x4 d4 = *(const f32x4*)(dp + 32 * dkt + 8 * g);
#pragma unroll
          for (int i = 0; i < 4; ++i) S[dkt][4 * g + i] = S[dkt][4 * g + i] * d4[i] + up[(dkt * 16 + 4 * g + i) * 64];
        }
    }
  }
  GL_LSTORE(lds);
  __syncthreads();
  const bf16_t* vrow = vT + (size_t)(b * 1024 + hd * 256 + 32 * w + r) * 8192;
#pragma unroll 1
  for (int cc = 0; cc < 8; ++cc) {
    const int ch = seg * 8 + cc, tc0 = ch * 64;
    const size_t tokabs0 = (size_t)b * 8192 + tc0;
    const unsigned char* buf = lds + (cc & 1) * GL_BUF;
    if (cc + 1 < 8) GL_GLOAD(cc + 1);
    bf16x8 vnat[4];
#pragma unroll
    for (int ks = 0; ks < 4; ++ks) vnat[ks] = *(const bf16x8*)(vrow + tc0 + 16 * ks + 8 * h);
    f32x16 o0 = {}, o1 = {};
    if (PASS == 1) {
      f32x16 X00 = {}, X01 = {}, X11 = {};
      { const unsigned char* qL = buf + GL_Q + r * 272 + h * 16; const unsigned char* kL = buf + GL_K + r * 272 + h * 16;
#pragma unroll
        for (int ks = 0; ks < 8; ++ks) {
          const bf16x8 k0 = *(const bf16x8*)(kL + ks * 32), k1 = *(const bf16x8*)(kL + 32 * 272 + ks * 32);
          const bf16x8 q0 = *(const bf16x8*)(qL + ks * 32), q1 = *(const bf16x8*)(qL + 32 * 272 + ks * 32);
          X00 = mfma32(k0, q0, X00); X01 = mfma32(k0, q1, X01); X11 = mfma32(k1, q1, X11);
        } }
      u32x2 vpa[4], vpb[4];
      { const bf16_t* vp = vrow + tc0 + 4 * h;
#pragma unroll
        for (int q = 0; q < 4; ++q) { vpa[q] = *(const u32x2*)(vp + 16 * q); vpb[q] = *(const u32x2*)(vp + 16 * q + 8); } }
#pragma unroll
      for (int rg = 0; rg < 16; ++rg) { const int j = (rg & 3) + 8 * (rg >> 2) + 4 * h; if (r < j) { X00[rg] = 0.f; X11[rg] = 0.f; } }
      { const unsigned char* qP = buf + GL_Q + r * 272 + 8 * h;
#pragma unroll
        for (int dkt = 0; dkt < 4; ++dkt)
#pragma unroll
          for (int sx = 0; sx < 2; ++sx) {
            const bf16x8 sa = pack8(S[dkt], sx);
            const unsigned char* qq = qP + (32 * dkt + 16 * sx) * 2;
            const u32x2 a0 = *(const u32x2*)qq, a1 = *(const u32x2*)(qq + 16);
            const u32x2 c0 = *(const u32x2*)(qq + 32 * 272), c1 = *(const u32x2*)(qq + 32 * 272 + 16);
            o0 = mfma32(sa, mk8(a0[0], a0[1], a1[0], a1[1]), o0);
            o1 = mfma32(sa, mk8(c0[0], c0[1], c1[0], c1[1]), o1);
          } }
#pragma unroll
      for (int sx = 0; sx < 2; ++sx) {
        const bf16x8 v0 = mk8(vpa[sx][0], vpa[sx][1], vpb[sx][0], vpb[sx][1]), v1 = mk8(vpa[2 + sx][0], vpa[2 + sx][1], vpb[2 + sx][0], vpb[2 + sx][1]);
        o0 = mfma32(v0, pack8(X00, sx), o0);
        o1 = mfma32(v0, pack8(X01, sx), o1);
        o1 = mfma32(v1, pack8(X11, sx), o1);
      }
      float ss0 = 0.f, ss1 = 0.f;
#pragma unroll
      for (int rg = 0; rg < 16; ++rg) { ss0 += o0[rg] * o0[rg]; ss1 += o1[rg] * o1[rg]; }
      ss0 = hsum(ss0); ss1 = hsum(ss1);
      float* red = (float*)(lds + GL_RED) + (cc & 1) * 512;
      if (h == 0) { red[w * 64 + r] = ss0; red[w * 64 + 32 + r] = ss1; }
    }
    { const unsigned char* ktL = buf + GL_KT + r * 144 + h * 16;
#pragma unroll
      for (int ks = 0; ks < 4; ++ks)
#pragma unroll
        for (int dkt = 0; dkt < 4; ++dkt) S[dkt] = mfma32(*(const bf16x8*)(ktL + dkt * 32 * 144 + ks * 32), vnat[ks], S[dkt]); }
    { const float* dcp = decay + (size_t)(b * 128 + ch) * 512 + hd * 128 + 4 * h;
#pragma unroll
      for (int dkt = 0; dkt < 4; ++dkt)
#pragma unroll
        for (int g = 0; g < 4; ++g) {
          const f32x4 d4 = *(const f32x4*)(dcp + 32 * dkt + 8 * g);
#pragma unroll
          for (int i = 0; i < 4; ++i) S[dkt][4 * g + i] *= d4[i];
        } }
    if (cc + 1 < 8) GL_LSTORE(lds + ((cc + 1) & 1) * GL_BUF);
    __syncthreads();
    if (PASS == 1) {
      const float* red = (const float*)(lds + GL_RED) + (cc & 1) * 512;
      float t0 = 0.f, t1 = 0.f;
#pragma unroll
      for (int ww = 0; ww < 8; ++ww) { t0 += red[ww * 64 + r]; t1 += red[ww * 64 + 32 + r]; }
      const float ri0 = rsqrtf(t0 * (1.f / 256.f) + 1e-5f), ri1 = rsqrtf(t1 * (1.f / 256.f) + 1e-5f);
      u32x2 r4s[2][4]; f32x4 gns[4];
#pragma unroll
      for (int g = 0; g < 4; ++g) {
        gns[g] = *(const f32x4*)(normg + 32 * w + 8 * g + 4 * h);
#pragma unroll
        for (int it = 0; it < 2; ++it) r4s[it][g] = *(const u32x2*)(Hg + (tokabs0 + 32 * it + r) * 2048 + 1024 + hd * 256 + 32 * w + 8 * g + 4 * h);
      }
#pragma unroll
      for (int it = 0; it < 2; ++it) {
        const size_t tok = tokabs0 + 32 * it + r;
        u32x2 pk4[4];
#pragma unroll
        for (int g = 0; g < 4; ++g) {
          const u32x2 r4 = r4s[it][g];
          const f32x4 gn = gns[g];
          const float rv[4] = {bflo(r4[0]), bfhi(r4[0]), bflo(r4[1]), bfhi(r4[1])};
          float ov[4];
#pragma unroll
          for (int i = 0; i < 4; ++i) {
            const float oo = it ? o1[4 * g + i] : o0[4 * g + i];
            const float sg = rv[i] / (1.f + __expf(-rv[i]));
            ov[i] = oo * (it ? ri1 : ri0) * gn[i] * sg;
          }
          pk4[g] = (u32x2){pk_bf16(ov[0], ov[1]), pk_bf16(ov[2], ov[3])};
        }
#pragma unroll
        for (int gp = 0; gp < 2; ++gp)
          *(u32x4*)(AO + tok * 1024 + hd * 256 + 32 * w + 8 * (2 * gp + h)) = widen_pair(pk4[2 * gp], pk4[2 * gp + 1], h);
      }
    }
  }
#undef GL_GLOAD
#undef GL_LSTORE
  if (PASS == 0) {
    float* up = Ubuf + ((size_t)(item * 8 + w) * 4) * 1024 + lane;
#pragma unroll
    for (int dkt = 0; dkt < 4; ++dkt)
#pragma unroll
      for (int rg = 0; rg < 16; ++rg) up[(dkt * 16 + rg) * 64] = S[dkt][rg];
    if (tid < 128) {
      float dv8[8];
#pragma unroll
      for (int cc = 0; cc < 8; ++cc) dv8[cc] = decay[(size_t)(b * 128 + seg * 8 + cc) * 512 + hd * 128 + tid];
      float d = 1.f;
#pragma unroll
      for (int cc = 0; cc < 8; ++cc) d *= dv8[cc];
      Dseg[item * 128 + tid] = d;
    }
  }
  __syncthreads();
}

#define XB_TMO      128
#define XB_XCNT(j)  (256  + 64 * (j))
#define XB_XSUB(j)  (1280 + 64 * (j))
#define XB_XGEN(j)  (2304 + 64 * (j))
#define XB_TOP      3328
#define XB_TOPGEN   3392
#define XCD_BAR_WORDS 3456
#define XB_SPIN_CAP (1u << 20)
DEVI unsigned xb_ld(unsigned* p)              { return __hip_atomic_load(p, __ATOMIC_RELAXED, __HIP_MEMORY_SCOPE_AGENT); }
DEVI unsigned xb_add(unsigned* p, unsigned v) { return __hip_atomic_fetch_add(p, v, __ATOMIC_RELAXED, __HIP_MEMORY_SCOPE_AGENT); }
DEVI unsigned xb_xcc_id() { return (unsigned)__builtin_amdgcn_s_getreg((3 << 11) | 20) & 0xFu; }
#define XB_SPIN(cond, bar) do { unsigned _sp = 0; while (cond) { __builtin_amdgcn_s_sleep(1); \
    if ((++_sp & 255u) == 0u) { if (xb_ld(&(bar)[XB_TMO])) break; if (_sp > XB_SPIN_CAP) { atomicAdd(&(bar)[XB_TMO], 1u); break; } } } } while (0)
struct XcdBarrier { unsigned* bar; unsigned x; volatile LAS unsigned* st; };
DEVI void xcd_barrier_complete(unsigned* bar, unsigned x, unsigned& nloc, unsigned& nx) {
  const unsigned G = gridDim.x * gridDim.y * gridDim.z;
  unsigned sum, cnt, mine, sp = 0u;
  for (;;) {
    sum = 0u; cnt = 0u; mine = 0u;
#pragma unroll
    for (unsigned j = 0; j < 16; ++j) { const unsigned c = xb_ld(&bar[XB_XCNT(j)]); sum += c; cnt += (c > 0u) ? 1u : 0u; mine = (j == x) ? c : mine; }
    if (sum == G) break;
    __builtin_amdgcn_s_sleep(1);
    if ((++sp & 255u) == 0u) { if (xb_ld(&bar[XB_TMO])) break; if (sp > XB_SPIN_CAP) { atomicAdd(&bar[XB_TMO], 1u); break; } }
  }
  nloc = mine > 0u ? mine : 1u; nx = cnt > 0u ? cnt : 1u;
}
DEVI void xcd_barrier(const XcdBarrier& b, bool leader) {
  asm volatile("s_waitcnt vmcnt(0)" ::: "memory");
  __syncthreads();
  if (leader) {
    unsigned* bar = b.bar;
    __builtin_amdgcn_s_waitcnt(0);
    unsigned bx = xb_xcc_id(); asm volatile("" : "+s"(bx));
    unsigned nloc = b.st[0], nx = b.st[1];
    if (nloc == 0u) { xcd_barrier_complete(bar, bx, nloc, nx); b.st[0] = nloc; b.st[1] = nx; }
    const unsigned old = xb_add(&bar[XB_XSUB(bx)], 1u);
    const unsigned gen = old / nloc;
    if (old + 1u == (gen + 1u) * nloc) {
      __builtin_amdgcn_fence(__ATOMIC_RELEASE, "agent");
      asm volatile("s_waitcnt vmcnt(0)" ::: "memory");
      const unsigned og = xb_add(&bar[XB_TOP], 1u);
      const unsigned tg = og / nx;
      if (og + 1u == (tg + 1u) * nx) xb_add(&bar[XB_TOPGEN], 1u);
      else XB_SPIN(xb_ld(&bar[XB_TOPGEN]) == tg, bar);
      __builtin_amdgcn_fence(__ATOMIC_ACQUIRE, "agent");
      xb_add(&bar[XB_XGEN(bx)], 1u);
      asm volatile("s_waitcnt vmcnt(0)" ::: "memory");
    } else {
      XB_SPIN(xb_ld(&bar[XB_XGEN(bx)]) == gen, bar);
      __builtin_amdgcn_fence(__ATOMIC_ACQUIRE, "agent");
      asm volatile("s_waitcnt vmcnt(0)" ::: "memory");
    }
  }
  __syncthreads();
}

#define GSYNC() xcd_barrier(xb, otid(wv) == 0)
__global__ void __launch_bounds__(512, 2) mega_fwd(Params p) {
  cg::grid_group grid = cg::this_grid();
  const int wv = __builtin_amdgcn_readfirstlane((int)threadIdx.x >> 6);
  unsigned char* ws = p.ws;
  XcdBarrier xb; xb.bar = (unsigned*)(ws + WS_BAR); xb.x = xb_xcc_id(); xb.st = (volatile LAS unsigned*)((LAS unsigned char*)g_lds + 131072);
  if (threadIdx.x == 0) { xb.st[0] = 0u; xb.st[1] = 0u; (void)xb_add(&xb.bar[XB_XCNT(xb.x)], 1u); }
  grid.sync();
  bf16_t* XB = (bf16_t*)(ws + WS_XB);
  bf16_t* AO = (bf16_t*)(ws + WS_AO);
  unsigned char* OV = ws + WS_OV;

#ifndef PM
#define PM 0xff
#endif
#ifndef DUP
#define DUP 0
#endif
  if (PM & 1) prologue(p, (char*)g_lds, wv);
  GSYNC();
#if (DUP & 32)
  prologue(p, (char*)g_lds, wv);
  GSYNC();
#endif

  { const int gtid = blockIdx.x * 512 + otid(wv);
    for (int i = gtid; i < 4 * 14336; i += gridDim.x * 512) {
      const int l = i / 14336, c = i % 14336;
      if (c < 6144 && !(l & 1)) continue;
      const float* pp = (const float*)(ws + WS_UVP) + (size_t)l * 16 * 16384 + c;
      float acc = 0.f;
#pragma unroll
      for (int kt = 0; kt < 16; ++kt) acc += pp[(size_t)kt * 16384];
      ((float*)(ws + WS_UV))[(size_t)l * 16384 + c] = acc;
    } }
#pragma unroll 1
  for (int l = 0; l < 4; ++l) {
    const bf16_t* wl = (const bf16_t*)(ws + WS_WT + (size_t)l * WT_LAYER);
    const int e = l >> 1;
    const bool odd = (l & 1) != 0;
    bf16_t* Hg = (bf16_t*)(OV + OV_HG); bf16_t* vT = (bf16_t*)(OV + OV_VT); bf16_t* kT = (bf16_t*)(OV + OV_KT);
    float* Ubuf = (float*)(OV + OV_U); float* decay = (float*)(ws + WS_DEC); float* Dseg = (float*)(ws + WS_DSEG);
#pragma unroll 1
    for (int st = 0; st < 9; ++st) {
      if (!odd && (st == 2 || st == 3)) continue;
      if (st == 5 || (st == 8 && l != 3)) {
        stat_finalize((const float*)(ws + WS_STATS) + (st == 8 ? 1048576 : 0), (float*)(ws + WS_MR) + (st == 8 ? 65536 : 0), wv);
        GSYNC();
        continue;
      }
      if (st == 0 || st == 4 || st == 6 || st == 7) {
        EpiArgs ea{};
        const bf16_t* A; const bf16_t* Bt; int N, K;
        const float* uv = (const float*)(ws + WS_UV) + (size_t)l * 16384;
        float* stats = (float*)(ws + WS_STATS);
        const float* mrb = (const float*)(ws + WS_MR);
        if (st == 0) {
          A = XB; Bt = wl; N = 3072; K = 1024;
          if (odd) { ea.stat_in = mrb + 65536; ea.u = uv + UV_U_IN; ea.v = uv + UV_V_IN; }
          else if (l > 0) { ln_bf16_phase(XB, AO, p.in[14] + (l - 1) * 1024, p.in[15] + (l - 1) * 1024, wv); GSYNC(); A = AO; }
          if (odd) { ea.kind = EPI_GLA; ea.H = Hg; ea.vt0 = vT; }
          else { ea.kind = EPI_EVEN; ea.H = (bf16_t*)(OV + OV_H); ea.vt0 = (bf16_t*)(OV + OV_DVT); ea.vt1 = (bf16_t*)(OV + OV_MVT); ea.kmsum = (float*)(ws + WS_KM) + (size_t)e * 65536; }
        } else if (st == 4) {
          A = AO; Bt = wl + 3 * 1024 * 1024; N = 1024; K = 1024; ea.kind = EPI_RES; ea.Y = XB; ea.X = p.X;
          if (l > 0) { ea.stat_prev = mrb + 65536; ea.gprev = p.in[14] + (l - 1) * 1024; ea.bprev = p.in[15] + (l - 1) * 1024; }
          ea.stat_new = stats;
        } else if (st == 6) {
          A = XB; Bt = wl + 4 * 1024 * 1024; N = 4096; K = 1024; ea.kind = EPI_FFN1; ea.Hff = (bf16_t*)OV;
          ea.stat_in = mrb; ea.u = uv + UV_U_F1; ea.v = uv + UV_V_F1;
        } else {
          A = (const bf16_t*)OV; Bt = wl + 8 * 1024 * 1024; N = 1024; K = 4096; ea.kind = EPI_RES; ea.Y = XB; ea.X = p.X;
          ea.stat_prev = mrb; ea.gprev = p.in[10] + l * 1024; ea.bprev = p.in[11] + l * 1024;
          ea.stat_new = stats + 1048576; ea.final_out = (l == 3);
        }
        if (PM & 2) gemm_phase(A, Bt, N, K, ea, wv);
#if (DUP & 2)
        if (st == 6) { GSYNC(); gemm_phase(A, Bt, N, K, ea, wv); }
#endif
      } else if (st == 1) {
        if (odd) {
#pragma unroll 1
          for (int it = blockIdx.x; it < 512; it += gridDim.x)
            if (PM & 8) gla_prep_item(it, XB, (const bf16_t*)(ws + WS_WGD) + (size_t)e * 16384, p.in[6] + e * 8192, p.in[7] + e * 512, Hg, kT, decay,
                                      (const float*)(ws + WS_MR) + 65536, (const float*)(ws + WS_UV) + (size_t)l * 16384 + UV_U_GD, (const float*)(ws + WS_UV) + (size_t)l * 16384 + UV_V_GD, wv);
        } else {
          if (PM & 4) attn_phase(p, e, wv);
#if (DUP & 1)
          GSYNC(); attn_phase(p, e, wv);
#endif
        }
      } else if (st == 2) {
#pragma unroll 1
        for (int it = blockIdx.x; it < 256; it += gridDim.x) if (PM & 16) gla_scan_item<0>(it, Hg, vT, kT, decay, Ubuf, Dseg, AO, p.in[8] + e * 256, wv);
#if (DUP & 4)
        GSYNC();
        for (int it = blockIdx.x; it < 256; it += gridDim.x) gla_scan_item<0>(it, Hg, vT, kT, decay, Ubuf, Dseg, AO, p.in[8] + e * 256, wv);
#endif
      } else if (st == 3) {
#pragma unroll 1
        for (int it = blockIdx.x; it < 256; it += gridDim.x) if (PM & 32) gla_scan_item<1>(it, Hg, vT, kT, decay, Ubuf, Dseg, AO, p.in[8] + e * 256, wv);
#if (DUP & 8)
        GSYNC();
        for (int it = blockIdx.x; it < 256; it += gridDim.x) gla_scan_item<1>(it, Hg, vT, kT, decay, Ubuf, Dseg, AO, p.in[8] + e * 256, wv);
#endif
      } else {
        if (PM & 64) ln_phase(p.X, XB, p.in[14] + l * 1024, p.in[15] + l * 1024, true, wv);
      }
      GSYNC();
#if (DUP & 16)
      GSYNC();
#endif
    }
  }
}

extern "C" void kernel_launch(void* const* d_in, const int* in_sizes, int n_in, void* d_out, int out_size, void* d_ws, size_t ws_size,
                              hipStream_t stream) {
  constexpr int LDS_BYTES = 131072 + 64;
  static int grid = 0;
  if (grid == 0) {
    if (n_in != 16 || out_size != NTOK * DM || ws_size < WS_END) {
      fprintf(stderr, "kernel_launch: unexpected shapes (n_in %d out %d ws %zu need %zu)\n", n_in, out_size, ws_size, (size_t)WS_END);
      grid = -1; return;
    }
    int dev = 0, cus = 0, per_cu = 0;
    hipGetDevice(&dev);
    hipDeviceGetAttribute(&cus, hipDeviceAttributeMultiprocessorCount, dev);
    hipFuncSetAttribute((const void*)mega_fwd, hipFuncAttributeMaxDynamicSharedMemorySize, LDS_BYTES);
    hipOccupancyMaxActiveBlocksPerMultiprocessor(&per_cu, (const void*)mega_fwd, 512, LDS_BYTES);
    if (per_cu < 1) per_cu = 1;
    grid = cus * per_cu;
    if (grid > 256) grid = 256;
    (void)hipGetLastError();
  }
  if (grid < 0) return;
  if (hipMemsetAsync((char*)d_ws + WS_BAR, 0, 16384, stream) != hipSuccess) { fprintf(stderr, "kernel_launch: memset of barrier words failed\n"); return; }
  Params p{};
  for (int i = 0; i < 16; ++i) p.in[i] = (const float*)d_in[i];
  p.X = (float*)d_out;
  p.ws = (unsigned char*)d_ws;
  void* args[] = {&p};
  hipError_t err = hipLaunchCooperativeKernel((const void*)mega_fwd, dim3(grid), dim3(512), args, LDS_BYTES, stream);
  if (err != hipSuccess) fprintf(stderr, "cooperative launch failed: %s (grid %d)\n", hipGetErrorString(err), grid);
}
```

```cpp
#include <hip/hip_runtime.h>
#include <hip/hip_cooperative_groups.h>
#include <cstdio>
#include <cstdint>
namespace cg = cooperative_groups;

typedef unsigned short bf16_t;
typedef short bf16x8 __attribute__((ext_vector_type(8)));
typedef float f32x4 __attribute__((ext_vector_type(4)));
typedef float f32x16 __attribute__((ext_vector_type(16)));
typedef unsigned u32x2 __attribute__((ext_vector_type(2)));
typedef unsigned u32x4 __attribute__((ext_vector_type(4)));

#define DEVI __device__ __forceinline__
#define NEG_INF (-__builtin_inff())

constexpr int SEQ = 8192, NTOK = 32768, DM = 1024;
constexpr float DN_ALPHA = 1.681792830507429f;

constexpr size_t MiB = 1024ull * 1024ull;
constexpr size_t WS_WT    = 4096;
constexpr size_t WT_LAYER = 24 * MiB;
constexpr size_t WS_WGD   = WS_WT + 4 * WT_LAYER;
constexpr size_t WS_XB    = WS_WGD + 65536;
constexpr size_t WS_AO    = WS_XB + 64 * MiB;
constexpr size_t WS_OV    = WS_AO + 64 * MiB;
constexpr size_t WS_KM    = WS_OV + 256 * MiB;
constexpr size_t WS_DEC   = WS_KM + 524288;
constexpr size_t WS_DSEG  = WS_DEC + 1 * MiB;
constexpr size_t WS_BAR   = WS_DSEG + 131072;
constexpr size_t WS_STATS = WS_BAR + 16384;
constexpr size_t WS_MR    = WS_STATS + 8 * MiB;
constexpr size_t WS_UV    = WS_MR + 524288;
constexpr size_t WS_UVP   = WS_UV + 262144;
constexpr size_t WS_END   = WS_UVP + 4 * MiB;
constexpr int UV_U_IN = 0, UV_V_IN = 3072, UV_U_F1 = 6144, UV_V_F1 = 10240, UV_U_GD = 14336, UV_V_GD = 14352;
constexpr size_t OV_H   = 0;
constexpr size_t OV_DVT = 192 * MiB;
constexpr size_t OV_MVT = 224 * MiB;
constexpr size_t OV_HG  = 0;
constexpr size_t OV_VT  = 128 * MiB;
constexpr size_t OV_KT  = 192 * MiB;
constexpr size_t OV_U   = 224 * MiB;

struct Params {
  const float* in[16];
  float* X;
  unsigned char* ws;
};

typedef __bf16 bf16x2_t __attribute__((ext_vector_type(2)));
DEVI unsigned pk_bf16(float lo, float hi) { bf16x2_t v = {(__bf16)lo, (__bf16)hi}; return __builtin_bit_cast(unsigned, v); }
DEVI bf16_t f2bf(float f) { return (bf16_t)(pk_bf16(f, 0.f) & 0xffffu); }
DEVI float bf2f(bf16_t v) { return __uint_as_float(((unsigned)v) << 16); }
DEVI float bflo(unsigned u) { return __uint_as_float(u << 16); }
DEVI float bfhi(unsigned u) { return __uint_as_float(u & 0xffff0000u); }
DEVI bf16x8 mk8(unsigned a, unsigned b, unsigned c, unsigned d) { u32x4 v = {a, b, c, d}; return __builtin_bit_cast(bf16x8, v); }
DEVI bf16x8 pack8(const f32x16& x, int s) {
  return s == 0 ? mk8(pk_bf16(x[0], x[1]), pk_bf16(x[2], x[3]), pk_bf16(x[4], x[5]), pk_bf16(x[6], x[7]))
                : mk8(pk_bf16(x[8], x[9]), pk_bf16(x[10], x[11]), pk_bf16(x[12], x[13]), pk_bf16(x[14], x[15]));
}
DEVI f32x16 mfma32(bf16x8 a, bf16x8 b, f32x16 c) { return __builtin_amdgcn_mfma_f32_32x32x16_bf16(a, b, c, 0, 0, 0); }
DEVI f32x4 mfma16(bf16x8 a, bf16x8 b, f32x4 c) { return __builtin_amdgcn_mfma_f32_16x16x32_bf16(a, b, c, 0, 0, 0); }
DEVI float ex2(float x) { return __builtin_amdgcn_exp2f(x); }

template <int X> DEVI float swz_xor(float v) { return __int_as_float(__builtin_amdgcn_ds_swizzle(__float_as_int(v), (X << 10) | 0x1f)); }
DEVI void halves(float v, float& lo, float& hi) {
  auto r = __builtin_amdgcn_permlane32_swap(__float_as_uint(v), __float_as_uint(v), false, false);
  lo = __uint_as_float(r[0]); hi = __uint_as_float(r[1]);
}
DEVI void halves_i(int v, int& lo, int& hi) {
  auto r = __builtin_amdgcn_permlane32_swap((unsigned)v, (unsigned)v, false, false);
  lo = (int)r[0]; hi = (int)r[1];
}
DEVI float hsum(float v) { float a, b; halves(v, a, b); return a + b; }
DEVI float hmax(float v) { float a, b; halves(v, a, b); return fmaxf(a, b); }
DEVI float sum16(float v) { v += swz_xor<1>(v); v += swz_xor<2>(v); v += swz_xor<4>(v); v += swz_xor<8>(v); return v; }
DEVI float sum64(float v) { v = sum16(v); v += swz_xor<16>(v); return hsum(v); }

DEVI u32x4 widen_pair(u32x2 a0, u32x2 a1, int h) {
  const unsigned sx = h ? a0[0] : a1[0], sy = h ? a0[1] : a1[1];
  const auto rx = __builtin_amdgcn_permlane32_swap(sx, sx, false, false);
  const auto ry = __builtin_amdgcn_permlane32_swap(sy, sy, false, false);
  const unsigned px = h ? rx[0] : rx[1], py = h ? ry[0] : ry[1];
  return h ? (u32x4){px, py, a1[0], a1[1]} : (u32x4){a0[0], a0[1], px, py};
}

DEVI u32x4 widen_pair16(u32x2 a0, u32x2 a1, int e) {
  const int sx = (int)(e ? a0[0] : a1[0]), sy = (int)(e ? a0[1] : a1[1]);
  const unsigned px = (unsigned)__builtin_amdgcn_ds_swizzle(sx, (16 << 10) | 0x1f), py = (unsigned)__builtin_amdgcn_ds_swizzle(sy, (16 << 10) | 0x1f);
  return e ? (u32x4){px, py, a1[0], a1[1]} : (u32x4){a0[0], a0[1], px, py};
}
DEVI int otid(int wv) { int t = wv * 64 + (int)__builtin_amdgcn_mbcnt_hi(~0u, __builtin_amdgcn_mbcnt_lo(~0u, 0u)); asm volatile("" : "+v"(t)); return t; }

constexpr double cexp_pos(double x) { double s = 1.0, t = 1.0; for (int i = 1; i < 100; ++i) { t *= x / i; s += t; } return s; }
constexpr float rope_inv(int p, int dim) { return (float)(1.0 / cexp_pos((2.0 * p / dim) * 9.210340371976184)); }
struct RopeTab { float d[32]; float m[64]; };
constexpr RopeTab make_rope_tab() { RopeTab t{}; for (int p = 0; p < 32; ++p) t.d[p] = rope_inv(p, 64); for (int p = 0; p < 64; ++p) t.m[p] = rope_inv(p, 128); return t; }
__device__ const RopeTab g_rope = make_rope_tab();

DEVI void sincos_f(float a, float& s, float& c) {
  float n = rintf(a * 0.636619772367581343f);
  float r = fmaf(-n, 1.5703125f, a);
  r = fmaf(-n, 4.837512969970703125e-4f, r);
  r = fmaf(-n, 7.54978995489188216e-8f, r);
  float r2 = r * r;
  float sp = r + r * r2 * (-1.66666667e-1f + r2 * (8.33333333e-3f + r2 * (-1.98412698e-4f + r2 * 2.75573192e-6f)));
  float cp = 1.f + r2 * (-0.5f + r2 * (4.16666667e-2f + r2 * (-1.38888889e-3f + r2 * (2.48015873e-5f + r2 * (-2.75573192e-7f)))));
  int q = ((int)n) & 3;
  float ss = (q & 1) ? cp : sp, cc = (q & 1) ? sp : cp;
  s = (q & 2) ? -ss : ss;
  c = ((q + 1) & 2) ? -cc : cc;
}

DEVI int perm_even(int c) {
  const int sec = c >> 9, cl = c & 511;
  if (sec == 0 || sec == 1) { const int mm = cl >> 6, j = cl & 63, second = j >> 5, p = j & 31; return sec * 512 + mm * 64 + (p >> 4) * 32 + second * 16 + (p & 15); }
  if (sec == 3 || sec == 4) { const int hh = cl >> 7, j = cl & 127, second = j >> 6, p = j & 63; return sec * 512 + hh * 128 + (p >> 4) * 32 + second * 16 + (p & 15); }
  return c;
}

DEVI int perm32_row(int c) {
  const int x = c & 31; return (c & ~31) + ((x >> 2) & 1) * 16 + (x >> 3) * 4 + (x & 3);
}
struct WJob { const float* W; int ldw; bf16_t* Wt; int K, k0, c0, perm; const float* gvec; const float* bvec; float* uvec; float* vvec; };
DEVI void wjob_load(const WJob& j, int t, f32x4& a, f32x4& b) {
  const float* src = j.W + (size_t)(j.k0 + (t >> 3)) * j.ldw + j.c0 + (t & 7) * 8;
  a = *(const f32x4*)src; b = *(const f32x4*)(src + 4);
}
DEVI void wtrans_tile(const WJob& jw, f32x4 a, f32x4 b, char* lds, int t) {
  bf16_t* Wt = jw.Wt; const int K = jw.K, k0 = jw.k0, c0 = jw.c0, perm = jw.perm;
  const float* gvec = jw.gvec; const float* bvec = jw.bvec; float* uvec = jw.uvec; float* vvec = jw.vvec;
  bf16_t* tl = (bf16_t*)lds;
  float* suw = (float*)(lds + 9216);
  const bool fold = gvec != nullptr;
  { const int kr = t >> 3, cc = (t & 7) * 8;
    if (fold) {
      const float gk = gvec[k0 + kr], bk = bvec[k0 + kr];
      float ua[8], va[8];
#pragma unroll
      for (int i = 0; i < 4; ++i) {
        const bf16_t ra = f2bf(a[i] * gk), rb = f2bf(b[i] * gk);
        tl[(cc + i) * 66 + kr] = ra; tl[(cc + 4 + i) * 66 + kr] = rb;
        ua[i] = bf2f(ra); ua[4 + i] = bf2f(rb); va[i] = a[i] * bk; va[4 + i] = b[i] * bk;
      }
#pragma unroll
      for (int i = 0; i < 8; ++i) {
        float x = ua[i], y = va[i];
        x += swz_xor<8>(x); y += swz_xor<8>(y);
        x += swz_xor<16>(x); y += swz_xor<16>(y);
        x = hsum(x); y = hsum(y);
        if ((t & 63) < 8) { suw[(t >> 6) * 128 + cc + i] = x; suw[(t >> 6) * 128 + 64 + cc + i] = y; }
      }
    } else {
#pragma unroll
      for (int i = 0; i < 4; ++i) { tl[(cc + i) * 66 + kr] = f2bf(a[i]); tl[(cc + 4 + i) * 66 + kr] = f2bf(b[i]); }
    } }
  __syncthreads();
  { const int c = t >> 3, kc = (t & 7) * 8;
    const unsigned* rp = (const unsigned*)(tl + c * 66 + kc);
    const u32x4 v = {rp[0], rp[1], rp[2], rp[3]};
    const int g = perm == 1 ? perm_even(c0 + c) : (perm == 2 || (perm == 3 && ((c0 + c) < 1024 || (c0 + c) >= 2048)) ? perm32_row(c0 + c) : (c0 + c));
    *(u32x4*)(Wt + (size_t)g * K + k0 + kc) = v; }
  if (fold && t < 128) {
    float acc = 0.f;
#pragma unroll
    for (int w8 = 0; w8 < 8; ++w8) acc += suw[w8 * 128 + t];
    const int c = t & 63;
    const int g = perm == 1 ? perm_even(c0 + c) : (perm == 2 || (perm == 3 && ((c0 + c) < 1024 || (c0 + c) >= 2048)) ? perm32_row(c0 + c) : (c0 + c));
    ((t < 64 ? uvec : vvec) + (size_t)(k0 >> 6) * 16384)[g] = acc;
  }
  __syncthreads();
}

DEVI void prologue(const Params& p, char* lds, int wv) {
  const int G = gridDim.x;
  unsigned char* ws = p.ws;
  auto decode = [&](int jb, WJob& j) {
    const int l = jb / 3072; int rem = jb % 3072;
    bf16_t* wl = (bf16_t*)(ws + WS_WT + (size_t)l * WT_LAYER);
    float* uv = (float*)(ws + WS_UVP) + (size_t)l * 16 * 16384;
    j.gvec = nullptr; j.bvec = nullptr; j.uvec = nullptr; j.vvec = nullptr;
    if (rem < 768) {
      const int kt = rem / 48, ct = rem % 48;
      j.K = 1024; j.k0 = kt * 64; j.c0 = ct * 64; j.Wt = wl;
      if (l & 1) { j.W = p.in[5] + (size_t)(l >> 1) * 1024 * 3088; j.ldw = 3088; j.perm = 3; j.gvec = p.in[14] + (l - 1) * 1024; j.bvec = p.in[15] + (l - 1) * 1024; j.uvec = uv + UV_U_IN; j.vvec = uv + UV_V_IN; }
      else       { j.W = p.in[1] + (size_t)(l >> 1) * 1024 * 3072; j.ldw = 3072; j.perm = 1; }
    } else if (rem < 1024) {
      rem -= 768; const int kt = rem / 16, ct = rem % 16;
      j.W = (l & 1) ? p.in[9] + (size_t)(l >> 1) * 1024 * 1024 : p.in[4] + (size_t)(l >> 1) * 1024 * 1024;
      j.ldw = 1024; j.Wt = wl + 3 * 1024 * 1024; j.K = 1024; j.k0 = kt * 64; j.c0 = ct * 64; j.perm = 2;
    } else if (rem < 2048) {
      rem -= 1024; const int kt = rem / 64, ct = rem % 64;
      j.W = p.in[12] + (size_t)l * 1024 * 4096; j.ldw = 4096; j.Wt = wl + 4 * 1024 * 1024; j.K = 1024; j.k0 = kt * 64; j.c0 = ct * 64; j.perm = 2;
      j.gvec = p.in[10] + l * 1024; j.bvec = p.in[11] + l * 1024; j.uvec = uv + UV_U_F1; j.vvec = uv + UV_V_F1;
    } else {
      rem -= 2048; const int kt = rem / 16, ct = rem % 16;
      j.W = p.in[13] + (size_t)l * 4096 * 1024; j.ldw = 1024; j.Wt = wl + 8 * 1024 * 1024; j.K = 4096; j.k0 = kt * 64; j.c0 = ct * 64; j.perm = 2;
    }
  };
  { const int tw = otid(wv);
    int jb = blockIdx.x;
    WJob cur{}, nxt{}; f32x4 ca = {}, cbv = {}, na = {}, nb = {};
    if (jb < 4 * 3072) { decode(jb, cur); wjob_load(cur, tw, ca, cbv); }
#pragma unroll 1
    while (jb < 4 * 3072) {
      const int jn = jb + G;
      if (jn < 4 * 3072) { decode(jn, nxt); wjob_load(nxt, tw, na, nb); }
      wtrans_tile(cur, ca, cbv, lds, tw);
      cur = nxt; ca = na; cbv = nb; jb = jn;
    } }
  const int gt = blockIdx.x * 512 + otid(wv), GT = G * 512;
  { const int t = otid(wv); const int gw = blockIdx.x * 8 + (t >> 6), lane = t & 63;
    if (gw < 32) {
      const int o = gw >> 4, rr = gw & 15, lsrc = 2 * o;
      const float* gv = p.in[14] + lsrc * 1024; const float* bv = p.in[15] + lsrc * 1024;
      float us = 0.f, vs = 0.f;
      for (int k = lane; k < 1024; k += 64) {
        const float wgt = p.in[5][(size_t)o * 1024 * 3088 + (size_t)k * 3088 + 3072 + rr];
        const bf16_t rb = f2bf(wgt * gv[k]);
        ((bf16_t*)(ws + WS_WGD))[(o * 16 + rr) * 1024 + k] = rb;
        us += bf2f(rb); vs += wgt * bv[k];
      }
      us = sum64(us); vs = sum64(vs);
      if (lane == 0) { float* uv = (float*)(ws + WS_UV) + (size_t)(2 * o + 1) * 16384; uv[UV_U_GD + rr] = us; uv[UV_V_GD + rr] = vs; }
    } }
  for (int i = gt; i < 131072; i += GT) ((float*)(ws + WS_KM))[i] = 0.f;
  for (int i = gt; i < NTOK * DM / 8; i += 4 * GT) {
    f32x4 a[4], b[4];
#pragma unroll
    for (int k = 0; k < 4; ++k) { if (i + k * GT < NTOK * DM / 8) { const size_t e8 = (size_t)(i + k * GT) * 8; a[k] = *(const f32x4*)(p.in[0] + e8); b[k] = *(const f32x4*)(p.in[0] + e8 + 4); } }
#pragma unroll
    for (int k = 0; k < 4; ++k) {
      if (i + k * GT < NTOK * DM / 8) {
        u32x4 v = {pk_bf16(a[k][0], a[k][1]), pk_bf16(a[k][2], a[k][3]), pk_bf16(b[k][0], b[k][1]), pk_bf16(b[k][2], b[k][3])};
        *(u32x4*)((bf16_t*)(ws + WS_XB) + (size_t)(i + k * GT) * 8) = v;
      }
    }
  }
}

#define LAS __attribute__((address_space(3)))
constexpr int BM = 256, BK = 64, HALF = 128, HTB = HALF * BK * 2, NXCD = 8, WGM = 4;
DEVI int lds_byte(int r, int c) { const int st = (r >> 4) * 2 + (c >> 5), rr = r & 15, cc = c & 31, ob = rr * 64 + cc * 2; return st * 1024 + (ob ^ (((ob >> 9) & 1) << 5)); }
DEVI void stage_rc(int b, int& R, int& C) { const int st = b / 1024, sb = b % 1024, swz = sb ^ (((sb >> 9) & 1) << 5); R = (st >> 1) * 16 + swz / 64; C = (st & 1) * 32 + (swz % 64) / 2; }

enum { EPI_EVEN = 0, EPI_GLA = 1, EPI_RES = 2, EPI_FFN1 = 3 };
struct EpiArgs {
  int kind;
  bf16_t* H; bf16_t* vt0; bf16_t* vt1; float* kmsum;
  bf16_t* Hff;
  const float* stat_in; const float* u; const float* v;
  bf16_t* Y; float* X;
  const float* stat_prev; const float* gprev; const float* bprev;
  float* stat_new; int final_out;
};
DEVI void row_sums(const float* raw, int row, float& s1, float& s2) {
  typedef float f32x2 __attribute__((ext_vector_type(2)));
  float a1 = 0.f, a2 = 0.f;
#pragma unroll
  for (int k = 0; k < 16; ++k) { const f32x2 p = *(const f32x2*)(raw + (size_t)k * 65536 + 2 * row); a1 += p[0]; a2 += p[1]; }
  s1 = a1; s2 = a2;
}
DEVI void stat_finalize(const float* raw, float* mr, int wv) {
  for (int row = blockIdx.x * 512 + otid(wv); row < NTOK; row += gridDim.x * 512) {
    float s1, s2; row_sums(raw, row, s1, s2);
    const float mu = s1 * (1.f / 1024.f);
    const float var = fmaxf(s2 * (1.f / 1024.f) - mu * mu, 0.f);
    mr[2 * row] = mu; mr[2 * row + 1] = rsqrtf(var + 1e-5f);
  }
}
DEVI void row_mu_rstd(const float* mr, int row, float& mu, float& rstd) { mu = mr[2 * row]; rstd = mr[2 * row + 1]; }
struct Unit { int brow, bcol, swap; };

DEVI bool unit_next(int i, int nN, int kind, Unit& u) {
  const int nM = NTOK / BM, nwg = nM * nN;
  const long L = (long)i * gridDim.x + blockIdx.x;
  if (L >= nwg) return false;
  int wgid = (int)L;
  { const int q = nwg / NXCD, r = nwg % NXCD, xcd = wgid % NXCD, off = wgid / NXCD; wgid = (xcd < r ? xcd * (q + 1) : r * (q + 1) + (xcd - r) * q) + off; }
  const int nig = WGM * nN, gid = wgid / nig, fm = gid * WGM, gsz = (nM - fm) < WGM ? (nM - fm) : WGM;
  const int pm = fm + ((wgid % nig) % gsz), pn = (wgid % nig) / gsz;
  u.brow = pm * BM; u.bcol = pn * BM;
  const int sec = u.bcol >> 9;
  u.swap = (kind == EPI_EVEN && (sec == 2 || sec == 5)) || (kind == EPI_GLA && (sec == 2 || sec == 3));
  return true;
}

DEVI void acc_init(f32x4 (&acc)[2][2][4][2], const Unit& un, int wr, int wc, int fr, int fq, const EpiArgs& e) {
  if (!e.stat_in) {
#pragma unroll
    for (int a = 0; a < 2; ++a)
#pragma unroll
      for (int b = 0; b < 2; ++b)
#pragma unroll
        for (int m = 0; m < 4; ++m)
#pragma unroll
          for (int n = 0; n < 2; ++n) acc[a][b][m][n] = (f32x4){0.f, 0.f, 0.f, 0.f};
  } else if (!un.swap) {
    float nmu[8];
#pragma unroll
    for (int q = 0; q < 8; ++q) nmu[q] = -e.stat_in[2 * (un.brow + (q >> 2) * 128 + wr * 64 + (q & 3) * 16 + fr)];
#pragma unroll
    for (int bj = 0; bj < 2; ++bj)
#pragma unroll
      for (int n = 0; n < 2; ++n) {
        const f32x4 u4 = *(const f32x4*)(e.u + un.bcol + bj * 128 + wc * 32 + n * 16 + 4 * fq);
#pragma unroll
        for (int q = 0; q < 8; ++q) acc[q >> 2][bj][q & 3][n] = u4 * nmu[q];
      }
  } else {
    float uc[8];
#pragma unroll
    for (int q = 0; q < 8; ++q) uc[q] = e.u[un.bcol + (q >> 2) * 128 + wr * 64 + (q & 3) * 16 + fr];
#pragma unroll
    for (int bj = 0; bj < 2; ++bj)
#pragma unroll
      for (int n = 0; n < 2; ++n) {
        const int tok = un.brow + bj * 128 + wc * 32 + n * 16 + 4 * fq;
        const f32x4 sa = *(const f32x4*)(e.stat_in + 2 * tok), sb = *(const f32x4*)(e.stat_in + 2 * tok + 4);
        const f32x4 nmu = {-sa[0], -sa[2], -sb[0], -sb[2]};
#pragma unroll
        for (int q = 0; q < 8; ++q) acc[q >> 2][bj][q & 3][n] = nmu * uc[q];
      }
  }
}
DEVI float row_rstd(const float* mr, int row) { return mr[2 * row + 1]; }
DEVI f32x4 rstd4(const float* mr, int tok) {
  const f32x4 sa = *(const f32x4*)(mr + 2 * tok), sb = *(const f32x4*)(mr + 2 * tok + 4);
  return (f32x4){sa[1], sa[3], sb[1], sb[3]};
}

template <bool FOLD>
DEVI void epi_vt(const f32x4 (&acc)[2][2][4][2], bf16_t* vt, int chan0, int tok0, int nchan, int wr, int wc, int fr, int fq, const EpiArgs& e, int gcol0) {
  const int b = tok0 >> 13, s0 = tok0 & 8191;
  f32x4 rs[2][2];
#pragma unroll
  for (int bj = 0; bj < 2; ++bj)
#pragma unroll
    for (int n = 0; n < 2; ++n) { if (FOLD) rs[bj][n] = rstd4(e.stat_in, tok0 + bj * 128 + wc * 32 + n * 16 + 4 * fq); else rs[bj][n] = (f32x4){1.f, 1.f, 1.f, 1.f}; }
  float vcs[8];
#pragma unroll
  for (int q = 0; q < 8; ++q) { if (FOLD) vcs[q] = e.v[gcol0 + (q >> 2) * 128 + wr * 64 + (q & 3) * 16 + fr]; else vcs[q] = 0.f; }
#pragma unroll
  for (int ai = 0; ai < 2; ++ai)
#pragma unroll
    for (int m = 0; m < 4; ++m) {
      bf16_t* rowp = (bf16_t*)((char*)vt + ((unsigned)(b * nchan + chan0 + ai * 128 + wr * 64 + m * 16 + fr) * 8192u + (unsigned)(s0 + wc * 32 + 4 * fq)) * 2u);
      const float vc = vcs[ai * 4 + m];
      const int e1 = fq & 1;
#pragma unroll
      for (int bj = 0; bj < 2; ++bj) {
        const f32x4 v0 = acc[ai][bj][m][0] * rs[bj][0] + vc, v1 = acc[ai][bj][m][1] * rs[bj][1] + vc;
        const u32x2 a0 = {pk_bf16(v0[0], v0[1]), pk_bf16(v0[2], v0[3])}, a1 = {pk_bf16(v1[0], v1[1]), pk_bf16(v1[2], v1[3])};
        *(u32x4*)(rowp + bj * 128 + (e1 ? 12 : 0)) = widen_pair16(a0, a1, e1);
      }
    }
}

DEVI void epi_even(const f32x4 (&acc)[2][2][4][2], const Unit& u, int wr, int wc, int fr, int fq, const EpiArgs& e) {
  const int sec = u.bcol >> 9;
  if (u.swap) { epi_vt<false>(acc, sec == 2 ? e.vt0 : e.vt1, u.bcol & 511, u.brow, 512, wr, wc, fr, fq, e, u.bcol); return; }
  const bool moba = sec >= 3;
  const int b = u.brow >> 13, sb = u.brow & 8191;
#pragma unroll
  for (int bj = 0; bj < 2; ++bj) {
    const int gl = (u.bcol & 511) + bj * 128 + wc * 32;
    int p0, c1, half;
    if (!moba) { const int mm = gl >> 6, grp = (gl >> 5) & 1; p0 = grp * 16 + 4 * fq; c1 = sec * 512 + mm * 64 + p0; half = 32; }
    else       { const int hh = gl >> 7, grp = (gl >> 5) & 3; p0 = grp * 16 + 4 * fq; c1 = sec * 512 + hh * 128 + p0; half = 64; }
    const f32x4 inv = moba ? *(const f32x4*)(g_rope.m + p0) : *(const f32x4*)(g_rope.d + p0);
    f32x4 ks1 = {0.f, 0.f, 0.f, 0.f}, ks2 = {0.f, 0.f, 0.f, 0.f};
#pragma unroll
    for (int ai = 0; ai < 2; ++ai)
#pragma unroll
      for (int m = 0; m < 4; ++m) {
        const int row = u.brow + ai * 128 + wr * 64 + m * 16 + fr;
        const float pos = (float)(row & 8191);
        const f32x4 x1 = acc[ai][bj][m][0], x2 = acc[ai][bj][m][1];
        f32x4 y1, y2;
#pragma unroll
        for (int j = 0; j < 4; ++j) {
          float sn, cs; sincos_f(pos * inv[j], sn, cs);
          y1[j] = x1[j] * cs - x2[j] * sn; y2[j] = x2[j] * cs + x1[j] * sn;
        }
        u32x2 w1 = {pk_bf16(y1[0], y1[1]), pk_bf16(y1[2], y1[3])}, w2 = {pk_bf16(y2[0], y2[1]), pk_bf16(y2[2], y2[3])};
        const int e1 = fq & 1;
        const unsigned hoff = (unsigned)row * 6144u + (unsigned)(e1 ? c1 - 4 + half : c1) * 2u;
        *(u32x4*)((char*)e.H + hoff) = widen_pair16(w1, w2, e1);
        ks1 += y1; ks2 += y2;
        __builtin_amdgcn_sched_barrier(0);
      }
    if (sec == 4) {
#pragma unroll
      for (int j = 0; j < 4; ++j) {
        float a = ks1[j], c = ks2[j];
        a = sum16(a); c = sum16(c);
        if (fr == 0) {
          float* kp = e.kmsum + (size_t)(b * 32 + (sb >> 8)) * 512 + (c1 - 2048) + j;
          atomicAdd(kp, a); atomicAdd(kp + 64, c);
        }
      }
    }
  }
}

DEVI void epi_gla(const f32x4 (&acc)[2][2][4][2], const Unit& u, int wr, int wc, int fr, int fq, const EpiArgs& e) {
  if (u.swap) { epi_vt<true>(acc, e.vt0, u.bcol - 1024, u.brow, 1024, wr, wc, fr, fq, e, u.bcol); return; }
  const int cb = (u.bcol < 1024) ? u.bcol : u.bcol - 1024;
  f32x4 v4[2][2];
#pragma unroll
  for (int bj = 0; bj < 2; ++bj)
#pragma unroll
    for (int n = 0; n < 2; ++n) v4[bj][n] = *(const f32x4*)(e.v + u.bcol + bj * 128 + wc * 32 + n * 16 + 4 * fq);
  float rsq[8];
#pragma unroll
  for (int q = 0; q < 8; ++q) rsq[q] = row_rstd(e.stat_in, u.brow + (q >> 2) * 128 + wr * 64 + (q & 3) * 16 + fr);
#pragma unroll
  for (int ai = 0; ai < 2; ++ai)
#pragma unroll
    for (int m = 0; m < 4; ++m) {
      bf16_t* rowp = (bf16_t*)((char*)e.H + ((unsigned)(u.brow + ai * 128 + wr * 64 + m * 16 + fr) * 2048u + (unsigned)(cb + wc * 32 + 8 * fq)) * 2u);
      const float rsr = rsq[ai * 4 + m];
#pragma unroll
      for (int bj = 0; bj < 2; ++bj) {
        const f32x4 v0 = acc[ai][bj][m][0] * rsr + v4[bj][0], v1 = acc[ai][bj][m][1] * rsr + v4[bj][1];
        u32x4 w4 = {pk_bf16(v0[0], v0[1]), pk_bf16(v0[2], v0[3]), pk_bf16(v1[0], v1[1]), pk_bf16(v1[2], v1[3])};
        *(u32x4*)(rowp + bj * 128) = w4;
      }
    }
}

DEVI void epi_res(const f32x4 (&acc)[2][2][4][2], const Unit& u, int wr, int wc, int fr, int fq, const EpiArgs& e) {
  float mus[8], rsd[8]; f32x4 g4[2][2], b4[2][2];
  const bool ln = e.stat_prev != nullptr;
  if (ln) {
#pragma unroll
    for (int q = 0; q < 8; ++q) row_mu_rstd(e.stat_prev, u.brow + (q >> 2) * 128 + wr * 64 + (q & 3) * 16 + fr, mus[q], rsd[q]);
#pragma unroll
    for (int bj = 0; bj < 2; ++bj)
#pragma unroll
      for (int n = 0; n < 2; ++n) {
        const int c = u.bcol + bj * 128 + wc * 32 + 8 * fq + 4 * n;
        g4[bj][n] = *(const f32x4*)(e.gprev + c); b4[bj][n] = *(const f32x4*)(e.bprev + c);
      }
  } else {
#pragma unroll
    for (int q = 0; q < 8; ++q) { mus[q] = 0.f; rsd[q] = 1.f; }
#pragma unroll
    for (int bj = 0; bj < 2; ++bj)
#pragma unroll
      for (int n = 0; n < 2; ++n) { g4[bj][n] = (f32x4){1.f, 1.f, 1.f, 1.f}; b4[bj][n] = (f32x4){0.f, 0.f, 0.f, 0.f}; }
  }
#pragma unroll
  for (int ai = 0; ai < 2; ++ai)
#pragma unroll
    for (int m = 0; m < 4; ++m) {
      const int row = u.brow + ai * 128 + wr * 64 + m * 16 + fr;
      const unsigned o0 = (unsigned)row * 1024u + (unsigned)(u.bcol + wc * 32 + 8 * fq);
      const float mu = mus[ai * 4 + m], rstd = rsd[ai * 4 + m];
      u32x4 rb[2];
#pragma unroll
      for (int bj = 0; bj < 2; ++bj) rb[bj] = *(const u32x4*)((const char*)e.Y + (o0 + bj * 128) * 2u);
      float s1 = 0.f, s2 = 0.f;
#pragma unroll
      for (int bj = 0; bj < 2; ++bj) {
        const unsigned o = o0 + bj * 128;
        f32x4 r0 = {bflo(rb[bj][0]), bfhi(rb[bj][0]), bflo(rb[bj][1]), bfhi(rb[bj][1])};
        f32x4 r1 = {bflo(rb[bj][2]), bfhi(rb[bj][2]), bflo(rb[bj][3]), bfhi(rb[bj][3])};
        r0 = (r0 - mu) * rstd * g4[bj][0] + b4[bj][0];
        r1 = (r1 - mu) * rstd * g4[bj][1] + b4[bj][1];
        const f32x4 y0 = r0 * DN_ALPHA + acc[ai][bj][m][0], y1 = r1 * DN_ALPHA + acc[ai][bj][m][1];
        u32x4 w4 = {pk_bf16(y0[0], y0[1]), pk_bf16(y0[2], y0[3]), pk_bf16(y1[0], y1[1]), pk_bf16(y1[2], y1[3])};
        *(u32x4*)((char*)e.Y + o * 2u) = w4;
        if (e.final_out) { *(f32x4*)((char*)e.X + o * 4u) = y0; *(f32x4*)((char*)e.X + o * 4u + 16) = y1; }
        s1 += ((y0[0] + y0[1]) + (y0[2] + y0[3])) + ((y1[0] + y1[1]) + (y1[2] + y1[3]));
        s2 += ((y0[0] * y0[0] + y0[1] * y0[1]) + (y0[2] * y0[2] + y0[3] * y0[3])) + ((y1[0] * y1[0] + y1[1] * y1[1]) + (y1[2] * y1[2] + y1[3] * y1[3]));
      }
      s1 += swz_xor<16>(s1); s2 += swz_xor<16>(s2);
      s1 = hsum(s1); s2 = hsum(s2);
      if (fq == 0) { float* sp = e.stat_new + (size_t)((u.bcol >> 8) * 4 + wc) * 65536 + 2 * row; sp[0] = s1; sp[1] = s2; }
    }
}

DEVI void epi_ffn1(const f32x4 (&acc)[2][2][4][2], const Unit& u, int wr, int wc, int fr, int fq, const EpiArgs& e) {
  float rs[8]; f32x4 v4[2][2];
#pragma unroll
  for (int q = 0; q < 8; ++q) rs[q] = row_rstd(e.stat_in, u.brow + (q >> 2) * 128 + wr * 64 + (q & 3) * 16 + fr);
#pragma unroll
  for (int bj = 0; bj < 2; ++bj)
#pragma unroll
    for (int n = 0; n < 2; ++n) v4[bj][n] = *(const f32x4*)(e.v + u.bcol + bj * 128 + wc * 32 + n * 16 + 4 * fq);
#pragma unroll
  for (int ai = 0; ai < 2; ++ai)
#pragma unroll
    for (int m = 0; m < 4; ++m) {
      bf16_t* rowp = (bf16_t*)((char*)e.Hff + ((unsigned)(u.brow + ai * 128 + wr * 64 + m * 16 + fr) * 4096u + (unsigned)(u.bcol + wc * 32 + 8 * fq)) * 2u);
      const float rsr = rs[ai * 4 + m];
#pragma unroll
      for (int bj = 0; bj < 2; ++bj) {
        f32x4 v0 = acc[ai][bj][m][0] * rsr + v4[bj][0], v1 = acc[ai][bj][m][1] * rsr + v4[bj][1];
#pragma unroll
        for (int j = 0; j < 4; ++j) { const float t0 = fmaxf(v0[j], 0.f), t1 = fmaxf(v1[j], 0.f); v0[j] = t0 * t0; v1[j] = t1 * t1; }
        u32x4 w4 = {pk_bf16(v0[0], v0[1]), pk_bf16(v0[2], v0[3]), pk_bf16(v1[0], v1[1]), pk_bf16(v1[2], v1[3])};
        *(u32x4*)(rowp + bj * 128) = w4;
      }
    }
}

extern __shared__ __attribute__((aligned(16))) unsigned char g_lds[];

DEVI void gemm_phase(const bf16_t* A, const bf16_t* Bt, int N, int K, const EpiArgs& e, int wv) {
  LAS unsigned char* lds = (LAS unsigned char*)g_lds;
  const int tid = otid(wv), wid = __builtin_amdgcn_readfirstlane(tid >> 6), lane = tid & 63, wr = wid >> 2, wc = wid & 3, fr = lane & 15, fq = lane >> 4;
  const int nt = K / BK, nN = N / BM;
  unsigned voff[2];
#pragma unroll
  for (int i = 0; i < 2; ++i) { int R, C; stage_rc(tid * 16 + i * 8192, R, C); voff[i] = (unsigned)(R * K + C) * 2u; }
  const size_t kstep = (size_t)(BK * 2);
  const size_t hstep = (size_t)HALF * K * 2;
  const size_t tstep = 2 * hstep;
  const unsigned ldsw = (unsigned)wid * 1024u;
  const int aoff = lds_byte(wr * 64 + fr, fq * 8), boff = lds_byte(wc * 32 + fr, fq * 8);
#define PG8_SA(b, h) (((b) * 2 + (h)) * HTB)
#define PG8_SB(b, h) ((4 + (b) * 2 + (h)) * HTB)
#define PG8_STAGE(bufoff, gbase) do { _Pragma("unroll") for (int _i = 0; _i < 2; ++_i) \
    __builtin_amdgcn_global_load_lds((const unsigned*)((const char*)(gbase) + voff[_i]), (LAS unsigned*)(lds + (bufoff) + ldsw + _i * 8192), 16, 0, 0); } while (0)
#define PG8_LDA(dst, b, h) do { _Pragma("unroll") for (int m = 0; m < 4; ++m) _Pragma("unroll") for (int k = 0; k < 2; ++k) dst[m][k] = *(const LAS bf16x8*)(lds + PG8_SA(b, h) + aoff + m * 2048 + k * 1024); } while (0)
#define PG8_LDB(dst, b, h) do { _Pragma("unroll") for (int n = 0; n < 2; ++n) _Pragma("unroll") for (int k = 0; k < 2; ++k) dst[n][k] = *(const LAS bf16x8*)(lds + PG8_SB(b, h) + boff + n * 2048 + k * 1024); } while (0)
#define PG8_MMA(ai, bj, At, Bt_) do { __builtin_amdgcn_s_setprio(1); _Pragma("unroll") for (int m = 0; m < 4; ++m) _Pragma("unroll") for (int n = 0; n < 2; ++n) _Pragma("unroll") for (int k = 0; k < 2; ++k) \
    acc[ai][bj][m][n] = __builtin_amdgcn_mfma_f32_16x16x32_bf16(Bt_[n][k], At[m][k], acc[ai][bj][m][n], 0, 0, 0); __builtin_amdgcn_s_setprio(0); } while (0)
#define PG8_WAIT_V(n) asm volatile("s_waitcnt vmcnt(" #n ")" ::: "memory")
#define PG8_WAIT_L(n) asm volatile("s_waitcnt lgkmcnt(" #n ")" ::: "memory")
#define PG8_BAR __builtin_amdgcn_s_barrier()
#define PG8_SCHED __builtin_amdgcn_sched_barrier(0)
#define UNIT_P(u) ((const char*)((u).swap ? Bt : A) + (size_t)(((u).swap ? (u).bcol : (u).brow) >> 8) * tstep)
#define UNIT_Q(u) ((const char*)((u).swap ? A : Bt) + (size_t)(((u).swap ? (u).brow : (u).bcol) >> 8) * tstep)
  Unit cur, nxt; int ui = 0;
  if (!unit_next(0, nN, e.kind, cur)) return;
  f32x4 acc[2][2][4][2];
  acc_init(acc, cur, wr, wc, fr, fq, e);
  bf16x8 At[4][2], B0[2][2], B1[2][2];
  const char* cA = UNIT_P(cur); const char* cB = UNIT_Q(cur);
  PG8_STAGE(PG8_SB(0, 0), cB); PG8_STAGE(PG8_SB(0, 1), cB + hstep); PG8_STAGE(PG8_SA(0, 0), cA); PG8_STAGE(PG8_SA(0, 1), cA + hstep);
  if (wr == 1) PG8_BAR;
  PG8_WAIT_V(2); PG8_BAR;
  PG8_STAGE(PG8_SB(1, 0), cB + kstep); PG8_STAGE(PG8_SA(1, 0), cA + kstep); PG8_STAGE(PG8_SB(1, 1), cB + hstep + kstep);
  PG8_WAIT_V(6); PG8_BAR;
  for (;;) {
    const bool has_next = unit_next(ui + 1, nN, e.kind, nxt);
    const char* nA = has_next ? UNIT_P(nxt) : cA; const char* nB = has_next ? UNIT_Q(nxt) : cB;
#pragma unroll 1
    for (int t = 0; t < nt; t += 2) {
      const bool last = (t == nt - 2);
      const char* a1 = cA + (size_t)(t + 1) * kstep;
      const char* a2 = last ? nA : cA + (size_t)(t + 2) * kstep; const char* b2 = last ? nB : cB + (size_t)(t + 2) * kstep;
      const char* a3 = a2 + kstep; const char* b3 = b2 + kstep;
      PG8_LDB(B0, 0, 0); PG8_LDB(B1, 0, 1); PG8_SCHED; PG8_LDA(At, 0, 0); PG8_STAGE(PG8_SA(1, 1), a1 + hstep);
      PG8_WAIT_V(8); PG8_WAIT_L(0); PG8_BAR; PG8_MMA(0, 0, At, B0); PG8_MMA(0, 1, At, B1); PG8_BAR; PG8_SCHED;
      PG8_LDA(At, 0, 1); PG8_STAGE(PG8_SB(0, 0), b2); PG8_STAGE(PG8_SB(0, 1), b2 + hstep); PG8_STAGE(PG8_SA(0, 0), a2);
      PG8_WAIT_V(8); PG8_WAIT_L(0); PG8_BAR; PG8_MMA(1, 0, At, B0); PG8_MMA(1, 1, At, B1); PG8_BAR; PG8_SCHED;
      PG8_LDB(B0, 1, 0); PG8_LDB(B1, 1, 1); PG8_SCHED; PG8_LDA(At, 1, 0); PG8_STAGE(PG8_SA(0, 1), a2 + hstep);
      PG8_WAIT_V(8); PG8_WAIT_L(0); PG8_BAR; PG8_MMA(0, 0, At, B0); PG8_MMA(0, 1, At, B1); PG8_BAR; PG8_SCHED;
      PG8_LDA(At, 1, 1); PG8_STAGE(PG8_SB(1, 0), b3); PG8_STAGE(PG8_SB(1, 1), b3 + hstep); PG8_STAGE(PG8_SA(1, 0), a3);
      PG8_WAIT_V(8); PG8_WAIT_L(0); PG8_BAR; PG8_MMA(1, 0, At, B0); PG8_MMA(1, 1, At, B1); PG8_BAR; PG8_SCHED;
    }
    if (wr == 0) PG8_BAR;
    {
      const int tid_e = otid(wv);
      const int wid_e = __builtin_amdgcn_readfirstlane(tid_e >> 6), lane_e = tid_e & 63;
      const int wr_e = wid_e >> 2, wc_e = wid_e & 3, fr_e = lane_e & 15, fq_e = lane_e >> 4;
      if (e.kind == EPI_EVEN) epi_even(acc, cur, wr_e, wc_e, fr_e, fq_e, e);
      else if (e.kind == EPI_GLA) epi_gla(acc, cur, wr_e, wc_e, fr_e, fq_e, e);
      else if (e.kind == EPI_RES) epi_res(acc, cur, wr_e, wc_e, fr_e, fq_e, e);
      else epi_ffn1(acc, cur, wr_e, wc_e, fr_e, fq_e, e);
    }
    if (!has_next) break;
    cur = nxt; cA = nA; cB = nB; ++ui;
    { const int tid_i = otid(wv); const int wid_i = __builtin_amdgcn_readfirstlane(tid_i >> 6), lane_i = tid_i & 63;
      acc_init(acc, cur, wid_i >> 2, wid_i & 3, lane_i & 15, lane_i >> 4, e); }
    if (wr == 1) PG8_BAR;
  }
  PG8_WAIT_V(0);
  PG8_BAR;
#undef PG8_SA
#undef PG8_SB
#undef PG8_STAGE
#undef PG8_LDA
#undef PG8_LDB
#undef PG8_MMA
}

DEVI void ln_phase(float* X, bf16_t* XB, const float* g, const float* bt, bool final_out, int wv) {
  const int tidl = otid(wv); const int w = tidl >> 6, lane = tidl & 63;
  const int stride = gridDim.x * 8;
  int row = blockIdx.x * 8 + w;
  f32x4 v[4], vn[4];
  if (row < NTOK) {
#pragma unroll
    for (int i = 0; i < 4; ++i) v[i] = *(const f32x4*)(X + (size_t)row * 1024 + i * 256 + lane * 4);
  }
  for (; row < NTOK; row += stride) {
    float* xr = X + (size_t)row * 1024;
    if (row + stride < NTOK) {
#pragma unroll
      for (int i = 0; i < 4; ++i) vn[i] = *(const f32x4*)(X + (size_t)(row + stride) * 1024 + i * 256 + lane * 4);
    }
    float s = 0.f;
#pragma unroll
    for (int i = 0; i < 4; ++i) s += (v[i][0] + v[i][1]) + (v[i][2] + v[i][3]);
    s = sum64(s);
    const float mu = s * (1.f / 1024.f);
    float q = 0.f;
#pragma unroll
    for (int i = 0; i < 4; ++i) { const f32x4 d = v[i] - mu; q += (d[0] * d[0] + d[1] * d[1]) + (d[2] * d[2] + d[3] * d[3]); }
    q = sum64(q);
    const float rstd = rsqrtf(q * (1.f / 1024.f) + 1e-5f);
#pragma unroll
    for (int i = 0; i < 4; ++i) {
      const int c = i * 256 + lane * 4;
      const f32x4 gg = *(const f32x4*)(g + c), bb = *(const f32x4*)(bt + c);
      const f32x4 y = (v[i] - mu) * rstd * gg + bb;
      if (final_out) *(f32x4*)(xr + c) = y;
      else { u32x2 pkd = {pk_bf16(y[0], y[1]), pk_bf16(y[2], y[3])}; *(u32x2*)(XB + (size_t)row * 1024 + c) = pkd; }
    }
#pragma unroll
    for (int i = 0; i < 4; ++i) v[i] = vn[i];
  }
}

DEVI void ln_bf16_phase(const bf16_t* Y, bf16_t* XN, const float* g, const float* bt, int wv) {
  const int tidl = otid(wv); const int w = tidl >> 6, lane = tidl & 63;
  const int stride = gridDim.x * 8;
  int row = blockIdx.x * 8 + w;
  u32x4 ra = {}, rb = {}, na = {}, nb = {};
  if (row < NTOK) { ra = *(const u32x4*)(Y + (size_t)row * 1024 + lane * 8); rb = *(const u32x4*)(Y + (size_t)row * 1024 + 512 + lane * 8); }
  for (; row < NTOK; row += stride, ra = na, rb = nb) {
    if (row + stride < NTOK) { na = *(const u32x4*)(Y + (size_t)(row + stride) * 1024 + lane * 8); nb = *(const u32x4*)(Y + (size_t)(row + stride) * 1024 + 512 + lane * 8); }
    float v[16];
#pragma unroll
    for (int i = 0; i < 4; ++i) { v[2 * i] = bflo(ra[i]); v[2 * i + 1] = bfhi(ra[i]); v[8 + 2 * i] = bflo(rb[i]); v[8 + 2 * i + 1] = bfhi(rb[i]); }
    float sacc = 0.f;
#pragma unroll
    for (int i = 0; i < 16; ++i) sacc += v[i];
    sacc = sum64(sacc);
    const float mu = sacc * (1.f / 1024.f);
    float q = 0.f;
#pragma unroll
    for (int i = 0; i < 16; ++i) { const float d = v[i] - mu; q += d * d; }
    q = sum64(q);
    const float rstd = rsqrtf(q * (1.f / 1024.f) + 1e-5f);
#pragma unroll
    for (int hf = 0; hf < 2; ++hf) {
      const int c = hf * 512 + lane * 8;
      const f32x4 g0 = *(const f32x4*)(g + c), g1 = *(const f32x4*)(g + c + 4), b0 = *(const f32x4*)(bt + c), b1 = *(const f32x4*)(bt + c + 4);
      float y[8];
#pragma unroll
      for (int i = 0; i < 4; ++i) { y[i] = (v[hf * 8 + i] - mu) * rstd * g0[i] + b0[i]; y[4 + i] = (v[hf * 8 + 4 + i] - mu) * rstd * g1[i] + b1[i]; }
      u32x4 o = {pk_bf16(y[0], y[1]), pk_bf16(y[2], y[3]), pk_bf16(y[4], y[5]), pk_bf16(y[6], y[7])};
      *(u32x4*)(XN + (size_t)row * 1024 + c) = o;
    }
  }
}

constexpr int AT_BUF = 34816;
struct TileRegs { u32x4 k0, k1, v0, v1; };
DEVI void at_gload(TileRegs& r, const bf16_t* Kbase, const bf16_t* VTbase, int key0, int t) {
  r.k0 = *(const u32x4*)(Kbase + (size_t)(key0 + (t >> 4)) * 3072 + (t & 15) * 8);
  r.k1 = *(const u32x4*)(Kbase + (size_t)(key0 + 32 + (t >> 4)) * 3072 + (t & 15) * 8);
  r.v0 = *(const u32x4*)(VTbase + (size_t)(t >> 3) * 8192 + key0 + (t & 7) * 8);
  r.v1 = *(const u32x4*)(VTbase + (size_t)(64 + (t >> 3)) * 8192 + key0 + (t & 7) * 8);
}
DEVI void at_lstore(const TileRegs& r, unsigned char* buf, int t) {
  *(u32x4*)(buf + (t >> 4) * 272 + (t & 15) * 16) = r.k0;
  *(u32x4*)(buf + (32 + (t >> 4)) * 272 + (t & 15) * 16) = r.k1;
  unsigned char* vb = buf + 17408;
  u32x2* p0 = (u32x2*)(vb + (t >> 3) * 136 + (t & 7) * 16);
  u32x2 a = {r.v0[0], r.v0[1]}, b = {r.v0[2], r.v0[3]}; p0[0] = a; p0[1] = b;
  u32x2* p1 = (u32x2*)(vb + (64 + (t >> 3)) * 136 + (t & 7) * 16);
  u32x2 c = {r.v1[0], r.v1[1]}, d = {r.v1[2], r.v1[3]}; p1[0] = c; p1[1] = d;
}

template <int MODE>
DEVI void attn_item(const bf16_t* H, const bf16_t* vT, const float* kmsum, bf16_t* AO, int b, int hh, int qi,
                    float lam_full, float one_m_linit, const float* subln, int wv) {
  constexpr int NKS = MODE ? 8 : 4;
  unsigned char* lds = g_lds;
  const int tid = otid(wv), w = tid >> 6, lane = tid & 63, r = lane & 31, h = lane >> 5;
  const int map = MODE ? 0 : (w & 1);
  const int q0 = MODE ? qi * 256 + w * 32 : qi * 128 + (w >> 1) * 32;
  const int ntiles = MODE ? 4 * (qi + 1) : 2 * qi + 2;
  const size_t tokbase = (size_t)b * 8192;
#ifdef MOBA_ON_DIFF
  const int qcol = MODE ? hh * 128 : hh * 128 + map * 64;
  const int kcol = 512 + hh * 128;
#else
  const int qcol = MODE ? 1536 + hh * 128 : hh * 128 + map * 64;
  const int kcol = MODE ? 2048 + hh * 128 : 512 + hh * 128;
#endif
  const bf16_t* Kbase = H + tokbase * 3072 + kcol;
  const bf16_t* VTbase = vT + (size_t)(b * 512 + hh * 128) * 8192;
  const float cs = (MODE ? 0.08838834764831845f : 0.125f) * 1.4426950408889634f;
  const int kboff = MODE ? 0 : map * 128;

  bf16x8 qf[NKS];
  { const bf16_t* qp = H + (tokbase + q0 + r) * 3072 + qcol + 8 * h;
#pragma unroll
    for (int ks = 0; ks < NKS; ++ks) qf[ks] = *(const bf16x8*)(qp + 16 * ks); }

  unsigned sel = 0;
  if (MODE) {
    f32x16 gt = {};
    const float* kmp = kmsum + (size_t)(b * 32 + r) * 512 + hh * 128 + 8 * h;
    f32x4 kma[8], kmc[8];
#pragma unroll
    for (int ks = 0; ks < 8; ++ks) { kma[ks] = *(const f32x4*)(kmp + 16 * ks); kmc[ks] = *(const f32x4*)(kmp + 16 * ks + 4); }
#pragma unroll
    for (int ks = 0; ks < 8; ++ks) {
      const f32x4 a = kma[ks] * (1.f / 256.f), c = kmc[ks] * (1.f / 256.f);
      gt = mfma32(mk8(pk_bf16(a[0], a[1]), pk_bf16(a[2], a[3]), pk_bf16(c[0], c[1]), pk_bf16(c[2], c[3])), qf[ks < NKS ? ks : 0], gt);
    }
    float gv[16];
#pragma unroll
    for (int rg = 0; rg < 16; ++rg) { const int blk = (rg & 3) + 8 * (rg >> 2) + 4 * h; gv[rg] = (blk < qi) ? gt[rg] : NEG_INF; }
#pragma unroll
    for (int round = 0; round < 3; ++round) {
      float best = NEG_INF; int bi = 99;
#pragma unroll
      for (int rg = 0; rg < 16; ++rg) { const int blk = (rg & 3) + 8 * (rg >> 2) + 4 * h; if (gv[rg] > best) { best = gv[rg]; bi = blk; } }
      float b_lo, b_hi; int i_lo, i_hi; halves(best, b_lo, b_hi); halves_i(bi, i_lo, i_hi);
      const bool lowin = (b_lo > b_hi) || (b_lo == b_hi && i_lo < i_hi);
      const float wval = lowin ? b_lo : b_hi; const int wi = lowin ? i_lo : i_hi;
      if (wval > NEG_INF) sel |= 1u << wi;
#pragma unroll
      for (int rg = 0; rg < 16; ++rg) { const int blk = (rg & 3) + 8 * (rg >> 2) + 4 * h; if (blk == wi) gv[rg] = NEG_INF; }
    }
  }

#ifdef SELFIX
  if (MODE) sel = (qi >= 3) ? 7u : ((1u << qi) - 1u);
#endif
  f32x16 o[4] = {};
  float m = NEG_INF, l = 0.f;
  TileRegs tr;
  at_gload(tr, Kbase, VTbase, 0, tid); at_lstore(tr, lds, tid); __syncthreads();
#pragma unroll 1
  for (int tt = 0; tt < ntiles; ++tt) {
    const unsigned char* buf = lds + (tt & 1) * AT_BUF;
    const int key0 = tt * 64;
    if (tt + 1 < ntiles) at_gload(tr, Kbase, VTbase, key0 + 64, tid);
    bool active, needmask, lanesel = true;
    if (MODE && (tt >> 2) < qi) { lanesel = (sel >> (tt >> 2)) & 1u; active = __any(lanesel ? 1 : 0) != 0; needmask = false; }
    else { active = key0 <= q0 + 31; needmask = key0 + 63 > q0; }
    if (active) {
      f32x16 st[2];
      {
        bf16x8 kfa[NKS], kfb[NKS];
        const unsigned char* kp0 = buf + r * 272 + kboff + h * 16;
#pragma unroll
        for (int ks = 0; ks < NKS; ++ks) kfa[ks] = *(const bf16x8*)(kp0 + ks * 32);
#pragma unroll
        for (int ks = 0; ks < NKS; ++ks) kfb[ks] = *(const bf16x8*)(kp0 + 32 * 272 + ks * 32);
        __builtin_amdgcn_sched_barrier(0);
        f32x16 a0 = {}, a1 = {};
#pragma unroll
        for (int ks = 0; ks < NKS; ++ks) a0 = mfma32(kfa[ks], qf[ks], a0);
#pragma unroll
        for (int ks = 0; ks < NKS; ++ks) a1 = mfma32(kfb[ks], qf[ks], a1);
        st[0] = a0; st[1] = a1;
      }
      if (needmask) {
#pragma unroll
        for (int T = 0; T < 2; ++T)
#pragma unroll
          for (int rg = 0; rg < 16; ++rg) { const int key = key0 + 32 * T + 8 * (rg >> 2) + 4 * h + (rg & 3); if (key > q0 + r) st[T][rg] = NEG_INF; }
      }
      float mxr = NEG_INF;
#pragma unroll
      for (int T = 0; T < 2; ++T)
#pragma unroll
        for (int rg = 0; rg < 16; ++rg) mxr = fmaxf(mxr, st[T][rg]);
      mxr = hmax(mxr);
      const float mxs = lanesel ? mxr * cs : NEG_INF;
      if (__any((mxs > m + 8.0f) ? 1 : 0)) {
        const float mn = fmaxf(m, mxs);
        const float mu2 = (mn == NEG_INF) ? 0.f : mn;
        const float alpha = ex2(m - mu2);
        m = mn;
        l *= alpha;
#pragma unroll
        for (int dt = 0; dt < 4; ++dt) o[dt] = o[dt] * alpha;
      }
      const float nb = lanesel ? ((m == NEG_INF) ? 0.f : -m) : NEG_INF;
      float ps = 0.f;
#pragma unroll
      for (int T = 0; T < 2; ++T)
#pragma unroll
        for (int rg = 0; rg < 16; ++rg) { const float pv = ex2(fmaf(st[T][rg], cs, nb)); st[T][rg] = pv; ps += pv; }
      l += ps;
      {
        const unsigned char* vb0 = buf + 17408 + r * 136 + 8 * h;
        u32x2 vlo[2][4], vhi[2][4];
#pragma unroll
        for (int dt = 0; dt < 4; ++dt) { const unsigned char* vp = vb0 + dt * 32 * 136; vlo[0][dt] = *(const u32x2*)vp; vhi[0][dt] = *(const u32x2*)(vp + 16); }
#pragma unroll
        for (int step = 0; step < 4; ++step) {
          const int T = step >> 1, sx = step & 1;
          if (step < 3) {
#pragma unroll
            for (int dt = 0; dt < 4; ++dt) { const unsigned char* vp = vb0 + dt * 32 * 136 + (step + 1) * 32; vlo[(step + 1) & 1][dt] = *(const u32x2*)vp; vhi[(step + 1) & 1][dt] = *(const u32x2*)(vp + 16); }
          }
          const bf16x8 pb = pack8(st[T], sx);
#pragma unroll
          for (int dt = 0; dt < 4; ++dt) o[dt] = mfma32(mk8(vlo[step & 1][dt][0], vlo[step & 1][dt][1], vhi[step & 1][dt][0], vhi[step & 1][dt][1]), pb, o[dt]);
          __builtin_amdgcn_sched_barrier(0);
        }
      }
    }
    if (tt + 1 < ntiles) at_lstore(tr, lds + ((tt + 1) & 1) * AT_BUF, tid);
    __syncthreads();
  }
  const float lt = hsum(l);
  const float il = 1.f / lt;
  const size_t token = tokbase + q0 + r;
  if (MODE) {
#pragma unroll
    for (int dt = 0; dt < 4; ++dt)
#pragma unroll
      for (int gp = 0; gp < 2; ++gp) {
        const int g0 = 2 * gp, g1 = g0 + 1;
        const u32x2 a0 = {pk_bf16(o[dt][4 * g0] * il, o[dt][4 * g0 + 1] * il), pk_bf16(o[dt][4 * g0 + 2] * il, o[dt][4 * g0 + 3] * il)};
        const u32x2 a1 = {pk_bf16(o[dt][4 * g1] * il, o[dt][4 * g1 + 1] * il), pk_bf16(o[dt][4 * g1 + 2] * il, o[dt][4 * g1 + 3] * il)};
        *(u32x4*)(AO + token * 1024 + 512 + hh * 128 + 32 * dt + 8 * (g0 + h)) = widen_pair(a0, a1, h);
      }
  } else {
    float* ex = (float*)lds;
    const int rgp = w >> 1;
    if (map == 1) {
      const float f = il * lam_full;
#pragma unroll
      for (int dt = 0; dt < 4; ++dt)
#pragma unroll
        for (int rg = 0; rg < 16; ++rg) ex[((rgp * 4 + dt) * 16 + rg) * 64 + lane] = o[dt][rg] * f;
    }
    __syncthreads();
    if (map == 0) {
      float ss = 0.f;
#pragma unroll
      for (int dt = 0; dt < 4; ++dt)
#pragma unroll
        for (int rg = 0; rg < 16; ++rg) { const float d = o[dt][rg] * il - ex[((rgp * 4 + dt) * 16 + rg) * 64 + lane]; o[dt][rg] = d; ss += d * d; }
      ss = hsum(ss);
      const float rinv = rsqrtf(ss * (1.f / 128.f) + 1e-5f) * one_m_linit;
#pragma unroll
      for (int dt = 0; dt < 4; ++dt)
#pragma unroll
        for (int gp = 0; gp < 2; ++gp) {
          u32x2 a[2];
#pragma unroll
          for (int k = 0; k < 2; ++k) {
            const int g = 2 * gp + k, dv = 32 * dt + 8 * g + 4 * h;
            const f32x4 sl = *(const f32x4*)(lds + 130048 + dv * 4);
            a[k] = (u32x2){pk_bf16(o[dt][4 * g] * rinv * sl[0], o[dt][4 * g + 1] * rinv * sl[1]), pk_bf16(o[dt][4 * g + 2] * rinv * sl[2], o[dt][4 * g + 3] * rinv * sl[3])};
          }
          *(u32x4*)(AO + token * 1024 + hh * 128 + 32 * dt + 8 * (2 * gp + h)) = widen_pair(a[0], a[1], h);
        }
    }
    __syncthreads();
  }
}

#ifndef AM
#define AM 3
#endif
DEVI void attn_phase(const Params& p, int e, int wv) {
  asm volatile("" : "+s"(e));
  unsigned char* ws = p.ws;
  const bf16_t* H = (const bf16_t*)(ws + WS_OV + OV_H);
  const bf16_t* dvT = (const bf16_t*)(ws + WS_OV + OV_DVT);
  const bf16_t* mvT = (const bf16_t*)(ws + WS_OV + OV_MVT);
  const float* kmsum = (const float*)(ws + WS_KM) + (size_t)e * 65536;
  bf16_t* AO = (bf16_t*)(ws + WS_AO);
  const float* lam = p.in[2] + e * 256;
  float s1 = 0.f, s2 = 0.f;
  for (int i = 0; i < 64; ++i) { s1 += lam[i] * lam[64 + i]; s2 += lam[128 + i] * lam[192 + i]; }
  const float linit = (e == 0) ? 0.2f : 0.47071301834358413f;
  const float lam_full = __expf(s1) - __expf(s2) + linit;
  const float* subln = p.in[3] + e * 128;
  { const int t0 = otid(wv); if (t0 < 128) ((float*)(g_lds + 130048))[t0] = subln[t0]; __syncthreads(); }
  const int vb = (gridDim.x == 256) ? (int)((blockIdx.x & 7) * 32 + (blockIdx.x >> 3)) : (int)blockIdx.x;
#pragma unroll 1
  for (int u = vb; u < 768; u += gridDim.x) {
    if (u < 512) {
      if (!(AM & 1)) continue;
      const int pidx = (u & 255) * 2 + (u >> 8); const int bh = pidx >> 5, ip = pidx & 31;
      attn_item<0>(H, dvT, kmsum, AO, bh >> 2, bh & 3, 63 - ip, lam_full, 1.f - linit, subln, wv);
      attn_item<0>(H, dvT, kmsum, AO, bh >> 2, bh & 3, ip, lam_full, 1.f - linit, subln, wv);
    } else {
      if (!(AM & 2)) continue;
      const int pp = u - 512, bh = pp >> 4, jp = pp & 15;
#ifdef MOBA_ON_DIFF
#define MVT_SRC dvT
#else
#define MVT_SRC mvT
#endif
      attn_item<1>(H, MVT_SRC, kmsum, AO, bh >> 2, bh & 3, 31 - jp, lam_full, 1.f - linit, subln, wv);
      attn_item<1>(H, MVT_SRC, kmsum, AO, bh >> 2, bh & 3, jp, lam_full, 1.f - linit, subln, wv);
    }
  }
}

DEVI void gla_prep_item(int item, const bf16_t* XB, const bf16_t* WgdT, const float* Wup, const float* bgate,
                        bf16_t* Hg, bf16_t* kT, float* decay, const float* stat_in, const float* ugd, const float* vgd, int wv) {
  const int tid = otid(wv), w = tid >> 6, lane = tid & 63;
  const int b = item >> 7, ch = item & 127;
  const size_t tok0 = (size_t)b * 8192 + ch * 64;
  float* gd = (float*)g_lds;
  if (w < 4) {
    const int fr = lane & 15, fq = lane >> 4;
    f32x4 acc = {};
    const bf16_t* ap = XB + (tok0 + 16 * w + fr) * 1024 + 8 * fq;
    const bf16_t* bp = WgdT + fr * 1024 + 8 * fq;
#pragma unroll 1
    for (int k0 = 0; k0 < 32; k0 += 8) {
      bf16x8 af[8], bfr[8];
#pragma unroll
      for (int i = 0; i < 8; ++i) { af[i] = *(const bf16x8*)(ap + 32 * (k0 + i)); bfr[i] = *(const bf16x8*)(bp + 32 * (k0 + i)); }
#pragma unroll
      for (int i = 0; i < 8; ++i) acc = mfma16(af[i], bfr[i], acc);
    }
    const float ug = ugd[fr], vg = vgd[fr];
#pragma unroll
    for (int j = 0; j < 4; ++j) {
      float mu, rstd; row_mu_rstd(stat_in, (int)tok0 + 16 * w + 4 * fq + j, mu, rstd);
      gd[(16 * w + 4 * fq + j) * 16 + fr] = rstd * (acc[j] - mu * ug) + vg;
    }
  }
  __syncthreads();
  const int c = tid;
  float wup[16];
#pragma unroll
  for (int rr = 0; rr < 16; ++rr) wup[rr] = Wup[rr * 512 + c];
  const float bias = bgate[c];
  float bsum = 0.f;
  bf16_t* qp = Hg + tok0 * 2048 + c;
  bf16_t* kp = qp + 512;
  bf16_t* ktp = kT + (size_t)(b * 512 + c) * 8192 + ch * 64;
  bf16_t qv[8], kv[8], qn[8], kn[8];
#pragma unroll
  for (int tt = 0; tt < 8; ++tt) { qv[tt] = qp[(size_t)tt * 2048]; kv[tt] = kp[(size_t)tt * 2048]; }
#pragma unroll 1
  for (int t8 = 0; t8 < 8; ++t8) {
    if (t8 < 7) {
#pragma unroll
      for (int tt = 0; tt < 8; ++tt) { qn[tt] = qp[(size_t)((t8 + 1) * 8 + tt) * 2048]; kn[tt] = kp[(size_t)((t8 + 1) * 8 + tt) * 2048]; }
    }
    unsigned short kb[8];
#pragma unroll
    for (int tt = 0; tt < 8; ++tt) {
      const int t = t8 * 8 + tt;
      const f32x4* g4 = (const f32x4*)(gd + t * 16);
      float z = bias;
#pragma unroll
      for (int i = 0; i < 4; ++i) { const f32x4 gg = g4[i]; z += gg[0] * wup[4 * i] + gg[1] * wup[4 * i + 1] + gg[2] * wup[4 * i + 2] + gg[3] * wup[4 * i + 3]; }
      const float ls = fminf(z, 0.f) - __logf(1.f + __expf(-fabsf(z)));
      bsum += ls * 0.0625f;
      const float eb = __expf(bsum), en = __expf(-bsum);
      const float q = bf2f(qv[tt]), k = bf2f(kv[tt]);
      qp[(size_t)t * 2048] = f2bf(q * eb * 0.08838834764831845f);
      const bf16_t kk = f2bf(k * en);
      kp[(size_t)t * 2048] = kk;
      kb[tt] = kk;
    }
    u32x4 pk = {(unsigned)kb[0] | ((unsigned)kb[1] << 16), (unsigned)kb[2] | ((unsigned)kb[3] << 16),
                (unsigned)kb[4] | ((unsigned)kb[5] << 16), (unsigned)kb[6] | ((unsigned)kb[7] << 16)};
    *(u32x4*)(ktp + t8 * 8) = pk;
#pragma unroll
    for (int tt = 0; tt < 8; ++tt) { qv[tt] = qn[tt]; kv[tt] = kn[tt]; }
  }
  decay[(size_t)(b * 128 + ch) * 512 + c] = __expf(bsum);
  __syncthreads();
}

constexpr int GL_Q = 0, GL_K = 17408, GL_KT = 34816, GL_BUF = 53248, GL_RED = 2 * GL_BUF;

template <int PASS>
DEVI void gla_scan_item(int item, const bf16_t* Hg, const bf16_t* vT, const bf16_t* kT, const float* decay,
                        float* Ubuf, float* Dseg, bf16_t* AO, const float* normg, int wv) {
  const int tid = otid(wv), w = tid >> 6, lane = tid & 63, r = lane & 31, h = lane >> 5;
  const int bh = item >> 4, seg = item & 15, b = bh >> 2, hd = bh & 3;
  unsigned char* lds = g_lds;
  const bf16_t* hq = Hg + ((size_t)b * 8192 + seg * 512 + (tid >> 4)) * 2048 + hd * 128 + (tid & 15) * 8;
  const bf16_t* kts = kT + (size_t)(b * 512 + hd * 128 + (tid >> 3)) * 8192 + seg * 512 + (tid & 7) * 8;
  u32x4 rq0, rq1, rk0, rk1, rt0, rt1;
#define GL_GLOAD(cc) do { \
    if (PASS == 1) { const bf16_t* _p = hq + (size_t)(cc) * 64 * 2048; rq0 = *(const u32x4*)_p; rq1 = *(const u32x4*)(_p + 32 * 2048); \
                     rk0 = *(const u32x4*)(_p + 512); rk1 = *(const u32x4*)(_p + 32 * 2048 + 512); } \
    rt0 = *(const u32x4*)(kts + (cc) * 64); rt1 = *(const u32x4*)(kts + (size_t)64 * 8192 + (cc) * 64); } while (0)
#define GL_LSTORE(bufp) do { \
    if (PASS == 1) { unsigned char* _q = (bufp) + GL_Q + (tid >> 4) * 272 + (tid & 15) * 16; *(u32x4*)_q = rq0; *(u32x4*)(_q + 32 * 272) = rq1; \
                     *(u32x4*)(_q + GL_K) = rk0; *(u32x4*)(_q + GL_K + 32 * 272) = rk1; } \
    unsigned char* _t = (bufp) + GL_KT + (tid >> 3) * 144 + (tid & 7) * 16; *(u32x4*)_t = rt0; *(u32x4*)(_t + 64 * 144) = rt1; } while (0)
  GL_GLOAD(0);
  f32x16 S[4] = {};
  if (PASS == 1) {
#pragma unroll 1
    for (int js = 0; js < seg; ++js) {
      const int it2 = bh * 16 + js;
      const float* up = Ubuf + ((size_t)(it2 * 8 + w) * 4) * 1024 + lane;
      const float* dp = Dseg + it2 * 128 + 4 * h;
#pragma unroll
      for (int dkt = 0; dkt < 4; ++dkt)
#pragma unroll
        for (int g = 0; g < 4; ++g) {
          const f32x4 d4 = *(const f32x4*)(dp + 32 * dkt + 8 * g);
#pragma unroll
          for (int i = 0; i < 4; ++i) S[dkt][4 * g + i] = S[dkt][4 * g + i] * d4[i] + up[(dkt * 16 + 4 * g + i) * 64];
        }
    }
  }
  GL_LSTORE(lds);
  __syncthreads();
  const bf16_t* vrow = vT + (size_t)(b * 1024 + hd * 256 + 32 * w + r) * 8192;
#pragma unroll 1
  for (int cc = 0; cc < 8; ++cc) {
    const int ch = seg * 8 + cc, tc0 = ch * 64;
    const size_t tokabs0 = (size_t)b * 8192 + tc0;
    const unsigned char* buf = lds + (cc & 1) * GL_BUF;
    if (cc + 1 < 8) GL_GLOAD(cc + 1);
    bf16x8 vnat[4];
#pragma unroll
    for (int ks = 0; ks < 4; ++ks) vnat[ks] = *(const bf16x8*)(vrow + tc0 + 16 * ks + 8 * h);
    f32x16 o0 = {}, o1 = {};
    if (PASS == 1) {
      f32x16 X00 = {}, X01 = {}, X11 = {};
      { const unsigned char* qL = buf + GL_Q + r * 272 + h * 16; const unsigned char* kL = buf + GL_K + r * 272 + h * 16;
#pragma unroll
        for (int ks = 0; ks < 8; ++ks) {
          const bf16x8 k0 = *(const bf16x8*)(kL + ks * 32), k1 = *(const bf16x8*)(kL + 32 * 272 + ks * 32);
          const bf16x8 q0 = *(const bf16x8*)(qL + ks * 32), q1 = *(const bf16x8*)(qL + 32 * 272 + ks * 32);
          X00 = mfma32(k0, q0, X00); X01 = mfma32(k0, q1, X01); X11 = mfma32(k1, q1, X11);
        } }
      u32x2 vpa[4], vpb[4];
      { const bf16_t* vp = vrow + tc0 + 4 * h;
#pragma unroll
        for (int q = 0; q < 4; ++q) { vpa[q] = *(const u32x2*)(vp + 16 * q); vpb[q] = *(const u32x2*)(vp + 16 * q + 8); } }
#pragma unroll
      for (int rg = 0; rg < 16; ++rg) { const int j = (rg & 3) + 8 * (rg >> 2) + 4 * h; if (r < j) { X00[rg] = 0.f; X11[rg] = 0.f; } }
      { const unsigned char* qP = buf + GL_Q + r * 272 + 8 * h;
#pragma unroll
        for (int dkt = 0; dkt < 4; ++dkt)
#pragma unroll
          for (int sx = 0; sx < 2; ++sx) {
            const bf16x8 sa = pack8(S[dkt], sx);
            const unsigned char* qq = qP + (32 * dkt + 16 * sx) * 2;
            const u32x2 a0 = *(const u32x2*)qq, a1 = *(const u32x2*)(qq + 16);
            const u32x2 c0 = *(const u32x2*)(qq + 32 * 272), c1 = *(const u32x2*)(qq + 32 * 272 + 16);
            o0 = mfma32(sa, mk8(a0[0], a0[1], a1[0], a1[1]), o0);
            o1 = mfma32(sa, mk8(c0[0], c0[1], c1[0], c1[1]), o1);
          } }
#pragma unroll
      for (int sx = 0; sx < 2; ++sx) {
        const bf16x8 v0 = mk8(vpa[sx][0], vpa[sx][1], vpb[sx][0], vpb[sx][1]), v1 = mk8(vpa[2 + sx][0], vpa[2 + sx][1], vpb[2 + sx][0], vpb[2 + sx][1]);
        o0 = mfma32(v0, pack8(X00, sx), o0);
        o1 = mfma32(v0, pack8(X01, sx), o1);
        o1 = mfma32(v1, pack8(X11, sx), o1);
      }
      float ss0 = 0.f, ss1 = 0.f;
#pragma unroll
      for (int rg = 0; rg < 16; ++rg) { ss0 += o0[rg] * o0[rg]; ss1 += o1[rg] * o1[rg]; }
      ss0 = hsum(ss0); ss1 = hsum(ss1);
      float* red = (float*)(lds + GL_RED) + (cc & 1) * 512;
      if (h == 0) { red[w * 64 + r] = ss0; red[w * 64 + 32 + r] = ss1; }
    }
    { const unsigned char* ktL = buf + GL_KT + r * 144 + h * 16;
#pragma unroll
      for (int ks = 0; ks < 4; ++ks)
#pragma unroll
        for (int dkt = 0; dkt < 4; ++dkt) S[dkt] = mfma32(*(const bf16x8*)(ktL + dkt * 32 * 144 + ks * 32), vnat[ks], S[dkt]); }
    { const float* dcp = decay + (size_t)(b * 128 + ch) * 512 + hd * 128 + 4 * h;
#pragma unroll
      for (int dkt = 0; dkt < 4; ++dkt)
#pragma unroll
        for (int g = 0; g < 4; ++g) {
          const f32x4 d4 = *(const f32x4*)(dcp + 32 * dkt + 8 * g);
#pragma unroll
          for (int i = 0; i < 4; ++i) S[dkt][4 * g + i] *= d4[i];
        } }
    if (cc + 1 < 8) GL_LSTORE(lds + ((cc + 1) & 1) * GL_BUF);
    __syncthreads();
    if (PASS == 1) {
      const float* red = (const float*)(lds + GL_RED) + (cc & 1) * 512;
      float t0 = 0.f, t1 = 0.f;
#pragma unroll
      for (int ww = 0; ww < 8; ++ww) { t0 += red[ww * 64 + r]; t1 += red[ww * 64 + 32 + r]; }
      const float ri0 = rsqrtf(t0 * (1.f / 256.f) + 1e-5f), ri1 = rsqrtf(t1 * (1.f / 256.f) + 1e-5f);
      u32x2 r4s[2][4]; f32x4 gns[4];
#pragma unroll
      for (int g = 0; g < 4; ++g) {
        gns[g] = *(const f32x4*)(normg + 32 * w + 8 * g + 4 * h);
#pragma unroll
        for (int it = 0; it < 2; ++it) r4s[it][g] = *(const u32x2*)(Hg + (tokabs0 + 32 * it + r) * 2048 + 1024 + hd * 256 + 32 * w + 8 * g + 4 * h);
      }
#pragma unroll
      for (int it = 0; it < 2; ++it) {
        const size_t tok = tokabs0 + 32 * it + r;
        u32x2 pk4[4];
#pragma unroll
        for (int g = 0; g < 4; ++g) {
          const u32x2 r4 = r4s[it][g];
          const f32x4 gn = gns[g];
          const float rv[4] = {bflo(r4[0]), bfhi(r4[0]), bflo(r4[1]), bfhi(r4[1])};
          float ov[4];
#pragma unroll
          for (int i = 0; i < 4; ++i) {
            const float oo = it ? o1[4 * g + i] : o0[4 * g + i];
            const float sg = rv[i] / (1.f + __expf(-rv[i]));
            ov[i] = oo * (it ? ri1 : ri0) * gn[i] * sg;
          }
          pk4[g] = (u32x2){pk_bf16(ov[0], ov[1]), pk_bf16(ov[2], ov[3])};
        }
#pragma unroll
        for (int gp = 0; gp < 2; ++gp)
          *(u32x4*)(AO + tok * 1024 + hd * 256 + 32 * w + 8 * (2 * gp + h)) = widen_pair(pk4[2 * gp], pk4[2 * gp + 1], h);
      }
    }
  }
#undef GL_GLOAD
#undef GL_LSTORE
  if (PASS == 0) {
    float* up = Ubuf + ((size_t)(item * 8 + w) * 4) * 1024 + lane;
#pragma unroll
    for (int dkt = 0; dkt < 4; ++dkt)
#pragma unroll
      for (int rg = 0; rg < 16; ++rg) up[(dkt * 16 + rg) * 64] = S[dkt][rg];
    if (tid < 128) {
      float dv8[8];
#pragma unroll
      for (int cc = 0; cc < 8; ++cc) dv8[cc] = decay[(size_t)(b * 128 + seg * 8 + cc) * 512 + hd * 128 + tid];
      float d = 1.f;
#pragma unroll
      for (int cc = 0; cc < 8; ++cc) d *= dv8[cc];
      Dseg[item * 128 + tid] = d;
    }
  }
  __syncthreads();
}

#define XB_TMO      128
#define XB_XCNT(j)  (256  + 64 * (j))
#define XB_XSUB(j)  (1280 + 64 * (j))
#define XB_XGEN(j)  (2304 + 64 * (j))
#define XB_TOP      3328
#define XB_TOPGEN   3392
#define XCD_BAR_WORDS 3456
#define XB_SPIN_CAP (1u << 20)
DEVI unsigned xb_ld(unsigned* p)              { return __hip_atomic_load(p, __ATOMIC_RELAXED, __HIP_MEMORY_SCOPE_AGENT); }
DEVI unsigned xb_add(unsigned* p, unsigned v) { return __hip_atomic_fetch_add(p, v, __ATOMIC_RELAXED, __HIP_MEMORY_SCOPE_AGENT); }
DEVI unsigned xb_xcc_id() { return (unsigned)__builtin_amdgcn_s_getreg((3 << 11) | 20) & 0xFu; }
#define XB_SPIN(cond, bar) do { unsigned _sp = 0; while (cond) { __builtin_amdgcn_s_sleep(1); \
    if ((++_sp & 255u) == 0u) { if (xb_ld(&(bar)[XB_TMO])) break; if (_sp > XB_SPIN_CAP) { atomicAdd(&(bar)[XB_TMO], 1u); break; } } } } while (0)
struct XcdBarrier { unsigned* bar; unsigned x; volatile LAS unsigned* st; };
DEVI void xcd_barrier_complete(unsigned* bar, unsigned x, unsigned& nloc, unsigned& nx) {
  const unsigned G = gridDim.x * gridDim.y * gridDim.z;
  unsigned sum, cnt, mine, sp = 0u;
  for (;;) {
    sum = 0u; cnt = 0u; mine = 0u;
#pragma unroll
    for (unsigned j = 0; j < 16; ++j) { const unsigned c = xb_ld(&bar[XB_XCNT(j)]); sum += c; cnt += (c > 0u) ? 1u : 0u; mine = (j == x) ? c : mine; }
    if (sum == G) break;
    __builtin_amdgcn_s_sleep(1);
    if ((++sp & 255u) == 0u) { if (xb_ld(&bar[XB_TMO])) break; if (sp > XB_SPIN_CAP) { atomicAdd(&bar[XB_TMO], 1u); break; } }
  }
  nloc = mine > 0u ? mine : 1u; nx = cnt > 0u ? cnt : 1u;
}
DEVI void xcd_barrier(const XcdBarrier& b, bool leader) {
  asm volatile("s_waitcnt vmcnt(0)" ::: "memory");
  __syncthreads();
  if (leader) {
    unsigned* bar = b.bar;
    __builtin_amdgcn_s_waitcnt(0);
    unsigned bx = xb_xcc_id(); asm volatile("" : "+s"(bx));
    unsigned nloc = b.st[0], nx = b.st[1];
    if (nloc == 0u) { xcd_barrier_complete(bar, bx, nloc, nx); b.st[0] = nloc; b.st[1] = nx; }
    const unsigned old = xb_add(&bar[XB_XSUB(bx)], 1u);
    const unsigned gen = old / nloc;
    if (old + 1u == (gen + 1u) * nloc) {
      __builtin_amdgcn_fence(__ATOMIC_RELEASE, "agent");
      asm volatile("s_waitcnt vmcnt(0)" ::: "memory");
      const unsigned og = xb_add(&bar[XB_TOP], 1u);
      const unsigned tg = og / nx;
      if (og + 1u == (tg + 1u) * nx) xb_add(&bar[XB_TOPGEN], 1u);
      else XB_SPIN(xb_ld(&bar[XB_TOPGEN]) == tg, bar);
      __builtin_amdgcn_fence(__ATOMIC_ACQUIRE, "agent");
      xb_add(&bar[XB_XGEN(bx)], 1u);
      asm volatile("s_waitcnt vmcnt(0)" ::: "memory");
    } else {
      XB_SPIN(xb_ld(&bar[XB_XGEN(bx)]) == gen, bar);
      __builtin_amdgcn_fence(__ATOMIC_ACQUIRE, "agent");
      asm volatile("s_waitcnt vmcnt(0)" ::: "memory");
    }
  }
  __syncthreads();
}

#define GSYNC() xcd_barrier(xb, otid(wv) == 0)
__global__ void __launch_bounds__(512, 2) mega_fwd(Params p) {
  cg::grid_group grid = cg::this_grid();
  const int wv = __builtin_amdgcn_readfirstlane((int)threadIdx.x >> 6);
  unsigned char* ws = p.ws;
  XcdBarrier xb; xb.bar = (unsigned*)(ws + WS_BAR); xb.x = xb_xcc_id(); xb.st = (volatile LAS unsigned*)((LAS unsigned char*)g_lds + 131072);
  if (threadIdx.x == 0) { xb.st[0] = 0u; xb.st[1] = 0u; (void)xb_add(&xb.bar[XB_XCNT(xb.x)], 1u); }
  grid.sync();
  bf16_t* XB = (bf16_t*)(ws + WS_XB);
  bf16_t* AO = (bf16_t*)(ws + WS_AO);
  unsigned char* OV = ws + WS_OV;

#ifndef PM
#define PM 0xff
#endif
#ifndef DUP
#define DUP 0
#endif
  if (PM & 1) prologue(p, (char*)g_lds, wv);
  GSYNC();
#if (DUP & 32)
  prologue(p, (char*)g_lds, wv);
  GSYNC();
#endif

  { const int gtid = blockIdx.x * 512 + otid(wv);
    for (int i = gtid; i < 4 * 14336; i += gridDim.x * 512) {
      const int l = i / 14336, c = i % 14336;
      if (c < 6144 && !(l & 1)) continue;
      const float* pp = (const float*)(ws + WS_UVP) + (size_t)l * 16 * 16384 + c;
      float acc = 0.f;
#pragma unroll
      for (int kt = 0; kt < 16; ++kt) acc += pp[(size_t)kt * 16384];
      ((float*)(ws + WS_UV))[(size_t)l * 16384 + c] = acc;
    } }
#pragma unroll 1
  for (int l = 0; l < 4; ++l) {
    const bf16_t* wl = (const bf16_t*)(ws + WS_WT + (size_t)l * WT_LAYER);
    const int e = l >> 1;
    const bool odd = (l & 1) != 0;
    bf16_t* Hg = (bf16_t*)(OV + OV_HG); bf16_t* vT = (bf16_t*)(OV + OV_VT); bf16_t* kT = (bf16_t*)(OV + OV_KT);
    float* Ubuf = (float*)(OV + OV_U); float* decay = (float*)(ws + WS_DEC); float* Dseg = (float*)(ws + WS_DSEG);
#pragma unroll 1
    for (int st = 0; st < 9; ++st) {
      if (!odd && (st == 2 || st == 3)) continue;
      if (st == 5 || (st == 8 && l != 3)) {
        stat_finalize((const float*)(ws + WS_STATS) + (st == 8 ? 1048576 : 0), (float*)(ws + WS_MR) + (st == 8 ? 65536 : 0), wv);
        GSYNC();
        continue;
      }
      if (st == 0 || st == 4 || st == 6 || st == 7) {
        EpiArgs ea{};
        const bf16_t* A; const bf16_t* Bt; int N, K;
        const float* uv = (const float*)(ws + WS_UV) + (size_t)l * 16384;
        float* stats = (float*)(ws + WS_STATS);
        const float* mrb = (const float*)(ws + WS_MR);
        if (st == 0) {
          A = XB; Bt = wl; N = 3072; K = 1024;
          if (odd) { ea.stat_in = mrb + 65536; ea.u = uv + UV_U_IN; ea.v = uv + UV_V_IN; }
          else if (l > 0) { ln_bf16_phase(XB, AO, p.in[14] + (l - 1) * 1024, p.in[15] + (l - 1) * 1024, wv); GSYNC(); A = AO; }
          if (odd) { ea.kind = EPI_GLA; ea.H = Hg; ea.vt0 = vT; }
          else { ea.kind = EPI_EVEN; ea.H = (bf16_t*)(OV + OV_H); ea.vt0 = (bf16_t*)(OV + OV_DVT); ea.vt1 = (bf16_t*)(OV + OV_MVT); ea.kmsum = (float*)(ws + WS_KM) + (size_t)e * 65536; }
        } else if (st == 4) {
          A = AO; Bt = wl + 3 * 1024 * 1024; N = 1024; K = 1024; ea.kind = EPI_RES; ea.Y = XB; ea.X = p.X;
          if (l > 0) { ea.stat_prev = mrb + 65536; ea.gprev = p.in[14] + (l - 1) * 1024; ea.bprev = p.in[15] + (l - 1) * 1024; }
          ea.stat_new = stats;
        } else if (st == 6) {
          A = XB; Bt = wl + 4 * 1024 * 1024; N = 4096; K = 1024; ea.kind = EPI_FFN1; ea.Hff = (bf16_t*)OV;
          ea.stat_in = mrb; ea.u = uv + UV_U_F1; ea.v = uv + UV_V_F1;
        } else {
          A = (const bf16_t*)OV; Bt = wl + 8 * 1024 * 1024; N = 1024; K = 4096; ea.kind = EPI_RES; ea.Y = XB; ea.X = p.X;
          ea.stat_prev = mrb; ea.gprev = p.in[10] + l * 1024; ea.bprev = p.in[11] + l * 1024;
          ea.stat_new = stats + 1048576; ea.final_out = (l == 3);
        }
        if (PM & 2) gemm_phase(A, Bt, N, K, ea, wv);
#if (DUP & 2)
        if (st == 6) { GSYNC(); gemm_phase(A, Bt, N, K, ea, wv); }
#endif
      } else if (st == 1) {
        if (odd) {
#pragma unroll 1
          for (int it = blockIdx.x; it < 512; it += gridDim.x)
            if (PM & 8) gla_prep_item(it, XB, (const bf16_t*)(ws + WS_WGD) + (size_t)e * 16384, p.in[6] + e * 8192, p.in[7] + e * 512, Hg, kT, decay,
                                      (const float*)(ws + WS_MR) + 65536, (const float*)(ws + WS_UV) + (size_t)l * 16384 + UV_U_GD, (const float*)(ws + WS_UV) + (size_t)l * 16384 + UV_V_GD, wv);
        } else {
          if (PM & 4) attn_phase(p, e, wv);
#if (DUP & 1)
          GSYNC(); attn_phase(p, e, wv);
#endif
        }
      } else if (st == 2) {
#pragma unroll 1
        for (int it = blockIdx.x; it < 256; it += gridDim.x) if (PM & 16) gla_scan_item<0>(it, Hg, vT, kT, decay, Ubuf, Dseg, AO, p.in[8] + e * 256, wv);
#if (DUP & 4)
        GSYNC();
        for (int it = blockIdx.x; it < 256; it += gridDim.x) gla_scan_item<0>(it, Hg, vT, kT, decay, Ubuf, Dseg, AO, p.in[8] + e * 256, wv);
#endif
      } else if (st == 3) {
#pragma unroll 1
        for (int it = blockIdx.x; it < 256; it += gridDim.x) if (PM & 32) gla_scan_item<1>(it, Hg, vT, kT, decay, Ubuf, Dseg, AO, p.in[8] + e * 256, wv);
#if (DUP & 8)
        GSYNC();
        for (int it = blockIdx.x; it < 256; it += gridDim.x) gla_scan_item<1>(it, Hg, vT, kT, decay, Ubuf, Dseg, AO, p.in[8] + e * 256, wv);
#endif
      } else {
        if (PM & 64) ln_phase(p.X, XB, p.in[14] + l * 1024, p.in[15] + l * 1024, true, wv);
      }
      GSYNC();
#if (DUP & 16)
      GSYNC();
#endif
    }
  }
}

extern "C" void kernel_launch(void* const* d_in, const int* in_sizes, int n_in, void* d_out, int out_size, void* d_ws, size_t ws_size,
                              hipStream_t stream) {
  constexpr int LDS_BYTES = 131072 + 64;
  static int grid = 0;
  if (grid == 0) {
    if (n_in != 16 || out_size != NTOK * DM || ws_size < WS_END) {
      fprintf(stderr, "kernel_launch: unexpected shapes (n_in %d out %d ws %zu need %zu)\n", n_in, out_size, ws_size, (size_t)WS_END);
      grid = -1; return;
    }
    int dev = 0, cus = 0, per_cu = 0;
    hipGetDevice(&dev);
    hipDeviceGetAttribute(&cus, hipDeviceAttributeMultiprocessorCount, dev);
    hipFuncSetAttribute((const void*)mega_fwd, hipFuncAttributeMaxDynamicSharedMemorySize, LDS_BYTES);
    hipOccupancyMaxActiveBlocksPerMultiprocessor(&per_cu, (const void*)mega_fwd, 512, LDS_BYTES);
    if (per_cu < 1) per_cu = 1;
    grid = cus * per_cu;
    if (grid > 256) grid = 256;
    (void)hipGetLastError();
  }
  if (grid < 0) return;
  if (hipMemsetAsync((char*)d_ws + WS_BAR, 0, 16384, stream) != hipSuccess) { fprintf(stderr, "kernel_launch: memset of barrier words failed\n"); return; }
  Params p{};
  for (int i = 0; i < 16; ++i) p.in[i] = (const float*)d_in[i];
  p.X = (float*)d_out;
  p.ws = (unsigned char*)d_ws;
  void* args[] = {&p};
  hipError_t err = hipLaunchCooperativeKernel((const void*)mega_fwd, dim3(grid), dim3(512), args, LDS_BYTES, stream);
  if (err != hipSuccess) fprintf(stderr, "cooperative launch failed: %s (grid %d)\n", hipGetErrorString(err), grid);
}
```
